# Optimizing an MI355X kernel written in HIP

```python
import math
import jax, jax.numpy as jnp
from jax import lax
import numpy as np


D_MODEL = 1024
BATCH = 4
SEQ = 4096
DEPTH = 2
DEC_BATCH = 16
DEC_SEQ = 64
PAST_LEN = 2048

CHUNK = 64
PLE_DIM = 256
SSM_WIDTH = 256
SSM_GROUP = 16
SSM_GROUPS = SSM_WIDTH // SSM_GROUP
SSM_STATE = 64
ATT_HEADS = 8
ATT_HEAD_DIM = 64
ATT_WIDTH = ATT_HEADS * ATT_HEAD_DIM
ATT_PAST_CHUNKS = 8
REL_CLIP = 256
RET_HEADS = 4
RET_KEY_DIM = 64
RET_VAL_DIM = 64
RET_QK = RET_HEADS * RET_KEY_DIM
RET_V = RET_HEADS * RET_VAL_DIM
ROPE_BASE = 10000.0
PEER_HEADS = 8
PEER_KEY_DIM = 256
N_KEYS = 128
N_EXPERTS = N_KEYS * N_KEYS
PEER_TOPK = 16
PEER_BLOCK = 128
DN_ALPHA = (2 * DEPTH) ** 0.25
DN_BETA = (8 * DEPTH) ** -0.25
LN_EPS = 1e-5
IN_SPLITS = (SSM_WIDTH, ATT_WIDTH, ATT_WIDTH, ATT_WIDTH, RET_QK, RET_QK, RET_V, RET_V, D_MODEL, D_MODEL, D_MODEL)
IN_COLS = sum(IN_SPLITS)
IN_OFFSETS = tuple(np.cumsum(IN_SPLITS)[:-1].tolist())

kernel_name = 'hybrid_s5_bandattn_retention_peer_stream_step'

F32 = jnp.float32


def layer_norm(x, g, b):
    xf = x.astype(F32)
    mu = xf.mean(-1, keepdims=True)
    var = jnp.square(xf - mu).mean(-1, keepdims=True)
    return ((xf - mu) * lax.rsqrt(var + LN_EPS) * g.astype(F32) + b.astype(F32)).astype(x.dtype)


def s5_mixer(u, h0_re, h0_im, lam_re, lam_im, b_re, b_im, c_re, c_im, log_dt, d_skip, w_glu, b_glu):
    bsz, t, _ = u.shape
    uf = u.astype(F32)
    ug = uf.reshape(bsz, t, SSM_GROUPS, SSM_GROUP)
    lam = lax.complex(lam_re.astype(F32), lam_im.astype(F32))
    dt = jnp.exp(log_dt.astype(F32))[:, None]
    lam_dt = lam * dt
    a_bar = jnp.exp(lam_dt)
    b = lax.complex(b_re.astype(F32), b_im.astype(F32))
    b_bar = ((a_bar - 1.0) / lam)[..., None] * b
    bu = jnp.einsum('gnp,btgp->btgn', b_bar, ug.astype(jnp.complex64))
    a_full = jnp.broadcast_to(a_bar, bu.shape)

    def combine(left, right):
        return (left[0] * right[0], right[0] * left[1] + right[1])

    _, h = lax.associative_scan(combine, (a_full, bu), axis=1)
    steps = jnp.arange(1, t + 1, dtype=F32)
    carry = jnp.exp(lam_dt[None] * steps[:, None, None])
    h0 = lax.complex(h0_re.astype(F32), h0_im.astype(F32))
    h = h + carry[None] * h0[:, None]
    c = lax.complex(c_re.astype(F32), c_im.astype(F32))
    y = jnp.real(jnp.einsum('gpn,btgn->btgp', c, h)).reshape(bsz, t, SSM_WIDTH) + d_skip.astype(F32) * uf
    z = jax.nn.gelu(y)
    out = z * jax.nn.sigmoid(z @ w_glu.astype(F32) + b_glu.astype(F32))
    h_last = h[:, -1]
    return out.astype(u.dtype), jnp.real(h_last), jnp.imag(h_last)


def rel_bias_lookup(dist, table):
    idx = jnp.clip(dist, -REL_CLIP, REL_CLIP) + REL_CLIP
    return jnp.moveaxis(table[idx], -1, 0).astype(F32)


def band_attention_prompt(q, k, v, table, n_rows):
    bsz, t, h, hd = q.shape
    n_chunks = t // CHUNK
    pad = ATT_PAST_CHUNKS * CHUNK
    band = pad + CHUNK
    kp = jnp.pad(k, ((0, 0), (pad, 0), (0, 0), (0, 0)))
    vp = jnp.pad(v, ((0, 0), (pad, 0), (0, 0), (0, 0)))
    i = jnp.arange(CHUNK)
    j = jnp.arange(band)
    bias = rel_bias_lookup(i[:, None] - j[None, :] + pad, table)
    qc = jnp.moveaxis(q.reshape(bsz, n_chunks, CHUNK, h, hd), 1, 0)
    scale = hd ** -0.5

    def one_chunk(args):
        c, qb = args
        start = c * CHUNK
        kb = lax.dynamic_slice_in_dim(kp, start, band, axis=1)
        vb = lax.dynamic_slice_in_dim(vp, start, band, axis=1)
        s = jnp.einsum('bihd,bjhd->bhij', qb, kb).astype(F32) * scale + bias
        valid = (j + start) >= pad
        s = jnp.where(valid, s, jnp.finfo(F32).min)
        p = jax.nn.softmax(s, axis=-1).astype(vb.dtype)
        return jnp.einsum('bhij,bjhd->bihd', p, vb)

    o = lax.map(one_chunk, (jnp.arange(n_chunks), qc))
    o = jnp.moveaxis(o, 0, 1).reshape(bsz, t, h * hd)
    return o, kp[:, -n_rows:], vp[:, -n_rows:]


def band_attention_sample(q, k, v, cache_k, cache_v, table):
    bsz, l, h, hd = q.shape
    r = cache_k.shape[1]
    kk = jnp.concatenate([cache_k, k], axis=1)
    vv = jnp.concatenate([cache_v, v], axis=1)
    q_pos = PAST_LEN + jnp.arange(l)
    k_pos = PAST_LEN - r + jnp.arange(r + l)
    bias = rel_bias_lookup(q_pos[:, None] - k_pos[None, :], table)
    s = jnp.einsum('bihd,bjhd->bhij', q, kk).astype(F32) * (hd ** -0.5) + bias
    p = jax.nn.softmax(s, axis=-1).astype(vv.dtype)
    o = jnp.einsum('bhij,bjhd->bihd', p, vv).reshape(bsz, l, h * hd)
    return o, k, v


def rope(x, pos):
    half = x.shape[-1] // 2
    freqs = ROPE_BASE ** (-jnp.arange(half, dtype=F32) / half)
    ang = pos.astype(F32)[:, None] * freqs[None]
    cos = jnp.cos(ang)[None, :, None, :]
    sin = jnp.sin(ang)[None, :, None, :]
    x1 = x[..., :half].astype(F32)
    x2 = x[..., half:].astype(F32)
    return jnp.concatenate([x1 * cos - x2 * sin, x1 * sin + x2 * cos], axis=-1).astype(x.dtype)


def retention(q, k, v, s0, chunk):
    bsz, t, h, dk = q.shape
    dv = v.shape[-1]
    nc = t // chunk
    lg = jnp.log1p(-(2.0 ** (-5.0 - jnp.arange(h, dtype=F32))))
    qc = q.reshape(bsz, nc, chunk, h, dk).astype(F32) * (dk ** -0.5)
    kc = k.reshape(bsz, nc, chunk, h, dk).astype(F32)
    vc = v.reshape(bsz, nc, chunk, h, dv).astype(F32)
    i = jnp.arange(chunk, dtype=F32)
    intra = jnp.exp(lg[:, None, None] * jnp.abs(i[:, None] - i[None, :]))
    scores = jnp.einsum('bnihd,bnjhd->bnhij', qc, kc) * intra
    o = jnp.einsum('bnhij,bnjhe->bnihe', scores, vc)
    k_w = jnp.exp(lg[None, :] * (chunk - 1.0 - i)[:, None])
    contrib = jnp.einsum('bnjhd,jh,bnjhe->bnhde', kc, k_w, vc)
    n = jnp.arange(nc, dtype=F32)
    lag = n[:, None] - 1.0 - n[None, :]
    carry_w = jnp.where(lag >= 0, jnp.exp(lg[:, None, None] * chunk * jnp.maximum(lag, 0.0)), 0.0)
    s0f = s0.astype(F32)
    s_prev = (jnp.einsum('hnm,bmhde->bnhde', carry_w, contrib)
              + jnp.exp(lg[None, :] * chunk * n[:, None])[None, :, :, None, None] * s0f[:, None])
    q_w = jnp.exp(lg[None, :] * (i[:, None] + 1.0))
    o = o + jnp.einsum('bnihd,ih,bnhde->bnihe', qc, q_w, s_prev)
    fin_w = jnp.exp(lg[:, None] * chunk * (nc - 1.0 - n)[None, :])
    s_fin = (jnp.einsum('hm,bmhde->bhde', fin_w, contrib)
             + jnp.exp(lg * chunk * nc)[None, :, None, None] * s0f)
    return o.reshape(bsz, t, h, dv), s_fin


def peer_ffn(x, w_q, sub_keys, u_tab, v_tab):
    bsz, t, d = x.shape
    xf = x.reshape(-1, d)
    n_tok = xf.shape[0]
    q = (xf @ w_q).reshape(n_tok, PEER_HEADS, 2, PEER_KEY_DIM // 2).astype(F32)
    s = jnp.einsum('thsd,hskd->thsk', q, sub_keys.astype(F32))
    sc, ix = lax.top_k(s, PEER_TOPK)
    cand = (sc[:, :, 0, :, None] + sc[:, :, 1, None, :]).reshape(n_tok, PEER_HEADS, -1)
    cand_ix = (ix[:, :, 0, :, None] * N_KEYS + ix[:, :, 1, None, :]).reshape(n_tok, PEER_HEADS, -1)
    top_s, sel = lax.top_k(cand, PEER_TOPK)
    expert = jnp.take_along_axis(cand_ix, sel, axis=-1)
    gate = jax.nn.softmax(top_s, axis=-1)
    n_blk = -(-n_tok // PEER_BLOCK)
    pad = n_blk * PEER_BLOCK - n_tok
    xb = jnp.pad(xf, ((0, pad), (0, 0))).reshape(n_blk, PEER_BLOCK, d)
    eb = jnp.pad(expert, ((0, pad), (0, 0), (0, 0))).reshape(n_blk, PEER_BLOCK, PEER_HEADS, PEER_TOPK)
    gb = jnp.pad(gate, ((0, pad), (0, 0), (0, 0))).reshape(n_blk, PEER_BLOCK, PEER_HEADS, PEER_TOPK)

    def block(args):
        xk, ek, gk = args
        u = u_tab[ek]
        act = jax.nn.gelu(jnp.einsum('bhkd,bd->bhk', u, xk).astype(F32))
        w = (gk * act).astype(xk.dtype)
        return jnp.einsum('bhk,bhkd->bd', w, v_tab[ek])

    out = lax.map(block, (xb, eb, gb)).reshape(-1, d)[:n_tok]
    return out.reshape(bsz, t, d)


def trunk_layer(x, pe, h0_re, h0_im, ck, cv, s0, pos, prompt, n_rows, lp):
    bsz, t, _ = x.shape
    h = x @ lp['w_in']
    (u_ssm, q_att, k_att, v_att, q_ret, k_ret, v_ret, g_ret,
     gate_ssm, gate_att, gate_ret) = jnp.split(h, IN_OFFSETS, axis=-1)
    y_ssm, h_re, h_im = s5_mixer(u_ssm, h0_re, h0_im, lp['ssm_lam_re'], lp['ssm_lam_im'],
                                 lp['ssm_b_re'], lp['ssm_b_im'], lp['ssm_c_re'], lp['ssm_c_im'],
                                 lp['ssm_log_dt'], lp['ssm_d'], lp['ssm_w_glu'], lp['ssm_b_glu'])
    q_att = q_att.reshape(bsz, t, ATT_HEADS, ATT_HEAD_DIM)
    k_att = k_att.reshape(bsz, t, ATT_HEADS, ATT_HEAD_DIM)
    v_att = v_att.reshape(bsz, t, ATT_HEADS, ATT_HEAD_DIM)
    if prompt:
        y_att, new_k, new_v = band_attention_prompt(q_att, k_att, v_att, lp['att_rel_bias'], n_rows)
    else:
        y_att, new_k, new_v = band_attention_sample(q_att, k_att, v_att, ck, cv, lp['att_rel_bias'])
    q_ret = rope(q_ret.reshape(bsz, t, RET_HEADS, RET_KEY_DIM), pos)
    k_ret = rope(k_ret.reshape(bsz, t, RET_HEADS, RET_KEY_DIM), pos)
    o_ret, s_fin = retention(q_ret, k_ret, v_ret.reshape(bsz, t, RET_HEADS, RET_VAL_DIM), s0,
                             CHUNK if prompt else t)
    mu = o_ret.mean(-1, keepdims=True)
    var = jnp.square(o_ret - mu).mean(-1, keepdims=True)
    o_ret = ((o_ret - mu) * lax.rsqrt(var + LN_EPS)).reshape(bsz, t, RET_V)
    y_ret = (o_ret * lp['ret_gn_g'].astype(F32) * jax.nn.silu(g_ret.astype(F32))).astype(x.dtype)
    merged = (jax.nn.sigmoid(gate_ssm) * (y_ssm @ lp['w_br_ssm'])
              + jax.nn.sigmoid(gate_att) * (y_att @ lp['w_br_att'])
              + jax.nn.sigmoid(gate_ret) * (y_ret @ lp['w_br_ret']))
    x = layer_norm(DN_ALPHA * x + merged @ lp['w_o'], lp['ln1_g'], lp['ln1_b'])
    x = layer_norm(DN_ALPHA * x + peer_ffn(x, lp['peer_w_q'], lp['peer_sub_keys'], lp['peer_u'], lp['peer_v']),
                   lp['ln2_g'], lp['ln2_b'])
    ple = jax.nn.sigmoid(x @ lp['ple_w_g']) * (pe @ lp['ple_w_p'])
    x = layer_norm(DN_ALPHA * x + ple, lp['ln3_g'], lp['ln3_b'])
    return x, (h_re, h_im, new_k, new_v, s_fin)


def setup_inputs(seed: int = 0) -> dict:
    key = jax.random.key(seed)
    ks = iter(jax.random.split(key, 48))

    def nrm(shape, scale):
        return jax.random.normal(next(ks), shape, F32) * scale

    att_rows = min(ATT_PAST_CHUNKS * CHUNK, PAST_LEN)
    lam_im = jnp.tile(math.pi * jnp.arange(SSM_STATE, dtype=F32), (DEPTH, SSM_GROUPS, 1))
    return {
        'x_prompt': nrm((BATCH, SEQ, D_MODEL), 1.0),
        'x_sample': nrm((DEC_BATCH, DEC_SEQ, D_MODEL), 1.0),
        'p_prompt': nrm((DEPTH, BATCH, SEQ, PLE_DIM), 1.0),
        'p_sample': nrm((DEPTH, DEC_BATCH, DEC_SEQ, PLE_DIM), 1.0),
        'state_ssm_re': nrm((DEPTH, DEC_BATCH, SSM_GROUPS, SSM_STATE), 0.1),
        'state_ssm_im': nrm((DEPTH, DEC_BATCH, SSM_GROUPS, SSM_STATE), 0.1),
        'cache_attn_k': nrm((DEPTH, DEC_BATCH, att_rows, ATT_HEADS, ATT_HEAD_DIM), 1.0),
        'cache_attn_v': nrm((DEPTH, DEC_BATCH, att_rows, ATT_HEADS, ATT_HEAD_DIM), 1.0),
        'state_ret': nrm((DEPTH, DEC_BATCH, RET_HEADS, RET_KEY_DIM, RET_VAL_DIM), 4.0),
        'w_in': nrm((DEPTH, D_MODEL, IN_COLS), D_MODEL ** -0.5),
        'ssm_lam_re': -0.5 + nrm((DEPTH, SSM_GROUPS, SSM_STATE), 0.01),
        'ssm_lam_im': lam_im,
        'ssm_b_re': nrm((DEPTH, SSM_GROUPS, SSM_STATE, SSM_GROUP), (2 * SSM_GROUP) ** -0.5),
        'ssm_b_im': nrm((DEPTH, SSM_GROUPS, SSM_STATE, SSM_GROUP), (2 * SSM_GROUP) ** -0.5),
        'ssm_c_re': nrm((DEPTH, SSM_GROUPS, SSM_GROUP, SSM_STATE), SSM_STATE ** -0.5),
        'ssm_c_im': nrm((DEPTH, SSM_GROUPS, SSM_GROUP, SSM_STATE), SSM_STATE ** -0.5),
        'ssm_log_dt': jax.random.uniform(next(ks), (DEPTH, SSM_GROUPS), F32, math.log(1e-3), math.log(1e-1)),
        'ssm_d': nrm((DEPTH, SSM_WIDTH), 1.0),
        'ssm_w_glu': nrm((DEPTH, SSM_WIDTH, SSM_WIDTH), SSM_WIDTH ** -0.5),
        'ssm_b_glu': nrm((DEPTH, SSM_WIDTH), 0.01),
        'att_rel_bias': nrm((DEPTH, 2 * REL_CLIP + 1, ATT_HEADS), 0.1),
        'ret_gn_g': 1.0 + nrm((DEPTH, RET_V), 0.02),
        'w_br_ssm': nrm((DEPTH, SSM_WIDTH, D_MODEL), SSM_WIDTH ** -0.5),
        'w_br_att': nrm((DEPTH, ATT_WIDTH, D_MODEL), ATT_WIDTH ** -0.5),
        'w_br_ret': nrm((DEPTH, RET_V, D_MODEL), RET_V ** -0.5),
        'w_o': nrm((DEPTH, D_MODEL, D_MODEL), DN_BETA * D_MODEL ** -0.5),
        'ln1_g': 1.0 + nrm((DEPTH, D_MODEL), 0.02),
        'ln1_b': nrm((DEPTH, D_MODEL), 0.01),
        'peer_w_q': nrm((DEPTH, D_MODEL, PEER_HEADS * PEER_KEY_DIM), D_MODEL ** -0.5),
        'peer_sub_keys': nrm((DEPTH, PEER_HEADS, 2, N_KEYS, PEER_KEY_DIM // 2), (PEER_KEY_DIM // 2) ** -0.5),
        'peer_u': nrm((DEPTH, N_EXPERTS, D_MODEL), D_MODEL ** -0.5),
        'peer_v': nrm((DEPTH, N_EXPERTS, D_MODEL), DN_BETA * PEER_HEADS ** -0.5),
        'ln2_g': 1.0 + nrm((DEPTH, D_MODEL), 0.02),
        'ln2_b': nrm((DEPTH, D_MODEL), 0.01),
        'ple_w_g': nrm((DEPTH, D_MODEL, D_MODEL), D_MODEL ** -0.5),
        'ple_w_p': nrm((DEPTH, PLE_DIM, D_MODEL), DN_BETA * PLE_DIM ** -0.5),
        'ln3_g': 1.0 + nrm((DEPTH, D_MODEL), 0.02),
        'ln3_b': nrm((DEPTH, D_MODEL), 0.01),
    }


def reference(x_prompt, x_sample, p_prompt, p_sample, state_ssm_re, state_ssm_im, cache_attn_k, cache_attn_v,
              state_ret, w_in, ssm_lam_re, ssm_lam_im, ssm_b_re, ssm_b_im, ssm_c_re, ssm_c_im, ssm_log_dt,
              ssm_d, ssm_w_glu, ssm_b_glu, att_rel_bias, ret_gn_g, w_br_ssm, w_br_att, w_br_ret, w_o,
              ln1_g, ln1_b, peer_w_q, peer_sub_keys, peer_u, peer_v, ln2_g, ln2_b, ple_w_g, ple_w_p,
              ln3_g, ln3_b):
    n_rows = cache_attn_k.shape[2]
    bsz_p = x_prompt.shape[0]
    pos_p = jnp.arange(x_prompt.shape[1])
    pos_s = PAST_LEN + jnp.arange(x_sample.shape[1])
    y_p, y_s = x_prompt, x_sample
    new_p = ([], [], [], [], [])
    new_s = ([], [], [], [], [])
    for li in range(DEPTH):
        lp = {
            'w_in': w_in[li], 'ssm_lam_re': ssm_lam_re[li], 'ssm_lam_im': ssm_lam_im[li],
            'ssm_b_re': ssm_b_re[li], 'ssm_b_im': ssm_b_im[li], 'ssm_c_re': ssm_c_re[li],
            'ssm_c_im': ssm_c_im[li], 'ssm_log_dt': ssm_log_dt[li], 'ssm_d': ssm_d[li],
            'ssm_w_glu': ssm_w_glu[li], 'ssm_b_glu': ssm_b_glu[li], 'att_rel_bias': att_rel_bias[li],
            'ret_gn_g': ret_gn_g[li], 'w_br_ssm': w_br_ssm[li], 'w_br_att': w_br_att[li],
            'w_br_ret': w_br_ret[li], 'w_o': w_o[li], 'ln1_g': ln1_g[li], 'ln1_b': ln1_b[li],
            'peer_w_q': peer_w_q[li], 'peer_sub_keys': peer_sub_keys[li], 'peer_u': peer_u[li],
            'peer_v': peer_v[li], 'ln2_g': ln2_g[li], 'ln2_b': ln2_b[li], 'ple_w_g': ple_w_g[li],
            'ple_w_p': ple_w_p[li], 'ln3_g': ln3_g[li], 'ln3_b': ln3_b[li],
        }
        zero_ssm = jnp.zeros((bsz_p, SSM_GROUPS, SSM_STATE), F32)
        zero_ret = jnp.zeros((bsz_p, RET_HEADS, RET_KEY_DIM, RET_VAL_DIM), F32)
        y_p, st = trunk_layer(y_p, p_prompt[li], zero_ssm, zero_ssm, None, None, zero_ret, pos_p,
                              True, n_rows, lp)
        for lst, a in zip(new_p, st):
            lst.append(a)
        y_s, st = trunk_layer(y_s, p_sample[li], state_ssm_re[li], state_ssm_im[li], cache_attn_k[li],
                              cache_attn_v[li], state_ret[li], pos_s, False, n_rows, lp)
        for lst, a in zip(new_s, st):
            lst.append(a)
    ssm_re_p = jnp.stack(new_p[0])
    ssm_im_p = jnp.stack(new_p[1])
    att_k_p = jnp.stack(new_p[2])
    att_v_p = jnp.stack(new_p[3])
    ret_p = jnp.stack(new_p[4])
    ssm_re_s = jnp.stack(new_s[0])
    ssm_im_s = jnp.stack(new_s[1])
    att_k_s = jnp.stack(new_s[2])
    att_v_s = jnp.stack(new_s[3])
    ret_s = jnp.stack(new_s[4])
    return (y_p, y_s, ssm_re_p, ssm_im_p, att_k_p, att_v_p, ret_p, ssm_re_s, ssm_im_s, att_k_s, att_v_s, ret_s)
```

```cpp
#include <hip/hip_runtime.h>
#include <hip/hip_cooperative_groups.h>
#include <cstdio>
#include <cstdint>
namespace cg = cooperative_groups;

#ifndef MULTI_LAUNCH
#define MULTI_LAUNCH 0
#endif

typedef unsigned short bf16;
using bf16x8 = __attribute__((ext_vector_type(8))) short;
using f32x16 = __attribute__((ext_vector_type(16))) float;
using f32x4 = __attribute__((ext_vector_type(4))) float;

#define NTOK 17408
#define NPTOK 16384
#define DM 1024
#define INC 5888
#define NCHUNK 272
#define C_USSM 0
#define C_QATT 256
#define C_KATT 768
#define C_VATT 1280
#define C_QRET 1792
#define C_KRET 2048
#define C_VRET 2304
#define C_GRET 2560
#define C_GATE 2816
#define DN_ALPHA 1.41421356237f
#define LN_EPS 1e-5f

constexpr size_t O_YP = 0;
constexpr size_t O_YS = O_YP + 4ull * 4096 * 1024;
constexpr size_t O_SRE_P = O_YS + 16ull * 64 * 1024;
constexpr size_t O_SIM_P = O_SRE_P + 2 * 4 * 16 * 64;
constexpr size_t O_AK_P = O_SIM_P + 2 * 4 * 16 * 64;
constexpr size_t O_AV_P = O_AK_P + 2ull * 4 * 512 * 512;
constexpr size_t O_RET_P = O_AV_P + 2ull * 4 * 512 * 512;
constexpr size_t O_SRE_S = O_RET_P + 2 * 4 * 4 * 4096;
constexpr size_t O_SIM_S = O_SRE_S + 2 * 16 * 16 * 64;
constexpr size_t O_AK_S = O_SIM_S + 2 * 16 * 16 * 64;
constexpr size_t O_AV_S = O_AK_S + 2ull * 16 * 64 * 512;
constexpr size_t O_RET_S = O_AV_S + 2ull * 16 * 64 * 512;
constexpr size_t O_END = O_RET_S + 2ull * 16 * 4 * 4096;

constexpr size_t W_IN = 0;
constexpr size_t W_BRS = W_IN + 5888ull * 1024 * 2;
constexpr size_t W_BRA = W_BRS + 1024ull * 256 * 2;
constexpr size_t W_BRR = W_BRA + 1024ull * 512 * 2;
constexpr size_t W_O = W_BRR + 1024ull * 256 * 2;
constexpr size_t W_QK = W_O + 1024ull * 1024 * 2;
constexpr size_t W_G = W_QK + 2048ull * 1024 * 2;
constexpr size_t W_P = W_G + 1024ull * 1024 * 2;
constexpr size_t W_GLU = W_P + 1024ull * 256 * 2;
constexpr size_t W_U = W_GLU + 256ull * 256 * 2;
constexpr size_t W_V = W_U + 16384ull * 1024 * 2;
constexpr size_t W_TT = W_V + 16384ull * 1024 * 2;
#define KERN_ELEMS (16 * 64 * 256)
constexpr size_t W_BST = W_TT + 16ull * 1024 * 1152 * 2;
constexpr size_t W_ROPE = W_BST + 16ull * 128 * 1024 * 2;
constexpr size_t W_X = W_ROPE + 4096ull * 32 * 8;
constexpr size_t W_PE = W_X + (size_t)NTOK * 1024 * 2;
constexpr size_t W_H = W_PE + (size_t)NTOK * 256 * 2;
constexpr size_t W_HT = W_H + (size_t)NTOK * 5888 * 2;
constexpr size_t W_YSSM = W_HT + 1024ull * NTOK * 2;
constexpr size_t W_YATT = W_YSSM + (size_t)NTOK * 256 * 2;
constexpr size_t W_YRET = W_YATT + (size_t)NTOK * 512 * 2;
constexpr size_t W_CK = W_YRET + (size_t)NTOK * 256 * 2;
constexpr size_t W_CVT = W_CK + 16ull * 512 * 512 * 2;
constexpr size_t W_CT = W_CVT + 16ull * 512 * 512 * 2;
constexpr size_t W_SPREV = W_CT + 272ull * 4 * 4096 * 4;
constexpr size_t W_SC = W_SPREV + 272ull * 4 * 4096 * 2;
constexpr size_t W_HS = W_SC + 272ull * 16 * 128 * 4;
constexpr size_t W_BAR = W_HS + 272ull * 16 * 128 * 2;
constexpr size_t WS_END = W_BAR + 16384;

#define LDS_TILE_BYTES 73728
#define LDS_BYTES (73728 + 16)
#define LDS_ROW 72
#define STAGE_ELEMS (128 * LDS_ROW)

struct Params {
  const float* in[38];
  float* out;
  unsigned char* ws;
  int pbeg, pend;
  int pad0, pad1;
};

typedef const __attribute__((address_space(4))) Params* KP;
__device__ __forceinline__ KP kp_get() { KP p = (KP)__builtin_amdgcn_kernarg_segment_ptr(); asm volatile("" : "+s"(p)); return p; }

enum { I_XP = 0, I_XS, I_PP, I_PS, I_SRE, I_SIM, I_CK, I_CV, I_SRET, I_WIN, I_LRE, I_LIM, I_BRE, I_BIM, I_CRE, I_CIM,
       I_LDT, I_SD, I_WGLU, I_BGLU, I_BIAS, I_GNG, I_WBS, I_WBA, I_WBR, I_WO, I_L1G, I_L1B, I_WQ, I_KEYS, I_PU, I_PV,
       I_L2G, I_L2B, I_WG, I_WP, I_L3G, I_L3B };

enum { PH_PRO = 0, PH_GIN, PH_A, PH_B, PH_C, PH_D, PH_E, PH_WO, PH_LN1, PH_PQ, PH_PEER, PH_PLE, PH_LN3, PH_N };

__device__ __forceinline__ bf16 f2bf(float f) {
  unsigned u = __float_as_uint(f);
  u += 0x7fffu + ((u >> 16) & 1u);
  return (bf16)(u >> 16);
}
__device__ __forceinline__ float bf2f(bf16 h) { return __uint_as_float(((unsigned)h) << 16); }
__device__ __forceinline__ unsigned pack2(float a, float b) { return (unsigned)f2bf(a) | ((unsigned)f2bf(b) << 16); }
__device__ __forceinline__ float bflo(unsigned u) { return __uint_as_float(u << 16); }
__device__ __forceinline__ float bfhi(unsigned u) { return __uint_as_float(u & 0xffff0000u); }
__device__ __forceinline__ float sigmoidf_(float x) { return __builtin_amdgcn_rcpf(1.f + __expf(-x)); }
__device__ __forceinline__ float gelu_tanh(float x) {
  float y = 0.7978845608028654f * (x + 0.044715f * x * x * x);
  float t = 1.f - 2.f * __builtin_amdgcn_rcpf(1.f + __expf(2.f * y));
  return 0.5f * x * (1.f + t);
}
__device__ __forceinline__ bf16x8 u4_to_frag(uint4 u) {
  union { uint4 u; bf16x8 f; } c; c.u = u; return c.f;
}
template <class T>
__device__ __forceinline__ T* launder(T* p) { asm volatile("" : "+s"(p)); return p; }
__device__ __forceinline__ int opaque(int v) { asm volatile("" : "+v"(v)); return v; }
__device__ __forceinline__ int bidx() { int v = blockIdx.x; asm volatile("" : "+s"(v)); return v; }
__device__ __forceinline__ int gdim() { int v = gridDim.x; asm volatile("" : "+s"(v)); return v; }
__device__ __forceinline__ int tidx() { int v = threadIdx.x; asm volatile("" : "+v"(v)); return v; }
__device__ __forceinline__ float wsum(float v) {
#pragma unroll
  for (int o = 32; o >= 1; o >>= 1) v += __shfl_xor(v, o);
  return v;
}


#define XB_TMO      128
#define XB_XCNT(j)  (256  + 64 * (j))
#define XB_XSUB(j)  (1280 + 64 * (j))
#define XB_XGEN(j)  (2304 + 64 * (j))
#define XB_TOP      3328
#define XB_TOPGEN   3392
#define XCD_BAR_WORDS 3456
#define XB_SPIN_CAP (1u << 20)
#define LAS __attribute__((address_space(3)))
__device__ __forceinline__ unsigned xb_ld(unsigned* p)              { return __hip_atomic_load(p, __ATOMIC_RELAXED, __HIP_MEMORY_SCOPE_AGENT); }
__device__ __forceinline__ unsigned xb_add(unsigned* p, unsigned v) { return __hip_atomic_fetch_add(p, v, __ATOMIC_RELAXED, __HIP_MEMORY_SCOPE_AGENT); }
__device__ __forceinline__ unsigned xb_xcc_id() { return (unsigned)__builtin_amdgcn_s_getreg((3 << 11) | 20) & 0xFu; }
#define XB_SPIN(cond, bar) do { unsigned _sp = 0; while (cond) { __builtin_amdgcn_s_sleep(1); \
    if ((++_sp & 255u) == 0u) { if (xb_ld(&(bar)[XB_TMO])) break; if (_sp > XB_SPIN_CAP) { atomicAdd(&(bar)[XB_TMO], 1u); break; } } } } while (0)
struct XcdBarrier { unsigned* bar; unsigned x; volatile LAS unsigned* st; };
__device__ __forceinline__ XcdBarrier xcd_barrier_post(unsigned* bar, volatile LAS unsigned* st) {
    XcdBarrier b; b.bar = bar; b.x = xb_xcc_id(); b.st = st;
    if (threadIdx.x == 0) (void)xb_add(&bar[XB_XCNT(b.x)], 1u);
    return b;
}
__device__ __forceinline__ void xcd_barrier_complete(unsigned* bar, unsigned x, unsigned& nloc, unsigned& nx) {
    const unsigned G = gridDim.x * gridDim.y * gridDim.z;
    unsigned sum, cnt, mine, sp = 0u;
    for (;;) {
        sum = 0u; cnt = 0u; mine = 0u;
#pragma unroll
        for (unsigned j = 0; j < 16; ++j) { const unsigned c = xb_ld(&bar[XB_XCNT(j)]); sum += c; cnt += (c > 0u) ? 1u : 0u; mine = (j == x) ? c : mine; }
        if (sum == G) break;
        __builtin_amdgcn_s_sleep(1);
        if ((++sp & 255u) == 0u) { if (xb_ld(&bar[XB_TMO])) break; if (sp > XB_SPIN_CAP) { atomicAdd(&bar[XB_TMO], 1u); break; } }
    }
    nloc = mine > 0u ? mine : 1u; nx = cnt > 0u ? cnt : 1u;
}
__device__ __forceinline__ void xcd_barrier(const XcdBarrier& b) {
    asm volatile("s_waitcnt vmcnt(0)" ::: "memory");
    __syncthreads();
    if (threadIdx.x == 0) {
        unsigned* bar = b.bar;
        __builtin_amdgcn_s_waitcnt(0);
        unsigned nloc = b.st[0], nx = b.st[1];
        if (nloc == 0u) { xcd_barrier_complete(bar, b.x, nloc, nx); b.st[0] = nloc; b.st[1] = nx; }
        const unsigned old = xb_add(&bar[XB_XSUB(b.x)], 1u);
        const unsigned gen = old / nloc;
        if (old + 1u == (gen + 1u) * nloc) {
            __builtin_amdgcn_fence(__ATOMIC_RELEASE, "agent");
            asm volatile("s_waitcnt vmcnt(0)" ::: "memory");
            const unsigned og = xb_add(&bar[XB_TOP], 1u);
            const unsigned tg = og / nx;
            if (og + 1u == (tg + 1u) * nx) xb_add(&bar[XB_TOPGEN], 1u);
            else XB_SPIN(xb_ld(&bar[XB_TOPGEN]) == tg, bar);
            __builtin_amdgcn_fence(__ATOMIC_ACQUIRE, "agent");
            xb_add(&bar[XB_XGEN(b.x)], 1u);
            asm volatile("s_waitcnt vmcnt(0)" ::: "memory");
        } else {
            XB_SPIN(xb_ld(&bar[XB_XGEN(b.x)]) == gen, bar);
            __builtin_amdgcn_fence(__ATOMIC_ACQUIRE, "agent");
            asm volatile("s_waitcnt vmcnt(0)" ::: "memory");
        }
    }
    __syncthreads();
}

__device__ __forceinline__ void gemm_compute_stage(f32x16 (&acc)[2][2], const bf16* Ac, const bf16* Bc, int wm, int wn, int lane) {
#pragma unroll
  for (int kk = 0; kk < 4; kk++) {
    bf16x8 a[2], b[2];
#pragma unroll
    for (int mi = 0; mi < 2; mi++) a[mi] = *(const bf16x8*)(Ac + (wm * 64 + mi * 32 + (lane & 31)) * LDS_ROW + kk * 16 + (lane >> 5) * 8);
#pragma unroll
    for (int ni = 0; ni < 2; ni++) b[ni] = *(const bf16x8*)(Bc + (wn * 64 + ni * 32 + (lane & 31)) * LDS_ROW + kk * 16 + (lane >> 5) * 8);
#pragma unroll
    for (int mi = 0; mi < 2; mi++)
#pragma unroll
      for (int ni = 0; ni < 2; ni++) acc[mi][ni] = __builtin_amdgcn_mfma_f32_32x32x16_bf16(a[mi], b[ni], acc[mi][ni], 0, 0, 0);
  }
}

template <class AL, class BL>
__device__ __forceinline__ void gemm_kloop(f32x16 (&acc)[2][2], AL aload, BL bload, int kt0, int nkt, bf16* smem) {
  const int tid = tidx(), lane = tid & 63, w = tid >> 6;
  const int wm = w >> 1, wn = w & 1;
  const int lr = tid >> 3, lc = tid & 7;
  uint4 a0[4], b0[4], a1[4], b1[4];
  bf16* const buf0 = smem;
  bf16* const buf1 = smem + 2 * STAGE_ELEMS;
#define KL_LOAD(A_, B_, st) { _Pragma("unroll") for (int i = 0; i < 4; i++) { A_[i] = aload(lr + 32 * i, (kt0 + (st)) * 8 + lc); B_[i] = bload(lr + 32 * i, (kt0 + (st)) * 8 + lc); } }
#define KL_STORE(A_, B_, buf) { _Pragma("unroll") for (int i = 0; i < 4; i++) { \
    *(uint4*)((buf) + (lr + 32 * i) * LDS_ROW + lc * 8) = A_[i]; *(uint4*)((buf) + STAGE_ELEMS + (lr + 32 * i) * LDS_ROW + lc * 8) = B_[i]; } }
  KL_LOAD(a0, b0, 0)
  KL_STORE(a0, b0, buf0)
  if (nkt > 1) KL_LOAD(a0, b0, 1)
  if (nkt > 2) KL_LOAD(a1, b1, 2)
  __syncthreads();
  int kt = 0;
  for (; kt + 4 < nkt; kt += 2) {
    KL_STORE(a0, b0, buf1)
    KL_LOAD(a0, b0, kt + 3)
    gemm_compute_stage(acc, buf0, buf0 + STAGE_ELEMS, wm, wn, lane);
    __syncthreads();
    KL_STORE(a1, b1, buf0)
    KL_LOAD(a1, b1, kt + 4)
    gemm_compute_stage(acc, buf1, buf1 + STAGE_ELEMS, wm, wn, lane);
    __syncthreads();
  }
  for (; kt < nkt; kt += 2) {
    if (kt + 1 < nkt) KL_STORE(a0, b0, buf1)
    if (kt + 3 < nkt) KL_LOAD(a0, b0, kt + 3)
    gemm_compute_stage(acc, buf0, buf0 + STAGE_ELEMS, wm, wn, lane);
    __syncthreads();
    if (kt + 1 >= nkt) break;
    if (kt + 2 < nkt) KL_STORE(a1, b1, buf0)
    if (kt + 4 < nkt) KL_LOAD(a1, b1, kt + 4)
    gemm_compute_stage(acc, buf1, buf1 + STAGE_ELEMS, wm, wn, lane);
    __syncthreads();
  }
#undef KL_LOAD
#undef KL_STORE
}

#define TL_ROW 40
#define TL_STAGE (384 * TL_ROW)
__device__ __forceinline__ void gemm_tall_compute(f32x16 (&acc)[2][2][2], const bf16* St, int wm, int wn, int lane) {
  const bf16* Ac = St; const bf16* Bc = St + 256 * TL_ROW;
#pragma unroll
  for (int kk = 0; kk < 2; kk++) {
    bf16x8 a[2][2], b[2];
#pragma unroll
    for (int h = 0; h < 2; h++)
#pragma unroll
      for (int mi = 0; mi < 2; mi++) a[h][mi] = *(const bf16x8*)(Ac + (h * 128 + wm * 64 + mi * 32 + (lane & 31)) * TL_ROW + kk * 16 + (lane >> 5) * 8);
#pragma unroll
    for (int ni = 0; ni < 2; ni++) b[ni] = *(const bf16x8*)(Bc + (wn * 64 + ni * 32 + (lane & 31)) * TL_ROW + kk * 16 + (lane >> 5) * 8);
#pragma unroll
    for (int h = 0; h < 2; h++)
#pragma unroll
      for (int mi = 0; mi < 2; mi++)
#pragma unroll
        for (int ni = 0; ni < 2; ni++) acc[h][mi][ni] = __builtin_amdgcn_mfma_f32_32x32x16_bf16(a[h][mi], b[ni], acc[h][mi][ni], 0, 0, 0);
  }
}
template <class AL, class BL>
__device__ __forceinline__ void gemm_kloop_tall(f32x16 (&acc)[2][2][2], AL aload, BL bload, int nkt, bf16* smem) {
  const int tid = tidx(), lane = tid & 63, w = tid >> 6;
  const int wm = w >> 1, wn = w & 1;
  const int lr = tid >> 2, lc = tid & 3;
  uint4 a0[4], b0[2], a1[4], b1[2];
  bf16* const buf0 = smem;
  bf16* const buf1 = smem + TL_STAGE;
#define TL_LOAD(A_, B_, st) { _Pragma("unroll") for (int i = 0; i < 4; i++) A_[i] = aload(lr + 64 * i, (st) * 4 + lc); \
                              _Pragma("unroll") for (int i = 0; i < 2; i++) B_[i] = bload(lr + 64 * i, (st) * 4 + lc); }
#define TL_STORE(A_, B_, buf) { _Pragma("unroll") for (int i = 0; i < 4; i++) *(uint4*)((buf) + (lr + 64 * i) * TL_ROW + lc * 8) = A_[i]; \
                                _Pragma("unroll") for (int i = 0; i < 2; i++) *(uint4*)((buf) + (256 + lr + 64 * i) * TL_ROW + lc * 8) = B_[i]; }
  TL_LOAD(a0, b0, 0)
  TL_STORE(a0, b0, buf0)
  if (nkt > 1) TL_LOAD(a0, b0, 1)
  if (nkt > 2) TL_LOAD(a1, b1, 2)
  __syncthreads();
  int kt = 0;
  for (; kt + 4 < nkt; kt += 2) {
    TL_STORE(a0, b0, buf1)
    TL_LOAD(a0, b0, kt + 3)
    gemm_tall_compute(acc, buf0, wm, wn, lane);
    __syncthreads();
    TL_STORE(a1, b1, buf0)
    TL_LOAD(a1, b1, kt + 4)
    gemm_tall_compute(acc, buf1, wm, wn, lane);
    __syncthreads();
  }
  for (; kt < nkt; kt += 2) {
    if (kt + 1 < nkt) TL_STORE(a0, b0, buf1)
    if (kt + 3 < nkt) TL_LOAD(a0, b0, kt + 3)
    gemm_tall_compute(acc, buf0, wm, wn, lane);
    __syncthreads();
    if (kt + 1 >= nkt) break;
    if (kt + 2 < nkt) TL_STORE(a1, b1, buf0)
    if (kt + 4 < nkt) TL_LOAD(a1, b1, kt + 4)
    gemm_tall_compute(acc, buf1, wm, wn, lane);
    __syncthreads();
  }
#undef TL_LOAD
#undef TL_STORE
}

template <class AL, class BL>
__device__ __forceinline__ void gemm_kloop_light(f32x16 (&acc)[2][2], AL aload, BL bload, int kt0, int nkt, bf16* smem) {
  const int tid = tidx(), lane = tid & 63, w = tid >> 6;
  const int wm = w >> 1, wn = w & 1;
  const int lr = tid >> 3, lc = tid & 7;
  uint4 a0[4], b0[4];
#define KL_LOAD(A_, B_, st) { _Pragma("unroll") for (int i = 0; i < 4; i++) { A_[i] = aload(lr + 32 * i, (kt0 + (st)) * 8 + lc); B_[i] = bload(lr + 32 * i, (kt0 + (st)) * 8 + lc); } }
#define KL_STORE(A_, B_, buf) { _Pragma("unroll") for (int i = 0; i < 4; i++) { \
    *(uint4*)((buf) + (lr + 32 * i) * LDS_ROW + lc * 8) = A_[i]; *(uint4*)((buf) + STAGE_ELEMS + (lr + 32 * i) * LDS_ROW + lc * 8) = B_[i]; } }
  KL_LOAD(a0, b0, 0)
  KL_STORE(a0, b0, smem)
  if (nkt > 1) KL_LOAD(a0, b0, 1)
  __syncthreads();
  for (int kt = 0; kt < nkt; kt++) {
    bf16* cur = smem + (kt & 1) * 2 * STAGE_ELEMS;
    bf16* nxt = smem + ((kt + 1) & 1) * 2 * STAGE_ELEMS;
    if (kt + 1 < nkt) KL_STORE(a0, b0, nxt)
    if (kt + 2 < nkt) KL_LOAD(a0, b0, kt + 2)
    gemm_compute_stage(acc, cur, cur + STAGE_ELEMS, wm, wn, lane);
    __syncthreads();
  }
#undef KL_LOAD
#undef KL_STORE
}

__device__ __forceinline__ void zero_acc(f32x16 (&acc)[2][2]) {
#pragma unroll
  for (int mi = 0; mi < 2; mi++)
#pragma unroll
    for (int ni = 0; ni < 2; ni++)
#pragma unroll
      for (int r = 0; r < 16; r++) acc[mi][ni][r] = 0.f;
}

#define EPI_ROW(mi, r) (erb + (mi) * 32 + ((r) & 3) + 8 * ((r) >> 2))
#define EPI_BASE int erb = opaque(wm * 64 + 4 * (lane >> 5));
#define EPI_COL(ni) (wn * 64 + (ni) * 32 + (lane & 31))
#define EPI_VARS const int lane = tidx() & 63, w = tidx() >> 6, wm = w >> 1, wn = w & 1;


#define CS_LD 132
template <class F>
__device__ __forceinline__ void epi_rowmajor(const f32x16 (&acc)[2][2], bf16* smem, F f) {
  const int tid = tidx(), lane = tid & 63, w = tid >> 6, wm = w >> 1, wn = w & 1;
  float* Cs = (float*)smem;
#pragma unroll
  for (int mi = 0; mi < 2; mi++)
#pragma unroll
    for (int ni = 0; ni < 2; ni++)
#pragma unroll
      for (int r = 0; r < 16; r++) {
        int row = wm * 64 + mi * 32 + (r & 3) + 8 * (r >> 2) + 4 * (lane >> 5), col = wn * 64 + ni * 32 + (lane & 31);
        Cs[row * CS_LD + col] = acc[mi][ni][r];
      }
  __syncthreads();
#pragma unroll
  for (int it = 0; it < 8; it++) {
    int ch = tid + 256 * it;
    int row = ch >> 4, c8 = (ch & 15) * 8;
    float4 a = *(const float4*)(Cs + row * CS_LD + c8), b = *(const float4*)(Cs + row * CS_LD + c8 + 4);
    float v[8] = {a.x, a.y, a.z, a.w, b.x, b.y, b.z, b.w};
    f(row, c8, v);
  }
  __syncthreads();
}


__device__ __forceinline__ bool tile_swz(int t, int NT, int& mt, int& nt) {
  const int SN = (NT + 7) >> 3;
  {
    const int full = (16 * SN / 8) * 512;
    if ((16 * SN) % 8 == 0 && t >= full) {
      const int x8 = t & 7, jl = (t - full) >> 3;
      mt = 128 + x8; nt = jl;
      return jl < NT;
    }
  }
  const int x = t & 7, q = t >> 3;
  const int sidx = (q >> 6) * 8 + x, loc = q & 63;
  const int sm = sidx / SN, sn = sidx - sm * SN;
  mt = sm * 8 + (loc >> 3); nt = sn * 8 + (loc & 7);
  return (mt < 136) && (nt < NT);
}
#define SWZ_TOTAL(NT) (((17 * (((NT) + 7) >> 3) + 7) >> 3) * 512)

__device__ __forceinline__ void transpose_tile(const float* __restrict__ src, int ldsrc, bf16* __restrict__ dst, int lddst, int k0, int n0, float* lds) {
  const int tid = tidx();
  const int tx = tid & 15, ty = tid >> 4;
#pragma unroll
  for (int i = 0; i < 4; i++) {
    int k = ty + 16 * i;
    float4 v = *(const float4*)(src + (size_t)(k0 + k) * ldsrc + n0 + tx * 4);
    lds[k * 65 + tx * 4 + 0] = v.x; lds[k * 65 + tx * 4 + 1] = v.y; lds[k * 65 + tx * 4 + 2] = v.z; lds[k * 65 + tx * 4 + 3] = v.w;
  }
  __syncthreads();
#pragma unroll
  for (int i = 0; i < 2; i++) {
    int ch = tid + 256 * i;
    int n = ch >> 3, kc = (ch & 7) * 8;
    uint4 o;
    o.x = pack2(lds[(kc + 0) * 65 + n], lds[(kc + 1) * 65 + n]); o.y = pack2(lds[(kc + 2) * 65 + n], lds[(kc + 3) * 65 + n]);
    o.z = pack2(lds[(kc + 4) * 65 + n], lds[(kc + 5) * 65 + n]); o.w = pack2(lds[(kc + 6) * 65 + n], lds[(kc + 7) * 65 + n]);
    *(uint4*)(dst + (size_t)(n0 + n) * lddst + k0 + kc) = o;
  }
  __syncthreads();
}

__device__ __forceinline__ void transpose_job(const float* src, bf16* dst, int K, int N, int batch, float* lds, int jb, int jn) {
  const int tk = K / 64, tn = N / 64;
  const int ntiles = tk * tn * batch;
  for (int t = jb; t < ntiles; t += jn) {
    int b = t / (tk * tn), r = t % (tk * tn);
    int kt = r / tn, nt = r % tn;
    transpose_tile(src + (size_t)b * K * N, N, dst + (size_t)b * K * N, K, kt * 64, nt * 64, lds);
  }
}

__device__ __forceinline__ void convert_job(const float* __restrict__ src, bf16* __restrict__ dst, size_t n, int jb, int jn) {
  size_t n8 = n / 8;
#pragma unroll 4
  for (size_t i = (size_t)jb * 256 + tidx(); i < n8; i += (size_t)jn * 256) {
    float4 a = ((const float4*)src)[2 * i], b = ((const float4*)src)[2 * i + 1];
    uint4 o;
    o.x = pack2(a.x, a.y); o.y = pack2(a.z, a.w); o.z = pack2(b.x, b.y); o.w = pack2(b.z, b.w);
    ((uint4*)dst)[i] = o;
  }
}

__device__ __forceinline__ void convert_fp8_job(const float* __restrict__ src, unsigned char* __restrict__ dst, size_t n, float scale, int jb, int jn) {
  size_t n16 = n / 16;
#pragma unroll 2
  for (size_t i = (size_t)jb * 256 + tidx(); i < n16; i += (size_t)jn * 256) {
    const float4* sp = (const float4*)src + 4 * i;
    unsigned o[4];
#pragma unroll
    for (int q = 0; q < 4; q++) {
      float4 a = sp[q];
      float f0 = fminf(fmaxf(a.x * scale, -448.f), 448.f), f1 = fminf(fmaxf(a.y * scale, -448.f), 448.f);
      float f2 = fminf(fmaxf(a.z * scale, -448.f), 448.f), f3 = fminf(fmaxf(a.w * scale, -448.f), 448.f);
      int wv = 0;
      wv = __builtin_amdgcn_cvt_pk_fp8_f32(f0, f1, wv, false);
      wv = __builtin_amdgcn_cvt_pk_fp8_f32(f2, f3, wv, true);
      o[q] = (unsigned)wv;
    }
    ((uint4*)dst)[i] = make_uint4(o[0], o[1], o[2], o[3]);
  }
}

__device__ __forceinline__ bool light_block(int heavy_x, int& jb, int& jn) {
  const int b = bidx(), g = gdim();
  if ((g & 7) || g < 128) { jb = b; jn = g; return true; }
  {
    const int nh = heavy_x == 1 ? 8 : 16;
    const int jl = b >> 3;
    jn = ((g >> 3) - nh) * 8;
    jb = (jl - nh) * 8 + (b & 7);
    return jl >= nh;
  }
  const int x = b & 7;
  jn = (g >> 3) * (8 - heavy_x);
  jb = (b >> 3) * (8 - heavy_x) + (x - heavy_x);
  return x >= heavy_x;
}

__device__ __forceinline__ void wqk_job(const float* __restrict__ wq, const float* __restrict__ keys, bf16* __restrict__ dst, float* lds, int jb, int jn) {
  float* Ks = lds;
  float* Ws = lds + 64 * 129;
  const int tid = tidx();
  for (int t = jb; t < 32 * 16; t += jn) {
    int n0 = (t / 16) * 64, k0 = (t % 16) * 64;
    int hs = n0 / 128, key0 = n0 % 128;
    for (int i = tid; i < 64 * 128; i += 256) {
      int r = i / 128, d = i % 128;
      Ks[r * 129 + d] = keys[((size_t)hs * 128 + key0 + r) * 128 + d];
      Ws[r * 129 + d] = wq[(size_t)(k0 + r) * 2048 + hs * 128 + d];
    }
    __syncthreads();
    int tx = tid & 15, ty = tid >> 4;
    float acc[4][4];
#pragma unroll
    for (int i = 0; i < 4; i++)
#pragma unroll
      for (int j = 0; j < 4; j++) acc[i][j] = 0.f;
    for (int d = 0; d < 128; d++) {
      float kv[4], wv[4];
#pragma unroll
      for (int i = 0; i < 4; i++) { kv[i] = Ks[(ty * 4 + i) * 129 + d]; wv[i] = Ws[(tx * 4 + i) * 129 + d]; }
#pragma unroll
      for (int i = 0; i < 4; i++)
#pragma unroll
        for (int j = 0; j < 4; j++) acc[i][j] += kv[i] * wv[j];
    }
#pragma unroll
    for (int i = 0; i < 4; i++) {
      uint2 o; o.x = pack2(acc[i][0], acc[i][1]); o.y = pack2(acc[i][2], acc[i][3]);
      *(uint2*)(dst + (size_t)(n0 + ty * 4 + i) * 1024 + k0 + tx * 4) = o;
    }
    __syncthreads();
  }
}

__device__ __forceinline__ void ssm_tables(KP P, int li, float* lds, int jb, int jn) {
  const float* lam_re = P->in[I_LRE] + li * 1024;
  const float* lam_im = P->in[I_LIM] + li * 1024;
  const float* b_re = P->in[I_BRE] + (size_t)li * 16 * 64 * 16;
  const float* b_im = P->in[I_BIM] + (size_t)li * 16 * 64 * 16;
  const float* c_re = P->in[I_CRE] + (size_t)li * 16 * 16 * 64;
  const float* c_im = P->in[I_CIM] + (size_t)li * 16 * 16 * 64;
  const float* log_dt = P->in[I_LDT] + li * 16;
  bf16* Tt = (bf16*)(P->ws + W_TT);
  bf16* Bst = (bf16*)(P->ws + W_BST);
  float* wr = lds; float* wi = lds + 64;
  const int tid = tidx();
  const int NT1 = 16 * 64, NT2 = 16 * 64, NT3 = 16 * 64;
  for (int t = jb; t < NT1 + NT2 + NT3; t += jn) {
    int kind, g, idx;
    if (t < NT1) { kind = 0; g = t / 64; idx = t % 64; }
    else if (t < NT1 + NT2) { kind = 1; g = (t - NT1) / 64; idx = (t - NT1) % 64; }
    else { kind = 2; g = (t - NT1 - NT2) / 64; idx = (t - NT1 - NT2) % 64; }
    int d = (kind == 0) ? idx : (kind == 1 ? idx + 1 : 63 - idx);
    const bool need_coef = (kind != 1);
    if (tid < 64) {
      int n = tid;
      float dt = expf(log_dt[g]);
      float lr = lam_re[g * 64 + n], lim = lam_im[g * 64 + n];
      float ar = lr * dt, ai = lim * dt;
      float dd = (float)(d < 0 ? 0 : d);
      float mag = expf(ar * dd);
      float sn, cs;
      sincosf(ai * dd, &sn, &cs);
      float pr = mag * cs, pi = mag * sn;
      if (need_coef) {
        float m1 = expf(ar); float s1, c1; sincosf(ai, &s1, &c1);
        float nr = m1 * c1 - 1.f, ni = m1 * s1;
        float den = lr * lr + lim * lim;
        float cr = (nr * lr + ni * lim) / den, ci = (ni * lr - nr * lim) / den;
        float xr = pr * cr - pi * ci, xi = pr * ci + pi * cr;
        pr = xr; pi = xi;
      }
      wr[n] = pr; wi[n] = pi;
    }
    __syncthreads();
    if (kind == 0) {
      int p = tid >> 4, q = tid & 15;
      if (d >= 0) {
        float* lcr = lds + 128; float* lci = lcr + 1024; float* lbr = lci + 1024; float* lbi = lbr + 1024;
        for (int i = tid; i < 1024; i += 256) {
          lcr[i] = c_re[(size_t)g * 1024 + i]; lci[i] = c_im[(size_t)g * 1024 + i];
          lbr[i] = b_re[(size_t)g * 1024 + i]; lbi[i] = b_im[(size_t)g * 1024 + i];
        }
        __syncthreads();
        float s = 0.f;
#pragma unroll 8
        for (int n = 0; n < 64; n++) {
          float cr = lcr[p * 64 + n], ci = lci[p * 64 + n];
          float xr = cr * wr[n] - ci * wi[n], xi = cr * wi[n] + ci * wr[n];
          float br = lbr[n * 16 + q], bi = lbi[n * 16 + q];
          s += xr * br - xi * bi;
        }
        Tt[(((size_t)g * 64 + d) * 16 + p) * 16 + q] = f2bf(s);
      }
    } else if (kind == 1) {
      int tt = idx;
      for (int i = tid; i < 2048; i += 256) {
        int p = i >> 7, nn = i & 127, n = nn >> 1, ri = nn & 1;
        float cr = c_re[((size_t)g * 16 + p) * 64 + n], ci = c_im[((size_t)g * 16 + p) * 64 + n];
        float v = ri == 0 ? (cr * wr[n] - ci * wi[n]) : -(cr * wi[n] + ci * wr[n]);
        Tt[KERN_ELEMS + ((size_t)g * 1024 + tt * 16 + p) * 128 + nn] = f2bf(v);
      }
    } else {
      int ss = idx;
      for (int i = tid; i < 2048; i += 256) {
        int nn = i >> 4, q = i & 15, n = nn >> 1, ri = nn & 1;
        float br = b_re[((size_t)g * 64 + n) * 16 + q], bi = b_im[((size_t)g * 64 + n) * 16 + q];
        float v = ri == 0 ? (wr[n] * br - wi[n] * bi) : (wr[n] * bi + wi[n] * br);
        Bst[((size_t)g * 128 + nn) * 1024 + ss * 16 + q] = f2bf(v);
      }
    }
    __syncthreads();
  }
}

__device__ __forceinline__ void pro_misc(KP P, int li, float* lds, int jb, int jn) {
  unsigned char* ws = P->ws;
  transpose_job(P->in[I_WIN] + (size_t)li * 1024 * 5888, (bf16*)(ws + W_IN), 1024, 5888, 1, lds, jb, jn);
  transpose_job(P->in[I_WBS] + (size_t)li * 256 * 1024, (bf16*)(ws + W_BRS), 256, 1024, 1, lds, jb, jn);
  transpose_job(P->in[I_WBA] + (size_t)li * 512 * 1024, (bf16*)(ws + W_BRA), 512, 1024, 1, lds, jb, jn);
  transpose_job(P->in[I_WBR] + (size_t)li * 256 * 1024, (bf16*)(ws + W_BRR), 256, 1024, 1, lds, jb, jn);
  transpose_job(P->in[I_WO] + (size_t)li * 1024 * 1024, (bf16*)(ws + W_O), 1024, 1024, 1, lds, jb, jn);
  transpose_job(P->in[I_WGLU] + (size_t)li * 256 * 256, (bf16*)(ws + W_GLU), 256, 256, 1, lds, jb, jn);
  wqk_job(P->in[I_WQ] + (size_t)li * 1024 * 2048, P->in[I_KEYS] + (size_t)li * 16 * 128 * 128, (bf16*)(ws + W_QK), lds, jb, jn);
  ssm_tables(P, li, lds, jb, jn);
}
__device__ __forceinline__ void pro_cache(KP P, int li, float* lds, int jb, int jn) {
  unsigned char* ws = P->ws;
  transpose_job(P->in[I_CV] + (size_t)li * 16 * 512 * 512, (bf16*)(ws + W_CVT), 512, 512, 16, lds, jb, jn);
  convert_job(P->in[I_CK] + (size_t)li * 16 * 512 * 512, (bf16*)(ws + W_CK), 16ull * 512 * 512, jb, jn);
}

__device__ __forceinline__ void phase_prologue(KP P, int li, bf16* smem) {
  float* lds = (float*)smem;
  unsigned char* ws = P->ws;
  pro_misc(P, li, lds, bidx(), gdim());
  pro_cache(P, li, lds, bidx(), gdim());
  if (li == 0) {
    convert_job(P->in[I_XP], (bf16*)(ws + W_X), (size_t)NPTOK * 1024, bidx(), gdim());
    convert_job(P->in[I_XS], (bf16*)(ws + W_X) + (size_t)NPTOK * 1024, 1024ull * 1024, bidx(), gdim());
    float2* rope = (float2*)(ws + W_ROPE);
    for (int i = bidx() * 256 + tidx(); i < 4096 * 32; i += gdim() * 256) {
      int pos = i >> 5, j = i & 31;
      float freq = expf(-(float)j * (9.210340371976184f / 32.f));
      float ang = (float)pos * freq;
      float sn, cs; sincosf(ang, &sn, &cs);
      rope[i] = make_float2(cs, sn);
    }
  }
}

__device__ __forceinline__ void phase_gemm_in(KP P, int li, bf16* smem) {
  EPI_VARS
  const bf16* X = (const bf16*)(P->ws + W_X);
  const bf16* Wt = (const bf16*)(P->ws + W_IN);
  bf16* H = (bf16*)(P->ws + W_H);
  bf16* HT = (bf16*)(P->ws + W_HT);
  const float2* rope = (const float2*)(P->ws + W_ROPE);
  float* out = P->out;
  for (int t = bidx(); t < 7 * 512; t += gdim()) {
    const int x_ = t & 7, q_ = t >> 3;
    const int loc_ = q_ & 63;
    const int sidx_ = ((q_ >> 6) * 8 + x_) * 2 + (loc_ >> 5);
    if (sidx_ >= 17 * 6) continue;
    const int sm_ = sidx_ / 6, sn_ = sidx_ - sm_ * 6;
    const int mt2 = sm_ * 4 + ((loc_ & 31) >> 3), nt = sn_ * 8 + (loc_ & 7);
    if (nt >= 46) continue;
    const int n0 = nt * 128;
    f32x16 acc2[2][2][2];
    zero_acc(acc2[0]); zero_acc(acc2[1]);
    {
      const bf16* Ab = X + (size_t)mt2 * 256 * 1024;
      const bf16* Bb = Wt + (size_t)n0 * 1024;
      gemm_kloop_tall(acc2,
        [&](int r, int kc) { return *(const uint4*)(Ab + (size_t)r * 1024 + kc * 8); },
        [&](int r, int kc) { return *(const uint4*)(Bb + (size_t)r * 1024 + kc * 8); }, 32, smem);
    }
   auto epilogue = [&](f32x16 (&acc)[2][2], const int m0) {
    EPI_BASE
    const int cb = n0 + wn * 64;
    if (cb >= C_QRET && cb < C_VRET) {
      const float sc = (cb < C_KRET) ? 0.125f : 1.f;
#pragma unroll
      for (int mi = 0; mi < 2; mi++)
#pragma unroll
        for (int r = 0; r < 16; r++) {
          int row = m0 + EPI_ROW(mi, r);
          int pos = row < NPTOK ? (row & 4095) : 2048 + ((row - NPTOK) & 63);
          float2 cs = rope[pos * 32 + (lane & 31)];
          float x1 = acc[mi][0][r], x2 = acc[mi][1][r];
          acc[mi][0][r] = (x1 * cs.x - x2 * cs.y) * sc;
          acc[mi][1][r] = (x1 * cs.y + x2 * cs.x) * sc;
        }
    }
    if (cb >= C_KATT && cb < C_QRET) {
      const bool isv = cb >= C_VATT;
      const int c0 = isv ? C_VATT : C_KATT;
#pragma unroll
      for (int mi = 0; mi < 2; mi++)
#pragma unroll
        for (int r = 0; r < 16; r++) {
          int row = m0 + EPI_ROW(mi, r);
#pragma unroll
          for (int ni = 0; ni < 2; ni++) {
            int col = n0 + EPI_COL(ni) - c0;
            if (row < NPTOK) {
              int b = row >> 12, tt = row & 4095;
              if (tt >= 3584) out[(isv ? O_AV_P : O_AK_P) + (((size_t)(li * 4 + b) * 512 + (tt - 3584)) * 512 + col)] = acc[mi][ni][r];
            } else {
              int rs = row - NPTOK;
              out[(isv ? O_AV_S : O_AK_S) + ((size_t)li * 1024 + rs) * 512 + col] = acc[mi][ni][r];
            }
          }
        }
    }
    int trow = -1;
    if (cb >= C_VATT && cb < C_QRET) trow = cb - C_VATT;
    else if (cb >= C_KRET && cb < C_VRET) trow = 512 + cb - C_KRET;
    else if (cb >= C_VRET && cb < C_GRET) trow = 768 + cb - C_VRET;
    if (trow >= 0) {
#pragma unroll
      for (int mi = 0; mi < 2; mi++)
#pragma unroll
        for (int ni = 0; ni < 2; ni++)
#pragma unroll
          for (int rg = 0; rg < 4; rg++) {
            int rowb = m0 + wm * 64 + mi * 32 + 8 * rg + 4 * (lane >> 5);
            uint2 o; o.x = pack2(acc[mi][ni][rg * 4], acc[mi][ni][rg * 4 + 1]); o.y = pack2(acc[mi][ni][rg * 4 + 2], acc[mi][ni][rg * 4 + 3]);
            *(uint2*)(HT + (size_t)(trow + ni * 32 + (lane & 31)) * NTOK + rowb) = o;
          }
    }
    const bool skipH = (n0 >= C_VATT && n0 < C_QRET) || (n0 >= C_VRET && n0 < C_GRET);
    if (!skipH) epi_rowmajor(acc, smem, [&](int row, int c8, float (&v)[8]) {
      uint4 o; o.x = pack2(v[0], v[1]); o.y = pack2(v[2], v[3]); o.z = pack2(v[4], v[5]); o.w = pack2(v[6], v[7]);
      *(uint4*)(H + (size_t)(m0 + row) * INC + n0 + c8) = o;
    });
   };
   epilogue(acc2[0], mt2 * 256);
   epilogue(acc2[1], mt2 * 256 + 128);
  }
}

#define AP_LD 72
__device__ __forceinline__ void attn_item(KP P, int li, int item, bf16* smem) {
  float* bias = (float*)smem;
  bf16* pbuf = smem + 2048;
  const bf16* H = (const bf16*)(P->ws + W_H);
  const bf16* HT = (const bf16*)(P->ws + W_HT);
  bf16* Yatt = (bf16*)(P->ws + W_YATT);
  const int h = item & 7, cidx = item >> 3;
  const float* tab = P->in[I_BIAS] + (size_t)li * 513 * 8;
  const int tid = opaque(tidx());
  const int lane = tid & 63, w = tid >> 6, l15 = lane & 15, g = lane >> 4;
  __syncthreads();
  for (int i = tid; i < 640; i += 256) bias[i] = tab[(min(i - 63, 256) + 256) * 8 + h];
  const int row0 = cidx * 64;
  const bf16* Qp = H + (size_t)(row0 + w * 16) * INC + C_QATT + h * 64;
  const bf16* Kcur = H + (size_t)row0 * INC + C_KATT + h * 64;
  const bf16* VTcur = HT + (size_t)(h * 64) * NTOK + row0;
  bf16* Yout = Yatt + (size_t)(row0 + w * 16) * 512 + h * 64;
  const bf16* Kpast; const bf16* VTpast; int kst; size_t vst; int jt_start, smin;
  if (cidx < 256) {
    int c = cidx & 63;
    jt_start = c >= 8 ? 0 : 32 - 4 * c;
    smin = c >= 8 ? 0 : 8 - c;
    Kpast = Kcur - (ptrdiff_t)512 * INC; kst = INC;
    VTpast = VTcur - 512; vst = NTOK;
  } else {
    int b = cidx - 256;
    jt_start = 0; smin = 0;
    Kpast = (const bf16*)(P->ws + W_CK) + (size_t)b * 512 * 512 + h * 64; kst = 512;
    VTpast = (const bf16*)(P->ws + W_CVT) + (size_t)b * 512 * 512 + (size_t)(h * 64) * 512; vst = 512;
  }
  const int lr = tid >> 2, lc = (tid & 3) * 16;
  bf16x8 qf[2];
#pragma unroll
  for (int ks = 0; ks < 2; ks++) qf[ks] = u4_to_frag(*(const uint4*)(Qp + (size_t)l15 * INC + ks * 32 + g * 8));
  uint4 r0a, r0b, r1a, r1b, r2a, r2b;
#define AP_LOAD(p, va, vb) { const int step_ = ((p) < 9) ? (p) : (p) - 9; const int se_ = max(step_, smin); const bf16* src_; \
    if ((p) < 9) src_ = (se_ < 8) ? (Kpast + (ptrdiff_t)(se_ * 64 + lr) * kst) : (Kcur + (size_t)lr * INC); \
    else src_ = (se_ < 8) ? (VTpast + (size_t)lr * vst + se_ * 64) : (VTcur + (size_t)lr * NTOK); \
    va = *(const uint4*)(src_ + lc); vb = *(const uint4*)(src_ + lc + 8); }
#define AP_STORE(p, va, vb) { bf16* dst_ = pbuf + ((p) & 1) * (64 * AP_LD) + lr * AP_LD + lc; *(uint4*)dst_ = va; *(uint4*)(dst_ + 8) = vb; }
  AP_LOAD(0, r0a, r0b) AP_LOAD(1, r1a, r1b) AP_LOAD(2, r2a, r2b)
  AP_STORE(0, r0a, r0b)
  __syncthreads();
  f32x4 s[36];
#pragma unroll
  for (int p = 0; p < 9; p++) {
    const bf16* pc = pbuf + (p & 1) * (64 * AP_LD);
#pragma unroll
    for (int t = 0; t < 4; t++) {
      const int jt = p * 4 + t;
      s[jt] = f32x4{0.f, 0.f, 0.f, 0.f};
#pragma unroll
      for (int ks = 0; ks < 2; ks++) {
        bf16x8 kf = *(const bf16x8*)(pc + (t * 16 + l15) * AP_LD + ks * 32 + g * 8);
        s[jt] = __builtin_amdgcn_mfma_f32_16x16x32_bf16(kf, qf[ks], s[jt], 0, 0, 0);
      }
    }
    AP_STORE(p + 1, r1a, r1b)
    r1a = r2a; r1b = r2b;
    AP_LOAD(p + 3, r2a, r2b)
    __syncthreads();
  }
  float inv;
  {
    const int iq = w * 16 + l15;
    const float* bq = bias + (iq - 4 * g + 575);
    float mx = -3.0e38f;
#pragma unroll
    for (int jt = 0; jt < 36; jt++) {
#pragma unroll
      for (int r = 0; r < 4; r++) {
        float v = s[jt][r] * 0.125f + bq[-(jt * 16 + r)];
        if (jt < 32) v = (jt < jt_start) ? -3.0e38f : v;
        s[jt][r] = v;
        mx = fmaxf(mx, v);
      }
    }
    mx = fmaxf(mx, __shfl_xor(mx, 16));
    mx = fmaxf(mx, __shfl_xor(mx, 32));
    float sum = 0.f;
#pragma unroll
    for (int jt = 0; jt < 36; jt++) {
#pragma unroll
      for (int r = 0; r < 4; r++) { float e = __expf(s[jt][r] - mx); s[jt][r] = e; sum += e; }
    }
    sum += __shfl_xor(sum, 16);
    sum += __shfl_xor(sum, 32);
    inv = 1.f / sum;
  }
  f32x4 o[4];
#pragma unroll
  for (int et = 0; et < 4; et++) o[et] = f32x4{0.f, 0.f, 0.f, 0.f};
#pragma unroll
  for (int p = 9; p < 18; p++) {
    const bf16* pc = pbuf + (p & 1) * (64 * AP_LD);
    const int step = p - 9;
#pragma unroll
    for (int u = 0; u < 2; u++) {
      const int kk = step * 2 + u;
      union { uint4 u4; bf16x8 f; } pf;
      pf.u4.x = pack2(s[2 * kk][0], s[2 * kk][1]); pf.u4.y = pack2(s[2 * kk][2], s[2 * kk][3]);
      pf.u4.z = pack2(s[2 * kk + 1][0], s[2 * kk + 1][1]); pf.u4.w = pack2(s[2 * kk + 1][2], s[2 * kk + 1][3]);
#pragma unroll
      for (int et = 0; et < 4; et++) {
        const bf16* vp = pc + (et * 16 + l15) * AP_LD + u * 32 + 4 * g;
        union { uint4 u4; bf16x8 f; } vf;
        uint2 a = *(const uint2*)vp, b = *(const uint2*)(vp + 16);
        vf.u4.x = a.x; vf.u4.y = a.y; vf.u4.z = b.x; vf.u4.w = b.y;
        o[et] = __builtin_amdgcn_mfma_f32_16x16x32_bf16(vf.f, pf.f, o[et], 0, 0, 0);
      }
    }
    if (p + 1 < 18) { AP_STORE(p + 1, r1a, r1b) }
    r1a = r2a; r1b = r2b;
    if (p + 3 < 18) { AP_LOAD(p + 3, r2a, r2b) }
    __syncthreads();
  }
#pragma unroll
  for (int et = 0; et < 4; et++) {
    uint2 ov; ov.x = pack2(o[et][0] * inv, o[et][1] * inv); ov.y = pack2(o[et][2] * inv, o[et][3] * inv);
    *(uint2*)(Yout + (size_t)l15 * 512 + et * 16 + 4 * g) = ov;
  }
}

__device__ __forceinline__ void ret_contrib_item(KP P, int item) {
  const bf16* HT = (const bf16*)(P->ws + W_HT);
  float* CT = (float*)(P->ws + W_CT);
  const int h = item & 3, cidx = item >> 2;
  const int lane = opaque(tidx() & 63), w = tidx() >> 6, l15 = lane & 15, g = lane >> 4;
  const float lg2 = log2f(1.f - exp2f(-5.f - (float)h));
  const int tok0 = cidx * 64;
  f32x4 acc[4];
#pragma unroll
  for (int dt = 0; dt < 4; dt++) acc[dt] = f32x4{0.f, 0.f, 0.f, 0.f};
#pragma unroll
  for (int ks = 0; ks < 2; ks++) {
    uint4 vr = *(const uint4*)(HT + (size_t)(768 + h * 64 + w * 16 + l15) * NTOK + tok0 + ks * 32 + g * 8);
    unsigned vv[4] = {vr.x, vr.y, vr.z, vr.w};
    union { uint4 u; bf16x8 f; } vf;
    unsigned oo[4];
#pragma unroll
    for (int q = 0; q < 4; q++) {
      int j = ks * 32 + g * 8 + 2 * q;
      float k0 = exp2f(lg2 * (float)(63 - j)), k1 = exp2f(lg2 * (float)(62 - j));
      oo[q] = pack2(bflo(vv[q]) * k0, bfhi(vv[q]) * k1);
    }
    vf.u = make_uint4(oo[0], oo[1], oo[2], oo[3]);
#pragma unroll
    for (int dt = 0; dt < 4; dt++) {
      bf16x8 kf = u4_to_frag(*(const uint4*)(HT + (size_t)(512 + h * 64 + dt * 16 + l15) * NTOK + tok0 + ks * 32 + g * 8));
      acc[dt] = __builtin_amdgcn_mfma_f32_16x16x32_bf16(vf.f, kf, acc[dt], 0, 0, 0);
    }
  }
#pragma unroll
  for (int dt = 0; dt < 4; dt++)
#pragma unroll
    for (int r = 0; r < 4; r++) {
      int e = w * 16 + 4 * g + r, d = dt * 16 + l15;
      CT[((size_t)(cidx * 4 + h) * 64 + e) * 64 + d] = acc[dt][r];
    }
}

__device__ __forceinline__ void ssm_state_tile(KP P, int t, bf16* smem) {
  EPI_VARS
  const bf16* H = (const bf16*)(P->ws + W_H);
  const bf16* Bst = (const bf16*)(P->ws + W_BST);
  float* SC = (float*)(P->ws + W_SC);
  const int g = t / 3, mt = t % 3;
  const int m0 = mt * 128;
  f32x16 acc[2][2];
  zero_acc(acc);
  const bf16* Bb = Bst + (size_t)g * 128 * 1024;
  gemm_kloop(acc,
    [&](int r, int kc) { int c = min(m0 + r, NCHUNK - 1); int s = kc >> 1, q0 = (kc & 1) * 8;
                         return *(const uint4*)(H + (size_t)(c * 64 + s) * INC + g * 16 + q0); },
    [&](int r, int kc) { return *(const uint4*)(Bb + (size_t)r * 1024 + kc * 8); }, 0, 16, smem);
    EPI_BASE
#pragma unroll
  for (int mi = 0; mi < 2; mi++)
#pragma unroll
    for (int ni = 0; ni < 2; ni++)
#pragma unroll
      for (int r = 0; r < 16; r++) {
        int c = m0 + EPI_ROW(mi, r), nn = EPI_COL(ni);
        if (c < NCHUNK) SC[((size_t)c * 16 + g) * 128 + nn] = acc[mi][ni][r];
      }
}

__device__ __forceinline__ void phase_A(KP P, int li, bf16* smem) {
  const int n_attn = NCHUNK * 8, n_ret = NCHUNK * 4, n_ssm = 48;
  const int total = n_attn + n_ret + n_ssm;
  for (int t = bidx(); t < total; t += gdim()) {
    if (t < n_ssm) ssm_state_tile(P, t, smem);
    else if (t < n_ssm + n_attn) attn_item(P, li, t - n_ssm, smem);
    else ret_contrib_item(P, t - n_ssm - n_attn);
  }
}

__device__ __forceinline__ void phase_B(KP P, int li) {
  const float* CT = (const float*)(P->ws + W_CT);
  bf16* SP = (bf16*)(P->ws + W_SPREV);
  const float* SC = (const float*)(P->ws + W_SC);
  bf16* HS = (bf16*)(P->ws + W_HS);
  float* out = P->out;
  const int gt = bidx() * 256 + tidx(), gn = gdim() * 256;
  for (int i = gt; i < 65536; i += gn) {
    int ed = i & 4095, h = (i >> 12) & 3, b = i >> 14;
    float g64 = exp2f(64.f * log2f(1.f - exp2f(-5.f - (float)h)));
    float S = 0.f;
    for (int c0 = 0; c0 < 64; c0 += 16) {
      float ct[16];
#pragma unroll
      for (int u = 0; u < 16; u++) ct[u] = CT[((size_t)((b * 64 + c0 + u) * 4 + h)) * 4096 + ed];
#pragma unroll
      for (int u = 0; u < 16; u++) {
        SP[((size_t)((b * 64 + c0 + u) * 4 + h)) * 4096 + ed] = f2bf(S);
        S = g64 * S + ct[u];
      }
    }
    int e = ed >> 6, d = ed & 63;
    out[O_RET_P + ((size_t)((li * 4 + b) * 4 + h)) * 4096 + d * 64 + e] = S;
  }
  for (int i = gt; i < 262144; i += gn) {
    int ed = i & 4095, h = (i >> 12) & 3, b = i >> 14;
    int e = ed >> 6, d = ed & 63;
    float g64 = exp2f(64.f * log2f(1.f - exp2f(-5.f - (float)h)));
    size_t sidx = ((size_t)((li * 16 + b) * 4 + h)) * 4096 + d * 64 + e;
    float S = P->in[I_SRET][sidx];
    size_t idx = ((size_t)((256 + b) * 4 + h)) * 4096 + ed;
    SP[idx] = f2bf(S);
    S = g64 * S + CT[idx];
    out[O_RET_S + sidx] = S;
  }
  for (int i = gt; i < 4096 + 16384; i += gn) {
    const bool prompt = i < 4096;
    int j = prompt ? i : i - 4096;
    int n = j & 63, g = (j >> 6) & 15, b = j >> 10;
    float dt = expf(P->in[I_LDT][li * 16 + g]);
    float ar = P->in[I_LRE][li * 1024 + g * 64 + n] * dt, ai = P->in[I_LIM][li * 1024 + g * 64 + n] * dt;
    float mag = expf(ar * 64.f); float sn, cs; sincosf(ai * 64.f, &sn, &cs);
    float a_r = mag * cs, a_i = mag * sn;
    if (prompt) {
      float hr = 0.f, hi = 0.f;
      for (int c0 = 0; c0 < 64; c0 += 16) {
        float2 cc[16];
#pragma unroll
        for (int u = 0; u < 16; u++) cc[u] = *(const float2*)(SC + ((size_t)(b * 64 + c0 + u) * 16 + g) * 128 + n * 2);
#pragma unroll
        for (int u = 0; u < 16; u++) {
          size_t idx = ((size_t)(b * 64 + c0 + u) * 16 + g) * 128 + n * 2;
          *(unsigned*)(HS + idx) = pack2(hr, hi);
          float nr = a_r * hr - a_i * hi + cc[u].x, ni = a_r * hi + a_i * hr + cc[u].y;
          hr = nr; hi = ni;
        }
      }
      out[O_SRE_P + ((size_t)(li * 4 + b) * 16 + g) * 64 + n] = hr;
      out[O_SIM_P + ((size_t)(li * 4 + b) * 16 + g) * 64 + n] = hi;
    } else {
      size_t sidx = ((size_t)(li * 16 + b) * 16 + g) * 64 + n;
      float hr = P->in[I_SRE][sidx], hi = P->in[I_SIM][sidx];
      size_t idx = ((size_t)(256 + b) * 16 + g) * 128 + n * 2;
      *(unsigned*)(HS + idx) = pack2(hr, hi);
      float cr = SC[idx], ci = SC[idx + 1];
      out[O_SRE_S + sidx] = a_r * hr - a_i * hi + cr;
      out[O_SIM_S + sidx] = a_r * hi + a_i * hr + ci;
    }
  }
}

__device__ __forceinline__ void ret_finish_item(KP P, int li, int item) {
  const bf16* H = (const bf16*)(P->ws + W_H);
  const bf16* HT = (const bf16*)(P->ws + W_HT);
  const bf16* SP = (const bf16*)(P->ws + W_SPREV);
  bf16* Yret = (bf16*)(P->ws + W_YRET);
  const float* gng = P->in[I_GNG] + li * 256;
  const int h = item & 3, cidx = item >> 2;
  const int lane = opaque(tidx() & 63), w = tidx() >> 6, l15 = lane & 15, g = lane >> 4;
  const float lg2 = log2f(1.f - exp2f(-5.f - (float)h));
  const int row0 = cidx * 64;
  const int iq = w * 16 + l15;
  bf16x8 qf[2];
#pragma unroll
  for (int ks = 0; ks < 2; ks++) qf[ks] = u4_to_frag(*(const uint4*)(H + (size_t)(row0 + iq) * INC + C_QRET + h * 64 + ks * 32 + g * 8));
  f32x4 s[4];
#pragma unroll
  for (int jt = 0; jt < 4; jt++) {
    s[jt] = f32x4{0.f, 0.f, 0.f, 0.f};
#pragma unroll
    for (int ks = 0; ks < 2; ks++) {
      bf16x8 kf = u4_to_frag(*(const uint4*)(H + (size_t)(row0 + jt * 16 + l15) * INC + C_KRET + h * 64 + ks * 32 + g * 8));
      s[jt] = __builtin_amdgcn_mfma_f32_16x16x32_bf16(kf, qf[ks], s[jt], 0, 0, 0);
    }
#pragma unroll
    for (int r = 0; r < 4; r++) {
      int j = jt * 16 + 4 * g + r;
      int dd = iq - j; dd = dd < 0 ? -dd : dd;
      s[jt][r] *= exp2f(lg2 * (float)dd);
    }
  }
  f32x4 o[4], oi[4];
#pragma unroll
  for (int et = 0; et < 4; et++) { o[et] = f32x4{0.f, 0.f, 0.f, 0.f}; oi[et] = f32x4{0.f, 0.f, 0.f, 0.f}; }
#pragma unroll
  for (int kk = 0; kk < 2; kk++) {
    union { uint4 u; bf16x8 f; } pf;
    pf.u.x = pack2(s[2 * kk][0], s[2 * kk][1]); pf.u.y = pack2(s[2 * kk][2], s[2 * kk][3]);
    pf.u.z = pack2(s[2 * kk + 1][0], s[2 * kk + 1][1]); pf.u.w = pack2(s[2 * kk + 1][2], s[2 * kk + 1][3]);
#pragma unroll
    for (int et = 0; et < 4; et++) {
      const bf16* vp = HT + (size_t)(768 + h * 64 + et * 16 + l15) * NTOK + row0 + kk * 32 + 4 * g;
      union { uint4 u; bf16x8 f; } vf;
      uint2 a = *(const uint2*)vp, b = *(const uint2*)(vp + 16);
      vf.u.x = a.x; vf.u.y = a.y; vf.u.z = b.x; vf.u.w = b.y;
      o[et] = __builtin_amdgcn_mfma_f32_16x16x32_bf16(vf.f, pf.f, o[et], 0, 0, 0);
    }
  }
#pragma unroll
  for (int ks = 0; ks < 2; ks++)
#pragma unroll
    for (int et = 0; et < 4; et++) {
      bf16x8 sf = u4_to_frag(*(const uint4*)(SP + ((size_t)(cidx * 4 + h) * 64 + et * 16 + l15) * 64 + ks * 32 + g * 8));
      oi[et] = __builtin_amdgcn_mfma_f32_16x16x32_bf16(sf, qf[ks], oi[et], 0, 0, 0);
    }
  const float qw = exp2f(lg2 * (float)(iq + 1));
  float sum = 0.f;
#pragma unroll
  for (int et = 0; et < 4; et++)
#pragma unroll
    for (int r = 0; r < 4; r++) { o[et][r] += qw * oi[et][r]; sum += o[et][r]; }
  sum += __shfl_xor(sum, 16); sum += __shfl_xor(sum, 32);
  const float mu = sum * (1.f / 64.f);
  float vs = 0.f;
#pragma unroll
  for (int et = 0; et < 4; et++)
#pragma unroll
    for (int r = 0; r < 4; r++) { float d = o[et][r] - mu; vs += d * d; }
  vs += __shfl_xor(vs, 16); vs += __shfl_xor(vs, 32);
  const float rstd = rsqrtf(vs * (1.f / 64.f) + LN_EPS);
#pragma unroll
  for (int et = 0; et < 4; et++) {
    int e0 = et * 16 + 4 * g;
    uint2 gr = *(const uint2*)(H + (size_t)(row0 + iq) * INC + C_GRET + h * 64 + e0);
    float gv[4] = {bflo(gr.x), bfhi(gr.x), bflo(gr.y), bfhi(gr.y)};
    float y[4];
#pragma unroll
    for (int r = 0; r < 4; r++) {
      float gg = gv[r];
      y[r] = (o[et][r] - mu) * rstd * gng[h * 64 + e0 + r] * (gg * sigmoidf_(gg));
    }
    uint2 ov; ov.x = pack2(y[0], y[1]); ov.y = pack2(y[2], y[3]);
    *(uint2*)(Yret + (size_t)(row0 + iq) * 256 + h * 64 + e0) = ov;
  }
}

__device__ __forceinline__ void ssm_toep_tile(KP P, int li, int t, bf16* smem) {
  EPI_VARS
  const bf16* H = (const bf16*)(P->ws + W_H);
  const bf16* Tt = (const bf16*)(P->ws + W_TT);
  const bf16* HS = (const bf16*)(P->ws + W_HS);
  bf16* Zs = (bf16*)(P->ws + W_CT);
  const float* dsk = P->in[I_SD] + li * 256;
  const int g = t / 24, r24 = t % 24, mt = r24 / 8, nt = r24 % 8;
  const int m0 = mt * 128, n0 = nt * 128;
  f32x16 acc[2][2];
  zero_acc(acc);
  const bf16* Kg = Tt + (size_t)g * 64 * 256;
  const bf16* Cg = Tt + KERN_ELEMS + ((size_t)g * 1024 + n0) * 128;
  auto al = [&](int r, int kc) {
    int c = min(m0 + r, NCHUNK - 1);
    if (kc < 128) { int s = kc >> 1, q0 = (kc & 1) * 8; return *(const uint4*)(H + (size_t)(c * 64 + s) * INC + g * 16 + q0); }
    return *(const uint4*)(HS + ((size_t)c * 16 + g) * 128 + (kc - 128) * 8);
  };
  auto bl = [&](int r, int kc) {
    if (kc < 128) {
      int n = n0 + r, tt = n >> 4, p = n & 15, ss = kc >> 1, q0 = (kc & 1) * 8;
      int d = tt - ss;
      uint4 v = *(const uint4*)(Kg + ((size_t)max(d, 0) * 16 + p) * 16 + q0);
      if (d < 0) v = make_uint4(0u, 0u, 0u, 0u);
      return v;
    }
    return *(const uint4*)(Cg + (size_t)r * 128 + (kc - 128) * 8);
  };
  gemm_kloop(acc, al, bl, 0, 2 * (nt + 1), smem);
  gemm_kloop(acc, al, bl, 16, 2, smem);
    EPI_BASE
#pragma unroll
  for (int mi = 0; mi < 2; mi++)
#pragma unroll
    for (int ni = 0; ni < 2; ni++)
#pragma unroll
      for (int r = 0; r < 16; r++) {
        int c = m0 + EPI_ROW(mi, r), n = n0 + EPI_COL(ni);
        if (c < NCHUNK) {
          int tt = n >> 4, p = n & 15;
          size_t tok = (size_t)c * 64 + tt;
          float u = bf2f(H[tok * INC + g * 16 + p]);
          float y = acc[mi][ni][r] + dsk[g * 16 + p] * u;
          Zs[tok * 256 + g * 16 + p] = f2bf(gelu_tanh(y));
        }
      }
}

__device__ __forceinline__ void phase_C(KP P, int li, bf16* smem) {
  const int n_toep = 16 * 24, n_ret = NCHUNK * 4;
  for (int t = bidx(); t < n_toep + n_ret; t += gdim()) {
    if (t < n_toep) ssm_toep_tile(P, li, t, smem);
    else ret_finish_item(P, li, t - n_toep);
  }
}

__device__ __forceinline__ void phase_D(KP P, int li, bf16* smem) {
  EPI_VARS
  const bf16* Zs = (const bf16*)(P->ws + W_CT);
  const bf16* Wt = (const bf16*)(P->ws + W_GLU);
  bf16* Yssm = (bf16*)(P->ws + W_YSSM);
  const float* bg = P->in[I_BGLU] + li * 256;
  for (int t = bidx(); t < 136 * 2; t += gdim()) {
    const int m0 = (t >> 1) * 128, n0 = (t & 1) * 128;
    f32x16 acc[2][2];
    zero_acc(acc);
    const bf16* Ab = Zs + (size_t)m0 * 256;
    const bf16* Bb = Wt + (size_t)n0 * 256;
    gemm_kloop(acc,
      [&](int r, int kc) { return *(const uint4*)(Ab + (size_t)r * 256 + kc * 8); },
      [&](int r, int kc) { return *(const uint4*)(Bb + (size_t)r * 256 + kc * 8); }, 0, 4, smem);
    EPI_BASE
#pragma unroll
    for (int mi = 0; mi < 2; mi++)
#pragma unroll
      for (int ni = 0; ni < 2; ni++)
#pragma unroll
        for (int r = 0; r < 16; r++) {
          int row = m0 + EPI_ROW(mi, r), col = n0 + EPI_COL(ni);
          float z = bf2f(Zs[(size_t)row * 256 + col]);
          Yssm[(size_t)row * 256 + col] = f2bf(z * sigmoidf_(acc[mi][ni][r] + bg[col]));
        }
  }
}

__device__ __forceinline__ void phase_E(KP P, int li, bf16* smem) {
  EPI_VARS
  const bf16* H = (const bf16*)(P->ws + W_H);
  bf16* MG = (bf16*)(P->ws + W_HT);
  for (int t = bidx(); t < SWZ_TOTAL(8); t += gdim()) {
    int mt_, nt_;
    if (!tile_swz(t, 8, mt_, nt_)) continue;
    const int m0 = mt_ * 128, n0 = nt_ * 128;
    f32x16 tot[2][2];
    zero_acc(tot);
#pragma unroll 1
    for (int br = 0; br < 3; br++) {
      const bf16* Y = (const bf16*)(P->ws + (br == 0 ? W_YSSM : (br == 1 ? W_YATT : W_YRET)));
      const bf16* Wt = (const bf16*)(P->ws + (br == 0 ? W_BRS : (br == 1 ? W_BRA : W_BRR)));
      const int K = (br == 1) ? 512 : 256;
      f32x16 acc[2][2];
      zero_acc(acc);
      const bf16* Ab = Y + (size_t)m0 * K;
      const bf16* Bb = Wt + (size_t)n0 * K;
      gemm_kloop_light(acc,
        [&](int r, int kc) { return *(const uint4*)(Ab + (size_t)r * K + kc * 8); },
        [&](int r, int kc) { return *(const uint4*)(Bb + (size_t)r * K + kc * 8); }, 0, K / 64, smem);
#pragma unroll
      for (int mi = 0; mi < 2; mi++)
#pragma unroll
        for (int ni = 0; ni < 2; ni++) {
          EPI_BASE
#pragma unroll
          for (int r = 0; r < 16; r++) {
            int row = m0 + EPI_ROW(mi, r), col = n0 + EPI_COL(ni);
            float gt = bf2f(H[(size_t)row * INC + C_GATE + br * 1024 + col]);
            tot[mi][ni][r] += sigmoidf_(gt) * acc[mi][ni][r];
          }
        }
    }
    EPI_BASE
#pragma unroll
    for (int mi = 0; mi < 2; mi++)
#pragma unroll
      for (int ni = 0; ni < 2; ni++)
#pragma unroll
        for (int r = 0; r < 16; r++) {
          int row = m0 + EPI_ROW(mi, r), col = n0 + EPI_COL(ni);
          MG[(size_t)row * 1024 + col] = f2bf(tot[mi][ni][r]);
        }
  }
  { int jb, jn; if (light_block(1, jb, jn)) convert_fp8_job(P->in[I_PU] + (size_t)li * 16384 * 1024, P->ws + W_U, 16384ull * 1024, 256.f, jb, jn); }
}

__device__ __forceinline__ void phase_WO(KP P, int li, bf16* smem) {
  EPI_VARS
  const bf16* MG = (const bf16*)(P->ws + W_HT);
  const bf16* Wt = (const bf16*)(P->ws + W_O);
  const bf16* X = (const bf16*)(P->ws + W_X);
  bf16* Z = (bf16*)(P->ws + W_H);
  for (int t = bidx(); t < SWZ_TOTAL(8); t += gdim()) {
    int mt_, nt_;
    if (!tile_swz(t, 8, mt_, nt_)) continue;
    const int m0 = mt_ * 128, n0 = nt_ * 128;
    f32x16 acc[2][2];
    zero_acc(acc);
    const bf16* Ab = MG + (size_t)m0 * 1024;
    const bf16* Bb = Wt + (size_t)n0 * 1024;
    gemm_kloop(acc,
      [&](int r, int kc) { return *(const uint4*)(Ab + (size_t)r * 1024 + kc * 8); },
      [&](int r, int kc) { return *(const uint4*)(Bb + (size_t)r * 1024 + kc * 8); }, 0, 16, smem);
    EPI_BASE
    epi_rowmajor(acc, smem, [&](int row, int c8, float (&v)[8]) {
      uint4 xr = *(const uint4*)(X + (size_t)(m0 + row) * 1024 + n0 + c8);
      uint4 o;
      o.x = pack2(DN_ALPHA * bflo(xr.x) + v[0], DN_ALPHA * bfhi(xr.x) + v[1]); o.y = pack2(DN_ALPHA * bflo(xr.y) + v[2], DN_ALPHA * bfhi(xr.y) + v[3]);
      o.z = pack2(DN_ALPHA * bflo(xr.z) + v[4], DN_ALPHA * bfhi(xr.z) + v[5]); o.w = pack2(DN_ALPHA * bflo(xr.w) + v[6], DN_ALPHA * bfhi(xr.w) + v[7]);
      *(uint4*)(Z + (size_t)(m0 + row) * 1024 + n0 + c8) = o;
    });
  }
  { int jb, jn; if (light_block(1, jb, jn)) convert_fp8_job(P->in[I_PV] + (size_t)li * 16384 * 1024, P->ws + W_V, 16384ull * 1024, 64.f, jb, jn); }
}

__device__ __forceinline__ void phase_LN(KP P, const float* gam, const float* bet, bool final_out, size_t xoff) {
  const bf16* Z = (const bf16*)(P->ws + W_H);
  bf16* X = (bf16*)(P->ws + xoff);
  const int lane = tidx() & 63;
  const int gw = bidx() * 4 + (tidx() >> 6), nw = gdim() * 4;
#pragma unroll 4
  for (int row = gw; row < NTOK; row += nw) {
    float4 v[4];
    float s = 0.f;
#pragma unroll
    for (int i = 0; i < 4; i++) {
      uint2 zr = *(const uint2*)(Z + (size_t)row * 1024 + i * 256 + lane * 4);
      v[i] = make_float4(bflo(zr.x), bfhi(zr.x), bflo(zr.y), bfhi(zr.y));
      s += v[i].x + v[i].y + v[i].z + v[i].w;
    }
    s = wsum(s);
    const float mu = s * (1.f / 1024.f);
    float q = 0.f;
#pragma unroll
    for (int i = 0; i < 4; i++) { float a = v[i].x - mu, b = v[i].y - mu, c = v[i].z - mu, d = v[i].w - mu; q += a * a + b * b + c * c + d * d; }
    q = wsum(q);
    const float rstd = rsqrtf(q * (1.f / 1024.f) + LN_EPS);
#pragma unroll
    for (int i = 0; i < 4; i++) {
      int col = i * 256 + lane * 4;
      float4 gg = *(const float4*)(gam + col), bb = *(const float4*)(bet + col);
      float4 y;
      y.x = (v[i].x - mu) * rstd * gg.x + bb.x; y.y = (v[i].y - mu) * rstd * gg.y + bb.y;
      y.z = (v[i].z - mu) * rstd * gg.z + bb.z; y.w = (v[i].w - mu) * rstd * gg.w + bb.w;
      uint2 o; o.x = pack2(y.x, y.y); o.y = pack2(y.z, y.w);
      if (!final_out) *(uint2*)(X + (size_t)row * 1024 + col) = o;
      else *(float4*)(P->out + (size_t)row * 1024 + col) = y;
    }
  }
}

__device__ __forceinline__ void phase_PQ(KP P, int li, bf16* smem) {
  EPI_VARS
  const bf16* X = (const bf16*)(P->ws + W_HT);
  const bf16* Wt = (const bf16*)(P->ws + W_QK);
  float* S = (float*)(P->ws + W_H);
  for (int t = bidx(); t < SWZ_TOTAL(16); t += gdim()) {
    int mt_, nt_;
    if (!tile_swz(t, 16, mt_, nt_)) continue;
    const int m0 = mt_ * 128, n0 = nt_ * 128;
    f32x16 acc[2][2];
    zero_acc(acc);
    const bf16* Ab = X + (size_t)m0 * 1024;
    const bf16* Bb = Wt + (size_t)n0 * 1024;
    gemm_kloop(acc,
      [&](int r, int kc) { return *(const uint4*)(Ab + (size_t)r * 1024 + kc * 8); },
      [&](int r, int kc) { return *(const uint4*)(Bb + (size_t)r * 1024 + kc * 8); }, 0, 16, smem);
    EPI_BASE
    epi_rowmajor(acc, smem, [&](int row, int c8, float (&v)[8]) {
      float* sp = S + (size_t)(m0 + row) * 2048 + n0 + c8;
      *(float4*)sp = make_float4(v[0], v[1], v[2], v[3]);
      *(float4*)(sp + 4) = make_float4(v[4], v[5], v[6], v[7]);
    });
  }
  { int jb, jn;
    if (light_block(2, jb, jn)) {
      float* lds = (float*)smem;
      convert_job(P->in[I_PP] + (size_t)li * NPTOK * 256, (bf16*)(P->ws + W_PE), (size_t)NPTOK * 256, jb, jn);
      convert_job(P->in[I_PS] + (size_t)li * 1024 * 256, (bf16*)(P->ws + W_PE) + (size_t)NPTOK * 256, 1024ull * 256, jb, jn);
      transpose_job(P->in[I_WG] + (size_t)li * 1024 * 1024, (bf16*)(P->ws + W_G), 1024, 1024, 1, lds, jb, jn);
      transpose_job(P->in[I_WP] + (size_t)li * 256 * 1024, (bf16*)(P->ws + W_P), 256, 1024, 1, lds, jb, jn);
      if (li == 0 && !MULTI_LAUNCH) pro_cache(P, 1, lds, jb, jn);
    }
  }
}

__device__ __forceinline__ float dpp_max_step(float v, const int ctrl_dummy);
#define DPP_MAX(v, ctrl) v = fmaxf(v, __int_as_float(__builtin_amdgcn_update_dpp(__float_as_int(v), __float_as_int(v), ctrl, 0xf, 0xf, false)))
__device__ __forceinline__ float wave_max(float v) {
  DPP_MAX(v, 0x111);
  DPP_MAX(v, 0x112);
  DPP_MAX(v, 0x114);
  DPP_MAX(v, 0x118);
  DPP_MAX(v, 0x142);
  DPP_MAX(v, 0x143);
  return __int_as_float(__builtin_amdgcn_readlane(__float_as_int(v), 63));
}

__device__ __forceinline__ void top16_of128(float v0, float v1, int lane, float& osc, int& oix) {
  osc = -3.0e38f; oix = 0;
#pragma unroll
  for (int r = 0; r < 16; r++) {
    float m = fmaxf(v0, v1);
    float wm = wave_max(m);
    unsigned long long bal = __ballot(m == wm);
    int src = __ffsll((long long)bal) - 1;
    int sel = (v0 == wm) ? 0 : 1;
    int selu = __builtin_amdgcn_readlane(sel, src);
    if (lane == src) { if (selu == 0) v0 = -3.0e38f; else v1 = -3.0e38f; }
    if (lane == r) { osc = wm; oix = src + 64 * selu; }
  }
}

typedef float f2v __attribute__((ext_vector_type(2)));
__device__ __forceinline__ unsigned fkey(float f) { unsigned u = __float_as_uint(f); return u ^ ((unsigned)((int)u >> 31) | 0x80000000u); }
__device__ __forceinline__ int mbcnt64(unsigned long long m) {
  return __builtin_amdgcn_mbcnt_hi((unsigned)(m >> 32), __builtin_amdgcn_mbcnt_lo((unsigned)m, 0u));
}
template <int NV>
__device__ __forceinline__ unsigned top16_threshold(const unsigned (&k)[NV]) {
  unsigned T = 0u;
#pragma unroll 1
  for (int bit = 31; bit >= 0; bit--) {
    const unsigned c = T | (1u << bit);
    int cnt = 0;
#pragma unroll
    for (int i = 0; i < NV; i++) cnt += __popcll(__ballot(k[i] >= c));
    if (cnt >= 16) T = c;
    if (cnt == 16) break;
  }
  return T;
}

__device__ __forceinline__ void phase_PEER(KP P, int li, bf16* smem) {
  const float* S = (const float*)(P->ws + W_H);
  bf16* X = (bf16*)(P->ws + W_X);
  const bf16* XA = (const bf16*)(P->ws + W_HT);
  const unsigned char* U = P->ws + W_U;
  const unsigned char* V = P->ws + W_V;
  const float* gam = P->in[I_L2G] + li * 1024;
  const float* bet = P->in[I_L2B] + li * 1024;
  const int lane = tidx() & 63;
  const int wv = tidx() >> 6;
  const int gw = bidx() * 4 + wv, nw = gdim() * 4;
  float* wl = (float*)smem + wv * 128;
  int* wli = (int*)wl;
  for (int tok = gw; tok < NTOK; tok += nw) {
    f2v xv[8];
    {
      uint4 a = *(const uint4*)(XA + (size_t)tok * 1024 + lane * 16);
      uint4 b = *(const uint4*)(XA + (size_t)tok * 1024 + lane * 16 + 8);
      xv[0] = f2v{bflo(a.x), bfhi(a.x)}; xv[1] = f2v{bflo(a.y), bfhi(a.y)}; xv[2] = f2v{bflo(a.z), bfhi(a.z)}; xv[3] = f2v{bflo(a.w), bfhi(a.w)};
      xv[4] = f2v{bflo(b.x), bfhi(b.x)}; xv[5] = f2v{bflo(b.y), bfhi(b.y)}; xv[6] = f2v{bflo(b.z), bfhi(b.z)}; xv[7] = f2v{bflo(b.w), bfhi(b.w)};
    }
    f2v outv[8];
#pragma unroll
    for (int i = 0; i < 8; i++) outv[i] = f2v{0.f, 0.f};
    const float* Srow = S + (size_t)tok * 2048;
#define PEER_ROUTE(sv, ts_out, eid_out) { \
      _Pragma("unroll") for (int side = 0; side < 2; side++) { \
        float v0 = sv[side * 2], v1 = sv[side * 2 + 1]; \
        unsigned kk[2] = {fkey(v0), fkey(v1)}; \
        unsigned T = top16_threshold<2>(kk); \
        bool s0 = kk[0] >= T, s1 = kk[1] >= T; \
        unsigned long long m0 = __ballot(s0), m1 = __ballot(s1); \
        int r0 = mbcnt64(m0), r1 = __popcll(m0) + mbcnt64(m1); \
        if (s0 && r0 < 16) { wl[side * 16 + r0] = v0; wli[32 + side * 16 + r0] = lane; } \
        if (s1 && r1 < 16) { wl[side * 16 + r1] = v1; wli[32 + side * 16 + r1] = lane + 64; } \
      } \
      { const int i = lane & 15, j0 = lane >> 4; \
        const float a = wl[i]; const int ai = wli[32 + i]; \
        float cs[4]; int ce[4]; unsigned kk[4]; \
        _Pragma("unroll") for (int m = 0; m < 4; m++) { cs[m] = a + wl[16 + j0 + 4 * m]; ce[m] = ai * 128 + wli[48 + j0 + 4 * m]; kk[m] = fkey(cs[m]); } \
        unsigned T = top16_threshold<4>(kk); \
        int base = 0; \
        _Pragma("unroll") for (int m = 0; m < 4; m++) { \
          bool sl = kk[m] >= T; unsigned long long mm = __ballot(sl); int r = base + mbcnt64(mm); \
          if (sl && r < 16) { wl[64 + r] = cs[m]; wli[80 + r] = ce[m]; } \
          base += __popcll(mm); } } \
      ts_out = wl[64 + (lane & 15)]; eid_out = wli[80 + (lane & 15)]; }
    float sva[4], svb[4];
#pragma unroll
    for (int i = 0; i < 4; i++) { sva[i] = Srow[i * 64 + lane]; svb[i] = Srow[256 + i * 64 + lane]; }
    float ts; int eid;
    PEER_ROUTE(sva, ts, eid)
#pragma unroll 1
    for (int h = 0; h < 8; h++) {
#pragma unroll
      for (int i = 0; i < 4; i++) { sva[i] = svb[i]; }
      if (h + 2 < 8) {
#pragma unroll
        for (int i = 0; i < 4; i++) svb[i] = Srow[(h + 2) * 256 + i * 64 + lane];
      }
      uint4 ub[16], vb[8];
#pragma unroll
      for (int k = 0; k < 16; k++) {
        int e = __builtin_amdgcn_readlane(eid, k);
        ub[k] = *(const uint4*)(U + (size_t)e * 1024 + lane * 16);
        if (k < 8) vb[k] = *(const uint4*)(V + (size_t)e * 1024 + lane * 16);
      }
      int eidc = eid;
      float tmax = ts;
      tmax = fmaxf(tmax, __shfl_xor(tmax, 1)); tmax = fmaxf(tmax, __shfl_xor(tmax, 2));
      tmax = fmaxf(tmax, __shfl_xor(tmax, 4)); tmax = fmaxf(tmax, __shfl_xor(tmax, 8));
      float ex = __expf(ts - tmax);
      float den = ex;
      den += __shfl_xor(den, 1); den += __shfl_xor(den, 2); den += __shfl_xor(den, 4); den += __shfl_xor(den, 8);
      float gate = ex / den;
      if (h + 1 < 8) { PEER_ROUTE(sva, ts, eid) }
      float dk[16];
#pragma unroll
      for (int k = 0; k < 16; k++) {
        f2v acc = f2v{0.f, 0.f};
        acc += __builtin_amdgcn_cvt_pk_f32_fp8((int)ub[k].x, false) * xv[0]; acc += __builtin_amdgcn_cvt_pk_f32_fp8((int)ub[k].x, true) * xv[1];
        acc += __builtin_amdgcn_cvt_pk_f32_fp8((int)ub[k].y, false) * xv[2]; acc += __builtin_amdgcn_cvt_pk_f32_fp8((int)ub[k].y, true) * xv[3];
        acc += __builtin_amdgcn_cvt_pk_f32_fp8((int)ub[k].z, false) * xv[4]; acc += __builtin_amdgcn_cvt_pk_f32_fp8((int)ub[k].z, true) * xv[5];
        acc += __builtin_amdgcn_cvt_pk_f32_fp8((int)ub[k].w, false) * xv[6]; acc += __builtin_amdgcn_cvt_pk_f32_fp8((int)ub[k].w, true) * xv[7];
        dk[k] = acc[0] + acc[1];
      }
      uint4 vc[8];
#pragma unroll
      for (int k = 0; k < 8; k++) {
        int e = __builtin_amdgcn_readlane(eidc, 8 + k);
        vc[k] = *(const uint4*)(V + (size_t)e * 1024 + lane * 16);
      }
      {
        bool hi = (lane & 32) != 0;
#pragma unroll
        for (int i = 0; i < 8; i++) { float send = hi ? dk[i] : dk[i + 8]; float keep = hi ? dk[i + 8] : dk[i]; dk[i] = keep + __shfl_xor(send, 32); }
        hi = (lane & 16) != 0;
#pragma unroll
        for (int i = 0; i < 4; i++) { float send = hi ? dk[i] : dk[i + 4]; float keep = hi ? dk[i + 4] : dk[i]; dk[i] = keep + __shfl_xor(send, 16); }
        hi = (lane & 8) != 0;
#pragma unroll
        for (int i = 0; i < 2; i++) { float send = hi ? dk[i] : dk[i + 2]; float keep = hi ? dk[i + 2] : dk[i]; dk[i] = keep + __shfl_xor(send, 8); }
        hi = (lane & 4) != 0;
        { float send = hi ? dk[0] : dk[1]; float keep = hi ? dk[1] : dk[0]; dk[0] = keep + __shfl_xor(send, 4); }
        dk[0] += __shfl_xor(dk[0], 2);
        dk[0] += __shfl_xor(dk[0], 1);
      }
      float wgt = __shfl(gate, (lane >> 2) & 15) * gelu_tanh(dk[0] * (1.f / 256.f)) * (1.f / 64.f);
#pragma unroll
      for (int k = 0; k < 16; k++) {
        float wk = __int_as_float(__builtin_amdgcn_readlane(__float_as_int(wgt), k * 4));
        const f2v wk2 = f2v{wk, wk};
        const uint4 vv = (k < 8) ? vb[k & 7] : vc[k & 7];
        outv[0] += wk2 * __builtin_amdgcn_cvt_pk_f32_fp8((int)vv.x, false); outv[1] += wk2 * __builtin_amdgcn_cvt_pk_f32_fp8((int)vv.x, true);
        outv[2] += wk2 * __builtin_amdgcn_cvt_pk_f32_fp8((int)vv.y, false); outv[3] += wk2 * __builtin_amdgcn_cvt_pk_f32_fp8((int)vv.y, true);
        outv[4] += wk2 * __builtin_amdgcn_cvt_pk_f32_fp8((int)vv.z, false); outv[5] += wk2 * __builtin_amdgcn_cvt_pk_f32_fp8((int)vv.z, true);
        outv[6] += wk2 * __builtin_amdgcn_cvt_pk_f32_fp8((int)vv.w, false); outv[7] += wk2 * __builtin_amdgcn_cvt_pk_f32_fp8((int)vv.w, true);
      }
    }
    float z[16];
    float s = 0.f;
#pragma unroll
    for (int i = 0; i < 8; i++) { z[2 * i] = outv[i][0] + DN_ALPHA * xv[i][0]; z[2 * i + 1] = outv[i][1] + DN_ALPHA * xv[i][1]; s += z[2 * i] + z[2 * i + 1]; }
    s = wsum(s);
    const float mu = s * (1.f / 1024.f);
    float q = 0.f;
#pragma unroll
    for (int i = 0; i < 16; i++) { float d = z[i] - mu; q += d * d; }
    q = wsum(q);
    const float rstd = rsqrtf(q * (1.f / 1024.f) + LN_EPS);
    float y[16];
    const int col = lane * 16;
#pragma unroll
    for (int i4 = 0; i4 < 4; i4++) {
      float4 g = *(const float4*)(gam + col + i4 * 4), b = *(const float4*)(bet + col + i4 * 4);
      y[i4 * 4 + 0] = (z[i4 * 4 + 0] - mu) * rstd * g.x + b.x; y[i4 * 4 + 1] = (z[i4 * 4 + 1] - mu) * rstd * g.y + b.y;
      y[i4 * 4 + 2] = (z[i4 * 4 + 2] - mu) * rstd * g.z + b.z; y[i4 * 4 + 3] = (z[i4 * 4 + 3] - mu) * rstd * g.w + b.w;
    }
    uint4 o0, o1;
    o0.x = pack2(y[0], y[1]); o0.y = pack2(y[2], y[3]); o0.z = pack2(y[4], y[5]); o0.w = pack2(y[6], y[7]);
    o1.x = pack2(y[8], y[9]); o1.y = pack2(y[10], y[11]); o1.z = pack2(y[12], y[13]); o1.w = pack2(y[14], y[15]);
    *(uint4*)(X + (size_t)tok * 1024 + col) = o0;
    *(uint4*)(X + (size_t)tok * 1024 + col + 8) = o1;
  }
}

__device__ __forceinline__ void phase_PLE(KP P, int li, bf16* smem) {
  EPI_VARS
  const bf16* X = (const bf16*)(P->ws + W_X);
  const bf16* PE = (const bf16*)(P->ws + W_PE);
  const bf16* Wg = (const bf16*)(P->ws + W_G);
  const bf16* Wp = (const bf16*)(P->ws + W_P);
  bf16* Z = (bf16*)(P->ws + W_H);
  for (int t = bidx(); t < SWZ_TOTAL(8); t += gdim()) {
    int mt_, nt_;
    if (!tile_swz(t, 8, mt_, nt_)) continue;
    const int m0 = mt_ * 128, n0 = nt_ * 128;
    f32x16 acc[2][2], acc2[2][2];
    zero_acc(acc); zero_acc(acc2);
    {
      const bf16* Ab = X + (size_t)m0 * 1024;
      const bf16* Bb = Wg + (size_t)n0 * 1024;
      gemm_kloop(acc,
        [&](int r, int kc) { return *(const uint4*)(Ab + (size_t)r * 1024 + kc * 8); },
        [&](int r, int kc) { return *(const uint4*)(Bb + (size_t)r * 1024 + kc * 8); }, 0, 16, smem);
    }
    {
      const bf16* Ab = PE + (size_t)m0 * 256;
      const bf16* Bb = Wp + (size_t)n0 * 256;
      gemm_kloop(acc2,
        [&](int r, int kc) { return *(const uint4*)(Ab + (size_t)r * 256 + kc * 8); },
        [&](int r, int kc) { return *(const uint4*)(Bb + (size_t)r * 256 + kc * 8); }, 0, 4, smem);
    }
    EPI_BASE
#pragma unroll
    for (int mi = 0; mi < 2; mi++)
#pragma unroll
      for (int ni = 0; ni < 2; ni++)
#pragma unroll
        for (int r = 0; r < 16; r++) acc[mi][ni][r] = sigmoidf_(acc[mi][ni][r]) * acc2[mi][ni][r];
    epi_rowmajor(acc, smem, [&](int row, int c8, float (&v)[8]) {
      uint4 xr = *(const uint4*)(X + (size_t)(m0 + row) * 1024 + n0 + c8);
      uint4 o;
      o.x = pack2(DN_ALPHA * bflo(xr.x) + v[0], DN_ALPHA * bfhi(xr.x) + v[1]); o.y = pack2(DN_ALPHA * bflo(xr.y) + v[2], DN_ALPHA * bfhi(xr.y) + v[3]);
      o.z = pack2(DN_ALPHA * bflo(xr.z) + v[4], DN_ALPHA * bfhi(xr.z) + v[5]); o.w = pack2(DN_ALPHA * bflo(xr.w) + v[6], DN_ALPHA * bfhi(xr.w) + v[7]);
      *(uint4*)(Z + (size_t)(m0 + row) * 1024 + n0 + c8) = o;
    });
  }
  if (li == 0 && !MULTI_LAUNCH) { int jb, jn; if (light_block(1, jb, jn)) pro_misc(P, 1, (float*)smem, jb, jn); }
}

__device__ __forceinline__ void run_phase(KP P, int li, int k, bf16* smem) {
  switch (k) {
    case PH_PRO: phase_prologue(P, li, smem); break;
    case PH_GIN: phase_gemm_in(P, li, smem); break;
    case PH_A: phase_A(P, li, smem); break;
    case PH_B: phase_B(P, li); break;
    case PH_C: phase_C(P, li, smem); break;
    case PH_D: phase_D(P, li, smem); break;
    case PH_E: phase_E(P, li, smem); break;
    case PH_WO: phase_WO(P, li, smem); break;
    case PH_LN1: phase_LN(P, P->in[I_L1G] + li * 1024, P->in[I_L1B] + li * 1024, false, W_HT); break;
    case PH_PQ: phase_PQ(P, li, smem); break;
    case PH_PEER: phase_PEER(P, li, smem); break;
    case PH_PLE: phase_PLE(P, li, smem); break;
    case PH_LN3: phase_LN(P, P->in[I_L3G] + li * 1024, P->in[I_L3B] + li * 1024, li == 1, W_X); break;
  }
}

#ifndef DUP_MASK
#define DUP_MASK 0
#endif
#define SYNC() xcd_barrier(xb)
#define RUN(k, call) { { KP P = kp_get(); call; } if ((DUP_MASK >> (k)) & 1) { SYNC(); KP P = kp_get(); call; } }
__global__ void __launch_bounds__(256, 2) fwd_kernel(Params Parg) {
  extern __shared__ __attribute__((aligned(16))) unsigned char lds_raw[];
  bf16* smem = (bf16*)lds_raw;
#if MULTI_LAUNCH
  { KP P = kp_get(); run_phase(P, P->pbeg / PH_N, P->pbeg % PH_N, smem); }
#else
  volatile LAS unsigned* st = (volatile LAS unsigned*)(lds_raw + LDS_TILE_BYTES);
  if (threadIdx.x == 0) { st[0] = 0u; st[1] = 0u; st[2] = 0u; st[3] = 0u; }
  __syncthreads();
  XcdBarrier xb;
  { KP P = kp_get(); xb = xcd_barrier_post((unsigned*)(P->ws + W_BAR), st);
    if (P->pad0 == 0x5eed) cg::this_grid().sync();
  }
#pragma unroll 1
  for (int li = 0; li < 2; li++) {
    if (li == 0) { RUN(PH_PRO, phase_prologue(P, li, smem)) SYNC(); }
    RUN(PH_GIN, phase_gemm_in(P, li, smem)) SYNC();
    RUN(PH_A, phase_A(P, li, smem)) SYNC();
    RUN(PH_B, phase_B(P, li)) SYNC();
    RUN(PH_C, phase_C(P, li, smem)) SYNC();
    RUN(PH_D, phase_D(P, li, smem)) SYNC();
    RUN(PH_E, phase_E(P, li, smem)) SYNC();
    RUN(PH_WO, phase_WO(P, li, smem)) SYNC();
    RUN(PH_LN1, phase_LN(P, P->in[I_L1G] + li * 1024, P->in[I_L1B] + li * 1024, false, W_HT)) SYNC();
    RUN(PH_PQ, phase_PQ(P, li, smem)) SYNC();
    RUN(PH_PEER, phase_PEER(P, li, smem)) SYNC();
    RUN(PH_PLE, phase_PLE(P, li, smem)) SYNC();
    RUN(PH_LN3, phase_LN(P, P->in[I_L3G] + li * 1024, P->in[I_L3B] + li * 1024, li == 1, W_X))
    if (li == 0) SYNC();
  }
#endif
}

extern "C" void kernel_launch(void* const* d_in, const int* in_sizes, int n_in, void* d_out, int out_size, void* d_ws,
                              size_t ws_size, hipStream_t stream) {
  static int grid_blocks = 0;
  if (grid_blocks == 0) {
    if (n_in != 38 || (size_t)out_size != O_END || ws_size < WS_END) {
      fprintf(stderr, "kernel_launch: unexpected sizes n_in=%d out=%d ws=%zu need %zu\n", n_in, out_size, ws_size, (size_t)WS_END);
      grid_blocks = -1; return;
    }
    int dev = 0, cus = 0, per_cu = 0;
    hipGetDevice(&dev);
    hipDeviceGetAttribute(&cus, hipDeviceAttributeMultiprocessorCount, dev);
    if (hipFuncSetAttribute((const void*)fwd_kernel, hipFuncAttributeMaxDynamicSharedMemorySize, LDS_BYTES) != hipSuccess) {
      fprintf(stderr, "kernel_launch: hipFuncSetAttribute failed\n"); grid_blocks = -1; return;
    }
    hipOccupancyMaxActiveBlocksPerMultiprocessor(&per_cu, (const void*)fwd_kernel, 256, LDS_BYTES);
    if (per_cu < 1) { fprintf(stderr, "kernel_launch: occupancy query gave %d\n", per_cu); grid_blocks = -1; return; }
    if (per_cu > 2) per_cu = 2;
    grid_blocks = cus * per_cu;
  }
  if (grid_blocks < 0) return;
  Params p{};
  for (int i = 0; i < 38; i++) p.in[i] = (const float*)d_in[i];
  p.out = (float*)d_out;
  p.ws = (unsigned char*)d_ws;
#if MULTI_LAUNCH
  for (int ph = 0; ph < 2 * PH_N; ph++) {
    p.pbeg = ph; p.pend = ph + 1;
    hipLaunchKernelGGL(fwd_kernel, dim3(grid_blocks), dim3(256), LDS_BYTES, stream, p);
  }
#else
  p.pbeg = 0; p.pend = 2 * PH_N;
  if (hipMemsetAsync((char*)d_ws + W_BAR, 0, 16384, stream) != hipSuccess) { fprintf(stderr, "memset failed\n"); return; }
  void* args[] = {&p};
#ifdef PLAIN_LAUNCH
  hipLaunchKernelGGL(fwd_kernel, dim3(grid_blocks), dim3(256), LDS_BYTES, stream, p);
  hipError_t e = hipSuccess; (void)args;
#else
  hipError_t e = hipLaunchCooperativeKernel((const void*)fwd_kernel, dim3(grid_blocks), dim3(256), args, LDS_BYTES, stream);
#endif
  if (e != hipSuccess) fprintf(stderr, "cooperative launch failed: %s (grid %d)\n", hipGetErrorString(e), grid_blocks);
#endif
}
```

```cpp
#include <hip/hip_runtime.h>
#include <hip/hip_cooperative_groups.h>
#include <cstdio>
#include <cstdint>
namespace cg = cooperative_groups;

#ifndef MULTI_LAUNCH
#define MULTI_LAUNCH 0
#endif

typedef unsigned short bf16;
using bf16x8 = __attribute__((ext_vector_type(8))) short;
using f32x16 = __attribute__((ext_vector_type(16))) float;
using f32x4 = __attribute__((ext_vector_type(4))) float;

#define NTOK 17408
#define NPTOK 16384
#define DM 1024
#define INC 5888
#define NCHUNK 272
#define C_USSM 0
#define C_QATT 256
#define C_KATT 768
#define C_VATT 1280
#define C_QRET 1792
#define C_KRET 2048
#define C_VRET 2304
#define C_GRET 2560
#define C_GATE 2816
#define DN_ALPHA 1.41421356237f
#define LN_EPS 1e-5f

constexpr size_t O_YP = 0;
constexpr size_t O_YS = O_YP + 4ull * 4096 * 1024;
constexpr size_t O_SRE_P = O_YS + 16ull * 64 * 1024;
constexpr size_t O_SIM_P = O_SRE_P + 2 * 4 * 16 * 64;
constexpr size_t O_AK_P = O_SIM_P + 2 * 4 * 16 * 64;
constexpr size_t O_AV_P = O_AK_P + 2ull * 4 * 512 * 512;
constexpr size_t O_RET_P = O_AV_P + 2ull * 4 * 512 * 512;
constexpr size_t O_SRE_S = O_RET_P + 2 * 4 * 4 * 4096;
constexpr size_t O_SIM_S = O_SRE_S + 2 * 16 * 16 * 64;
constexpr size_t O_AK_S = O_SIM_S + 2 * 16 * 16 * 64;
constexpr size_t O_AV_S = O_AK_S + 2ull * 16 * 64 * 512;
constexpr size_t O_RET_S = O_AV_S + 2ull * 16 * 64 * 512;
constexpr size_t O_END = O_RET_S + 2ull * 16 * 4 * 4096;

constexpr size_t W_IN = 0;
constexpr size_t W_BRS = W_IN + 5888ull * 1024 * 2;
constexpr size_t W_BRA = W_BRS + 1024ull * 256 * 2;
constexpr size_t W_BRR = W_BRA + 1024ull * 512 * 2;
constexpr size_t W_O = W_BRR + 1024ull * 256 * 2;
constexpr size_t W_QK = W_O + 1024ull * 1024 * 2;
constexpr size_t W_G = W_QK + 2048ull * 1024 * 2;
constexpr size_t W_P = W_G + 1024ull * 1024 * 2;
constexpr size_t W_GLU = W_P + 1024ull * 256 * 2;
constexpr size_t W_U = W_GLU + 256ull * 256 * 2;
constexpr size_t W_V = W_U + 16384ull * 1024 * 2;
constexpr size_t W_TT = W_V + 16384ull * 1024 * 2;
#define KERN_ELEMS (16 * 64 * 256)
constexpr size_t W_BST = W_TT + 16ull * 1024 * 1152 * 2;
constexpr size_t W_ROPE = W_BST + 16ull * 128 * 1024 * 2;
constexpr size_t W_X = W_ROPE + 4096ull * 32 * 8;
constexpr size_t W_PE = W_X + (size_t)NTOK * 1024 * 2;
constexpr size_t W_H = W_PE + (size_t)NTOK * 256 * 2;
constexpr size_t W_HT = W_H + (size_t)NTOK * 5888 * 2;
constexpr size_t W_YSSM = W_HT + 1024ull * NTOK * 2;
constexpr size_t W_YATT = W_YSSM + (size_t)NTOK * 256 * 2;
constexpr size_t W_YRET = W_YATT + (size_t)NTOK * 512 * 2;
constexpr size_t W_CK = W_YRET + (size_t)NTOK * 256 * 2;
constexpr size_t W_CVT = W_CK + 16ull * 512 * 512 * 2;
constexpr size_t W_CT = W_CVT + 16ull * 512 * 512 * 2;
constexpr size_t W_SPREV = W_CT + 272ull * 4 * 4096 * 4;
constexpr size_t W_SC = W_SPREV + 272ull * 4 * 4096 * 2;
constexpr size_t W_HS = W_SC + 272ull * 16 * 128 * 4;
constexpr size_t W_BAR = W_HS + 272ull * 16 * 128 * 2;
constexpr size_t WS_END = W_BAR + 16384;

#define LDS_TILE_BYTES 73728
#define LDS_BYTES (73728 + 16)
#define LDS_ROW 72
#define STAGE_ELEMS (128 * LDS_ROW)

struct Params {
  const float* in[38];
  float* out;
  unsigned char* ws;
  int pbeg, pend;
  int pad0, pad1;
};

typedef const __attribute__((address_space(4))) Params* KP;
__device__ __forceinline__ KP kp_get() { KP p = (KP)__builtin_amdgcn_kernarg_segment_ptr(); asm volatile("" : "+s"(p)); return p; }

enum { I_XP = 0, I_XS, I_PP, I_PS, I_SRE, I_SIM, I_CK, I_CV, I_SRET, I_WIN, I_LRE, I_LIM, I_BRE, I_BIM, I_CRE, I_CIM,
       I_LDT, I_SD, I_WGLU, I_BGLU, I_BIAS, I_GNG, I_WBS, I_WBA, I_WBR, I_WO, I_L1G, I_L1B, I_WQ, I_KEYS, I_PU, I_PV,
       I_L2G, I_L2B, I_WG, I_WP, I_L3G, I_L3B };

enum { PH_PRO = 0, PH_GIN, PH_A, PH_B, PH_C, PH_D, PH_E, PH_WO, PH_LN1, PH_PQ, PH_PEER, PH_PLE, PH_LN3, PH_N };

__device__ __forceinline__ bf16 f2bf(float f) {
  unsigned u = __float_as_uint(f);
  u += 0x7fffu + ((u >> 16) & 1u);
  return (bf16)(u >> 16);
}
__device__ __forceinline__ float bf2f(bf16 h) { return __uint_as_float(((unsigned)h) << 16); }
__device__ __forceinline__ unsigned pack2(float a, float b) { return (unsigned)f2bf(a) | ((unsigned)f2bf(b) << 16); }
__device__ __forceinline__ float bflo(unsigned u) { return __uint_as_float(u << 16); }
__device__ __forceinline__ float bfhi(unsigned u) { return __uint_as_float(u & 0xffff0000u); }
__device__ __forceinline__ float sigmoidf_(float x) { return __builtin_amdgcn_rcpf(1.f + __expf(-x)); }
__device__ __forceinline__ float gelu_tanh(float x) {
  float y = 0.7978845608028654f * (x + 0.044715f * x * x * x);
  float t = 1.f - 2.f * __builtin_amdgcn_rcpf(1.f + __expf(2.f * y));
  return 0.5f * x * (1.f + t);
}
__device__ __forceinline__ bf16x8 u4_to_frag(uint4 u) {
  union { uint4 u; bf16x8 f; } c; c.u = u; return c.f;
}
template <class T>
__device__ __forceinline__ T* launder(T* p) { asm volatile("" : "+s"(p)); return p; }
__device__ __forceinline__ int opaque(int v) { asm volatile("" : "+v"(v)); return v; }
__device__ __forceinline__ int bidx() { int v = blockIdx.x; asm volatile("" : "+s"(v)); return v; }
__device__ __forceinline__ int gdim() { int v = gridDim.x; asm volatile("" : "+s"(v)); return v; }
__device__ __forceinline__ int tidx() { int v = threadIdx.x; asm volatile("" : "+v"(v)); return v; }
__device__ __forceinline__ float wsum(float v) {
#pragma unroll
  for (int o = 32; o >= 1; o >>= 1) v += __shfl_xor(v, o);
  return v;
}


#define XB_TMO      128
#define XB_XCNT(j)  (256  + 64 * (j))
#define XB_XSUB(j)  (1280 + 64 * (j))
#define XB_XGEN(j)  (2304 + 64 * (j))
#define XB_TOP      3328
#define XB_TOPGEN   3392
#define XCD_BAR_WORDS 3456
#define XB_SPIN_CAP (1u << 20)
#define LAS __attribute__((address_space(3)))
__device__ __forceinline__ unsigned xb_ld(unsigned* p)              { return __hip_atomic_load(p, __ATOMIC_RELAXED, __HIP_MEMORY_SCOPE_AGENT); }
__device__ __forceinline__ unsigned xb_add(unsigned* p, unsigned v) { return __hip_atomic_fetch_add(p, v, __ATOMIC_RELAXED, __HIP_MEMORY_SCOPE_AGENT); }
__device__ __forceinline__ unsigned xb_xcc_id() { return (unsigned)__builtin_amdgcn_s_getreg((3 << 11) | 20) & 0xFu; }
#define XB_SPIN(cond, bar) do { unsigned _sp = 0; while (cond) { __builtin_amdgcn_s_sleep(1); \
    if ((++_sp & 255u) == 0u) { if (xb_ld(&(bar)[XB_TMO])) break; if (_sp > XB_SPIN_CAP) { atomicAdd(&(bar)[XB_TMO], 1u); break; } } } } while (0)
struct XcdBarrier { unsigned* bar; unsigned x; volatile LAS unsigned* st; };
__device__ __forceinline__ XcdBarrier xcd_barrier_post(unsigned* bar, volatile LAS unsigned* st) {
    XcdBarrier b; b.bar = bar; b.x = xb_xcc_id(); b.st = st;
    if (threadIdx.x == 0) (void)xb_add(&bar[XB_XCNT(b.x)], 1u);
    return b;
}
__device__ __forceinline__ void xcd_barrier_complete(unsigned* bar, unsigned x, unsigned& nloc, unsigned& nx) {
    const unsigned G = gridDim.x * gridDim.y * gridDim.z;
    unsigned sum, cnt, mine, sp = 0u;
    for (;;) {
        sum = 0u; cnt = 0u; mine = 0u;
#pragma unroll
        for (unsigned j = 0; j < 16; ++j) { const unsigned c = xb_ld(&bar[XB_XCNT(j)]); sum += c; cnt += (c > 0u) ? 1u : 0u; mine = (j == x) ? c : mine; }
        if (sum == G) break;
        __builtin_amdgcn_s_sleep(1);
        if ((++sp & 255u) == 0u) { if (xb_ld(&bar[XB_TMO])) break; if (sp > XB_SPIN_CAP) { atomicAdd(&bar[XB_TMO], 1u); break; } }
    }
    nloc = mine > 0u ? mine : 1u; nx = cnt > 0u ? cnt : 1u;
}
__device__ __forceinline__ void xcd_barrier(const XcdBarrier& b) {
    asm volatile("s_waitcnt vmcnt(0)" ::: "memory");
    __syncthreads();
    if (threadIdx.x == 0) {
        unsigned* bar = b.bar;
        __builtin_amdgcn_s_waitcnt(0);
        unsigned nloc = b.st[0], nx = b.st[1];
        if (nloc == 0u) { xcd_barrier_complete(bar, b.x, nloc, nx); b.st[0] = nloc; b.st[1] = nx; }
        const unsigned old = xb_add(&bar[XB_XSUB(b.x)], 1u);
        const unsigned gen = old / nloc;
        if (old + 1u == (gen + 1u) * nloc) {
            __builtin_amdgcn_fence(__ATOMIC_RELEASE, "agent");
            asm volatile("s_waitcnt vmcnt(0)" ::: "memory");
            const unsigned og = xb_add(&bar[XB_TOP], 1u);
            const unsigned tg = og / nx;
            if (og + 1u == (tg + 1u) * nx) xb_add(&bar[XB_TOPGEN], 1u);
            else XB_SPIN(xb_ld(&bar[XB_TOPGEN]) == tg, bar);
            __builtin_amdgcn_fence(__ATOMIC_ACQUIRE, "agent");
            xb_add(&bar[XB_XGEN(b.x)], 1u);
            asm volatile("s_waitcnt vmcnt(0)" ::: "memory");
        } else {
            XB_SPIN(xb_ld(&bar[XB_XGEN(b.x)]) == gen, bar);
            __builtin_amdgcn_fence(__ATOMIC_ACQUIRE, "agent");
            asm volatile("s_waitcnt vmcnt(0)" ::: "memory");
        }
    }
    __syncthreads();
}

__device__ __forceinline__ void gemm_compute_stage(f32x16 (&acc)[2][2], const bf16* Ac, const bf16* Bc, int wm, int wn, int lane) {
#pragma unroll
  for (int kk = 0; kk < 4; kk++) {
    bf16x8 a[2], b[2];
#pragma unroll
    for (int mi = 0; mi < 2; mi++) a[mi] = *(const bf16x8*)(Ac + (wm * 64 + mi * 32 + (lane & 31)) * LDS_ROW + kk * 16 + (lane >> 5) * 8);
#pragma unroll
    for (int ni = 0; ni < 2; ni++) b[ni] = *(const bf16x8*)(Bc + (wn * 64 + ni * 32 + (lane & 31)) * LDS_ROW + kk * 16 + (lane >> 5) * 8);
#pragma unroll
    for (int mi = 0; mi < 2; mi++)
#pragma unroll
      for (int ni = 0; ni < 2; ni++) acc[mi][ni] = __builtin_amdgcn_mfma_f32_32x32x16_bf16(a[mi], b[ni], acc[mi][ni], 0, 0, 0);
  }
}

template <class AL, class BL>
__device__ __forceinline__ void gemm_kloop(f32x16 (&acc)[2][2], AL aload, BL bload, int kt0, int nkt, bf16* smem) {
  const int tid = tidx(), lane = tid & 63, w = tid >> 6;
  const int wm = w >> 1, wn = w & 1;
  const int lr = tid >> 3, lc = tid & 7;
  uint4 a0[4], b0[4], a1[4], b1[4];
  bf16* const buf0 = smem;
  bf16* const buf1 = smem + 2 * STAGE_ELEMS;
#define KL_LOAD(A_, B_, st) { _Pragma("unroll") for (int i = 0; i < 4; i++) { A_[i] = aload(lr + 32 * i, (kt0 + (st)) * 8 + lc); B_[i] = bload(lr + 32 * i, (kt0 + (st)) * 8 + lc); } }
#define KL_STORE(A_, B_, buf) { _Pragma("unroll") for (int i = 0; i < 4; i++) { \
    *(uint4*)((buf) + (lr + 32 * i) * LDS_ROW + lc * 8) = A_[i]; *(uint4*)((buf) + STAGE_ELEMS + (lr + 32 * i) * LDS_ROW + lc * 8) = B_[i]; } }
  KL_LOAD(a0, b0, 0)
  KL_STORE(a0, b0, buf0)
  if (nkt > 1) KL_LOAD(a0, b0, 1)
  if (nkt > 2) KL_LOAD(a1, b1, 2)
  __syncthreads();
  int kt = 0;
  for (; kt + 4 < nkt; kt += 2) {
    KL_STORE(a0, b0, buf1)
    KL_LOAD(a0, b0, kt + 3)
    gemm_compute_stage(acc, buf0, buf0 + STAGE_ELEMS, wm, wn, lane);
    __syncthreads();
    KL_STORE(a1, b1, buf0)
    KL_LOAD(a1, b1, kt + 4)
    gemm_compute_stage(acc, buf1, buf1 + STAGE_ELEMS, wm, wn, lane);
    __syncthreads();
  }
  for (; kt < nkt; kt += 2) {
    if (kt + 1 < nkt) KL_STORE(a0, b0, buf1)
    if (kt + 3 < nkt) KL_LOAD(a0, b0, kt + 3)
    gemm_compute_stage(acc, buf0, buf0 + STAGE_ELEMS, wm, wn, lane);
    __syncthreads();
    if (kt + 1 >= nkt) break;
    if (kt + 2 < nkt) KL_STORE(a1, b1, buf0)
    if (kt + 4 < nkt) KL_LOAD(a1, b1, kt + 4)
    gemm_compute_stage(acc, buf1, buf1 + STAGE_ELEMS, wm, wn, lane);
    __syncthreads();
  }
#undef KL_LOAD
#undef KL_STORE
}

#define TL_ROW 40
#define TL_STAGE (384 * TL_ROW)
__device__ __forceinline__ void gemm_tall_compute(f32x16 (&acc)[2][2][2], const bf16* St, int wm, int wn, int lane) {
  const bf16* Ac = St; const bf16* Bc = St + 256 * TL_ROW;
#pragma unroll
  for (int kk = 0; kk < 2; kk++) {
    bf16x8 a[2][2], b[2];
#pragma unroll
    for (int h = 0; h < 2; h++)
#pragma unroll
      for (int mi = 0; mi < 2; mi++) a[h][mi] = *(const bf16x8*)(Ac + (h * 128 + wm * 64 + mi * 32 + (lane & 31)) * TL_ROW + kk * 16 + (lane >> 5) * 8);
#pragma unroll
    for (int ni = 0; ni < 2; ni++) b[ni] = *(const bf16x8*)(Bc + (wn * 64 + ni * 32 + (lane & 31)) * TL_ROW + kk * 16 + (lane >> 5) * 8);
#pragma unroll
    for (int h = 0; h < 2; h++)
#pragma unroll
      for (int mi = 0; mi < 2; mi++)
#pragma unroll
        for (int ni = 0; ni < 2; ni++) acc[h][mi][ni] = __builtin_amdgcn_mfma_f32_32x32x16_bf16(a[h][mi], b[ni], acc[h][mi][ni], 0, 0, 0);
  }
}
template <class AL, class BL>
__device__ __forceinline__ void gemm_kloop_tall(f32x16 (&acc)[2][2][2], AL aload, BL bload, int nkt, bf16* smem) {
  const int tid = tidx(), lane = tid & 63, w = tid >> 6;
  const int wm = w >> 1, wn = w & 1;
  const int lr = tid >> 2, lc = tid & 3;
  uint4 a0[4], b0[2], a1[4], b1[2];
  bf16* const buf0 = smem;
  bf16* const buf1 = smem + TL_STAGE;
#define TL_LOAD(A_, B_, st) { _Pragma("unroll") for (int i = 0; i < 4; i++) A_[i] = aload(lr + 64 * i, (st) * 4 + lc); \
                              _Pragma("unroll") for (int i = 0; i < 2; i++) B_[i] = bload(lr + 64 * i, (st) * 4 + lc); }
#define TL_STORE(A_, B_, buf) { _Pragma("unroll") for (int i = 0; i < 4; i++) *(uint4*)((buf) + (lr + 64 * i) * TL_ROW + lc * 8) = A_[i]; \
                                _Pragma("unroll") for (int i = 0; i < 2; i++) *(uint4*)((buf) + (256 + lr + 64 * i) * TL_ROW + lc * 8) = B_[i]; }
  TL_LOAD(a0, b0, 0)
  TL_STORE(a0, b0, buf0)
  if (nkt > 1) TL_LOAD(a0, b0, 1)
  if (nkt > 2) TL_LOAD(a1, b1, 2)
  __syncthreads();
  int kt = 0;
  for (; kt + 4 < nkt; kt += 2) {
    TL_STORE(a0, b0, buf1)
    TL_LOAD(a0, b0, kt + 3)
    gemm_tall_compute(acc, buf0, wm, wn, lane);
    __syncthreads();
    TL_STORE(a1, b1, buf0)
    TL_LOAD(a1, b1, kt + 4)
    gemm_tall_compute(acc, buf1, wm, wn, lane);
    __syncthreads();
  }
  for (; kt < nkt; kt += 2) {
    if (kt + 1 < nkt) TL_STORE(a0, b0, buf1)
    if (kt + 3 < nkt) TL_LOAD(a0, b0, kt + 3)
    gemm_tall_compute(acc, buf0, wm, wn, lane);
    __syncthreads();
    if (kt + 1 >= nkt) break;
    if (kt + 2 < nkt) TL_STORE(a1, b1, buf0)
    if (kt + 4 < nkt) TL_LOAD(a1, b1, kt + 4)
    gemm_tall_compute(acc, buf1, wm, wn, lane);
    __syncthreads();
  }
#undef TL_LOAD
#undef TL_STORE
}

template <class AL, class BL>
__device__ __forceinline__ void gemm_kloop_light(f32x16 (&acc)[2][2], AL aload, BL bload, int kt0, int nkt, bf16* smem) {
  const int tid = tidx(), lane = tid & 63, w = tid >> 6;
  const int wm = w >> 1, wn = w & 1;
  const int lr = tid >> 3, lc = tid & 7;
  uint4 a0[4], b0[4];
#define KL_LOAD(A_, B_, st) { _Pragma("unroll") for (int i = 0; i < 4; i++) { A_[i] = aload(lr + 32 * i, (kt0 + (st)) * 8 + lc); B_[i] = bload(lr + 32 * i, (kt0 + (st)) * 8 + lc); } }
#define KL_STORE(A_, B_, buf) { _Pragma("unroll") for (int i = 0; i < 4; i++) { \
    *(uint4*)((buf) + (lr + 32 * i) * LDS_ROW + lc * 8) = A_[i]; *(uint4*)((buf) + STAGE_ELEMS + (lr + 32 * i) * LDS_ROW + lc * 8) = B_[i]; } }
  KL_LOAD(a0, b0, 0)
  KL_STORE(a0, b0, smem)
  if (nkt > 1) KL_LOAD(a0, b0, 1)
  __syncthreads();
  for (int kt = 0; kt < nkt; kt++) {
    bf16* cur = smem + (kt & 1) * 2 * STAGE_ELEMS;
    bf16* nxt = smem + ((kt + 1) & 1) * 2 * STAGE_ELEMS;
    if (kt + 1 < nkt) KL_STORE(a0, b0, nxt)
    if (kt + 2 < nkt) KL_LOAD(a0, b0, kt + 2)
    gemm_compute_stage(acc, cur, cur + STAGE_ELEMS, wm, wn, lane);
    __syncthreads();
  }
#undef KL_LOAD
#undef KL_STORE
}

__device__ __forceinline__ void zero_acc(f32x16 (&acc)[2][2]) {
#pragma unroll
  for (int mi = 0; mi < 2; mi++)
#pragma unroll
    for (int ni = 0; ni < 2; ni++)
#pragma unroll
      for (int r = 0; r < 16; r++) acc[mi][ni][r] = 0.f;
}

#define EPI_ROW(mi, r) (erb + (mi) * 32 + ((r) & 3) + 8 * ((r) >> 2))
#define EPI_BASE int erb = opaque(wm * 64 + 4 * (lane >> 5));
#define EPI_COL(ni) (wn * 64 + (ni) * 32 + (lane & 31))
#define EPI_VARS const int lane = tidx() & 63, w = tidx() >> 6, wm = w >> 1, wn = w & 1;


#define CS_LD 132
template <class F>
__device__ __forceinline__ void epi_rowmajor(const f32x16 (&acc)[2][2], bf16* smem, F f) {
  const int tid = tidx(), lane = tid & 63, w = tid >> 6, wm = w >> 1, wn = w & 1;
  float* Cs = (float*)smem;
#pragma unroll
  for (int mi = 0; mi < 2; mi++)
#pragma unroll
    for (int ni = 0; ni < 2; ni++)
#pragma unroll
      for (int r = 0; r < 16; r++) {
        int row = wm * 64 + mi * 32 + (r & 3) + 8 * (r >> 2) + 4 * (lane >> 5), col = wn * 64 + ni * 32 + (lane & 31);
        Cs[row * CS_LD + col] = acc[mi][ni][r];
      }
  __syncthreads();
#pragma unroll
  for (int it = 0; it < 8; it++) {
    int ch = tid + 256 * it;
    int row = ch >> 4, c8 = (ch & 15) * 8;
    float4 a = *(const float4*)(Cs + row * CS_LD + c8), b = *(const float4*)(Cs + row * CS_LD + c8 + 4);
    float v[8] = {a.x, a.y, a.z, a.w, b.x, b.y, b.z, b.w};
    f(row, c8, v);
  }
  __syncthreads();
}


__device__ __forceinline__ bool tile_swz(int t, int NT, int& mt, int& nt) {
  const int SN = (NT + 7) >> 3;
  {
    const int full = (16 * SN / 8) * 512;
    if ((16 * SN) % 8 == 0 && t >= full) {
      const int x8 = t & 7, jl = (t - full) >> 3;
      mt = 128 + x8; nt = jl;
      return jl < NT;
    }
  }
  const int x = t & 7, q = t >> 3;
  const int sidx = (q >> 6) * 8 + x, loc = q & 63;
  const int sm = sidx / SN, sn = sidx - sm * SN;
  mt = sm * 8 + (loc >> 3); nt = sn * 8 + (loc & 7);
  return (mt < 136) && (nt < NT);
}
#define SWZ_TOTAL(NT) (((17 * (((NT) + 7) >> 3) + 7) >> 3) * 512)

__device__ __forceinline__ void transpose_tile(const float* __restrict__ src, int ldsrc, bf16* __restrict__ dst, int lddst, int k0, int n0, float* lds) {
  const int tid = tidx();
  const int tx = tid & 15, ty = tid >> 4;
#pragma unroll
  for (int i = 0; i < 4; i++) {
    int k = ty + 16 * i;
    float4 v = *(const float4*)(src + (size_t)(k0 + k) * ldsrc + n0 + tx * 4);
    lds[k * 65 + tx * 4 + 0] = v.x; lds[k * 65 + tx * 4 + 1] = v.y; lds[k * 65 + tx * 4 + 2] = v.z; lds[k * 65 + tx * 4 + 3] = v.w;
  }
  __syncthreads();
#pragma unroll
  for (int i = 0; i < 2; i++) {
    int ch = tid + 256 * i;
    int n = ch >> 3, kc = (ch & 7) * 8;
    uint4 o;
    o.x = pack2(lds[(kc + 0) * 65 + n], lds[(kc + 1) * 65 + n]); o.y = pack2(lds[(kc + 2) * 65 + n], lds[(kc + 3) * 65 + n]);
    o.z = pack2(lds[(kc + 4) * 65 + n], lds[(kc + 5) * 65 + n]); o.w = pack2(lds[(kc + 6) * 65 + n], lds[(kc + 7) * 65 + n]);
    *(uint4*)(dst + (size_t)(n0 + n) * lddst + k0 + kc) = o;
  }
  __syncthreads();
}

__device__ __forceinline__ void transpose_job(const float* src, bf16* dst, int K, int N, int batch, float* lds, int jb, int jn) {
  const int tk = K / 64, tn = N / 64;
  const int ntiles = tk * tn * batch;
  for (int t = jb; t < ntiles; t += jn) {
    int b = t / (tk * tn), r = t % (tk * tn);
    int kt = r / tn, nt = r % tn;
    transpose_tile(src + (size_t)b * K * N, N, dst + (size_t)b * K * N, K, kt * 64, nt * 64, lds);
  }
}

__device__ __forceinline__ void convert_job(const float* __restrict__ src, bf16* __restrict__ dst, size_t n, int jb, int jn) {
  size_t n8 = n / 8;
#pragma unroll 4
  for (size_t i = (size_t)jb * 256 + tidx(); i < n8; i += (size_t)jn * 256) {
    float4 a = ((const float4*)src)[2 * i], b = ((const float4*)src)[2 * i + 1];
    uint4 o;
    o.x = pack2(a.x, a.y); o.y = pack2(a.z, a.w); o.z = pack2(b.x, b.y); o.w = pack2(b.z, b.w);
    ((uint4*)dst)[i] = o;
  }
}

__device__ __forceinline__ void convert_fp8_job(const float* __restrict__ src, unsigned char* __restrict__ dst, size_t n, float scale, int jb, int jn) {
  size_t n16 = n / 16;
#pragma unroll 2
  for (size_t i = (size_t)jb * 256 + tidx(); i < n16; i += (size_t)jn * 256) {
    const float4* sp = (const float4*)src + 4 * i;
    unsigned o[4];
#pragma unroll
    for (int q = 0; q < 4; q++) {
      float4 a = sp[q];
      float f0 = fminf(fmaxf(a.x * scale, -448.f), 448.f), f1 = fminf(fmaxf(a.y * scale, -448.f), 448.f);
      float f2 = fminf(fmaxf(a.z * scale, -448.f), 448.f), f3 = fminf(fmaxf(a.w * scale, -448.f), 448.f);
      int wv = 0;
      wv = __builtin_amdgcn_cvt_pk_fp8_f32(f0, f1, wv, false);
      wv = __builtin_amdgcn_cvt_pk_fp8_f32(f2, f3, wv, true);
      o[q] = (unsigned)wv;
    }
    ((uint4*)dst)[i] = make_uint4(o[0], o[1], o[2], o[3]);
  }
}

__device__ __forceinline__ bool light_block(int heavy_x, int& jb, int& jn) {
  const int b = bidx(), g = gdim();
  if ((g & 7) || g < 128) { jb = b; jn = g; return true; }
  {
    const int nh = heavy_x == 1 ? 8 : 16;
    const int jl = b >> 3;
    jn = ((g >> 3) - nh) * 8;
    jb = (jl - nh) * 8 + (b & 7);
    return jl >= nh;
  }
  const int x = b & 7;
  jn = (g >> 3) * (8 - heavy_x);
  jb = (b >> 3) * (8 - heavy_x) + (x - heavy_x);
  return x >= heavy_x;
}

__device__ __forceinline__ void wqk_job(const float* __restrict__ wq, const float* __restrict__ keys, bf16* __restrict__ dst, float* lds, int jb, int jn) {
  float* Ks = lds;
  float* Ws = lds + 64 * 129;
  const int tid = tidx();
  for (int t = jb; t < 32 * 16; t += jn) {
    int n0 = (t / 16) * 64, k0 = (t % 16) * 64;
    int hs = n0 / 128, key0 = n0 % 128;
    for (int i = tid; i < 64 * 128; i += 256) {
      int r = i / 128, d = i % 128;
      Ks[r * 129 + d] = keys[((size_t)hs * 128 + key0 + r) * 128 + d];
      Ws[r * 129 + d] = wq[(size_t)(k0 + r) * 2048 + hs * 128 + d];
    }
    __syncthreads();
    int tx = tid & 15, ty = tid >> 4;
    float acc[4][4];
#pragma unroll
    for (int i = 0; i < 4; i++)
#pragma unroll
      for (int j = 0; j < 4; j++) acc[i][j] = 0.f;
    for (int d = 0; d < 128; d++) {
      float kv[4], wv[4];
#pragma unroll
      for (int i = 0; i < 4; i++) { kv[i] = Ks[(ty * 4 + i) * 129 + d]; wv[i] = Ws[(tx * 4 + i) * 129 + d]; }
#pragma unroll
      for (int i = 0; i < 4; i++)
#pragma unroll
        for (int j = 0; j < 4; j++) acc[i][j] += kv[i] * wv[j];
    }
#pragma unroll
    for (int i = 0; i < 4; i++) {
      uint2 o; o.x = pack2(acc[i][0], acc[i][1]); o.y = pack2(acc[i][2], acc[i][3]);
      *(uint2*)(dst + (size_t)(n0 + ty * 4 + i) * 1024 + k0 + tx * 4) = o;
    }
    __syncthreads();
  }
}

__device__ __forceinline__ void ssm_tables(KP P, int li, float* lds, int jb, int jn) {
  const float* lam_re = P->in[I_LRE] + li * 1024;
  const float* lam_im = P->in[I_LIM] + li * 1024;
  const float* b_re = P->in[I_BRE] + (size_t)li * 16 * 64 * 16;
  const float* b_im = P->in[I_BIM] + (size_t)li * 16 * 64 * 16;
  const float* c_re = P->in[I_CRE] + (size_t)li * 16 * 16 * 64;
  const float* c_im = P->in[I_CIM] + (size_t)li * 16 * 16 * 64;
  const float* log_dt = P->in[I_LDT] + li * 16;
  bf16* Tt = (bf16*)(P->ws + W_TT);
  bf16* Bst = (bf16*)(P->ws + W_BST);
  float* wr = lds; float* wi = lds + 64;
  const int tid = tidx();
  const int NT1 = 16 * 64, NT2 = 16 * 64, NT3 = 16 * 64;
  for (int t = jb; t < NT1 + NT2 + NT3; t += jn) {
    int kind, g, idx;
    if (t < NT1) { kind = 0; g = t / 64; idx = t % 64; }
    else if (t < NT1 + NT2) { kind = 1; g = (t - NT1) / 64; idx = (t - NT1) % 64; }
    else { kind = 2; g = (t - NT1 - NT2) / 64; idx = (t - NT1 - NT2) % 64; }
    int d = (kind == 0) ? idx : (kind == 1 ? idx + 1 : 63 - idx);
    const bool need_coef = (kind != 1);
    if (tid < 64) {
      int n = tid;
      float dt = expf(log_dt[g]);
      float lr = lam_re[g * 64 + n], lim = lam_im[g * 64 + n];
      float ar = lr * dt, ai = lim * dt;
      float dd = (float)(d < 0 ? 0 : d);
      float mag = expf(ar * dd);
      float sn, cs;
      sincosf(ai * dd, &sn, &cs);
      float pr = mag * cs, pi = mag * sn;
      if (need_coef) {
        float m1 = expf(ar); float s1, c1; sincosf(ai, &s1, &c1);
        float nr = m1 * c1 - 1.f, ni = m1 * s1;
        float den = lr * lr + lim * lim;
        float cr = (nr * lr + ni * lim) / den, ci = (ni * lr - nr * lim) / den;
        float xr = pr * cr - pi * ci, xi = pr * ci + pi * cr;
        pr = xr; pi = xi;
      }
      wr[n] = pr; wi[n] = pi;
    }
    __syncthreads();
    if (kind == 0) {
      int p = tid >> 4, q = tid & 15;
      if (d >= 0) {
        float* lcr = lds + 128; float* lci = lcr + 1024; float* lbr = lci + 1024; float* lbi = lbr + 1024;
        for (int i = tid; i < 1024; i += 256) {
          lcr[i] = c_re[(size_t)g * 1024 + i]; lci[i] = c_im[(size_t)g * 1024 + i];
          lbr[i] = b_re[(size_t)g * 1024 + i]; lbi[i] = b_im[(size_t)g * 1024 + i];
        }
        __syncthreads();
        float s = 0.f;
#pragma unroll 8
        for (int n = 0; n < 64; n++) {
          float cr = lcr[p * 64 + n], ci = lci[p * 64 + n];
          float xr = cr * wr[n] - ci * wi[n], xi = cr * wi[n] + ci * wr[n];
          float br = lbr[n * 16 + q], bi = lbi[n * 16 + q];
          s += xr * br - xi * bi;
        }
        Tt[(((size_t)g * 64 + d) * 16 + p) * 16 + q] = f2bf(s);
      }
    } else if (kind == 1) {
      int tt = idx;
      for (int i = tid; i < 2048; i += 256) {
        int p = i >> 7, nn = i & 127, n = nn >> 1, ri = nn & 1;
        float cr = c_re[((size_t)g * 16 + p) * 64 + n], ci = c_im[((size_t)g * 16 + p) * 64 + n];
        float v = ri == 0 ? (cr * wr[n] - ci * wi[n]) : -(cr * wi[n] + ci * wr[n]);
        Tt[KERN_ELEMS + ((size_t)g * 1024 + tt * 16 + p) * 128 + nn] = f2bf(v);
      }
    } else {
      int ss = idx;
      for (int i = tid; i < 2048; i += 256) {
        int nn = i >> 4, q = i & 15, n = nn >> 1, ri = nn & 1;
        float br = b_re[((size_t)g * 64 + n) * 16 + q], bi = b_im[((size_t)g * 64 + n) * 16 + q];
        float v = ri == 0 ? (wr[n] * br - wi[n] * bi) : (wr[n] * bi + wi[n] * br);
        Bst[((size_t)g * 128 + nn) * 1024 + ss * 16 + q] = f2bf(v);
      }
    }
    __syncthreads();
  }
}

__device__ __forceinline__ void pro_misc(KP P, int li, float* lds, int jb, int jn) {
  unsigned char* ws = P->ws;
  transpose_job(P->in[I_WIN] + (size_t)li * 1024 * 5888, (bf16*)(ws + W_IN), 1024, 5888, 1, lds, jb, jn);
  transpose_job(P->in[I_WBS] + (size_t)li * 256 * 1024, (bf16*)(ws + W_BRS), 256, 1024, 1, lds, jb, jn);
  transpose_job(P->in[I_WBA] + (size_t)li * 512 * 1024, (bf16*)(ws + W_BRA), 512, 1024, 1, lds, jb, jn);
  transpose_job(P->in[I_WBR] + (size_t)li * 256 * 1024, (bf16*)(ws + W_BRR), 256, 1024, 1, lds, jb, jn);
  transpose_job(P->in[I_WO] + (size_t)li * 1024 * 1024, (bf16*)(ws + W_O), 1024, 1024, 1, lds, jb, jn);
  transpose_job(P->in[I_WGLU] + (size_t)li * 256 * 256, (bf16*)(ws + W_GLU), 256, 256, 1, lds, jb, jn);
  wqk_job(P->in[I_WQ] + (size_t)li * 1024 * 2048, P->in[I_KEYS] + (size_t)li * 16 * 128 * 128, (bf16*)(ws + W_QK), lds, jb, jn);
  ssm_tables(P, li, lds, jb, jn);
}
__device__ __forceinline__ void pro_cache(KP P, int li, float* lds, int jb, int jn) {
  unsigned char* ws = P->ws;
  transpose_job(P->in[I_CV] + (size_t)li * 16 * 512 * 512, (bf16*)(ws + W_CVT), 512, 512, 16, lds, jb, jn);
  convert_job(P->in[I_CK] + (size_t)li * 16 * 512 * 512, (bf16*)(ws + W_CK), 16ull * 512 * 512, jb, jn);
}

__device__ __forceinline__ void phase_prologue(KP P, int li, bf16* smem) {
  float* lds = (float*)smem;
  unsigned char* ws = P->ws;
  pro_misc(P, li, lds, bidx(), gdim());
  pro_cache(P, li, lds, bidx(), gdim());
  if (li == 0) {
    convert_job(P->in[I_XP], (bf16*)(ws + W_X), (size_t)NPTOK * 1024, bidx(), gdim());
    convert_job(P->in[I_XS], (bf16*)(ws + W_X) + (size_t)NPTOK * 1024, 1024ull * 1024, bidx(), gdim());
    float2* rope = (float2*)(ws + W_ROPE);
    for (int i = bidx() * 256 + tidx(); i < 4096 * 32; i += gdim() * 256) {
      int pos = i >> 5, j = i & 31;
      float freq = expf(-(float)j * (9.210340371976184f / 32.f));
      float ang = (float)pos * freq;
      float sn, cs; sincosf(ang, &sn, &cs);
      rope[i] = make_float2(cs, sn);
    }
  }
}

__device__ __forceinline__ void phase_gemm_in(KP P, int li, bf16* smem) {
  EPI_VARS
  const bf16* X = (const bf16*)(P->ws + W_X);
  const bf16* Wt = (const bf16*)(P->ws + W_IN);
  bf16* H = (bf16*)(P->ws + W_H);
  bf16* HT = (bf16*)(P->ws + W_HT);
  const float2* rope = (const float2*)(P->ws + W_ROPE);
  float* out = P->out;
  for (int t = bidx(); t < 7 * 512; t += gdim()) {
    const int x_ = t & 7, q_ = t >> 3;
    const int loc_ = q_ & 63;
    const int sidx_ = ((q_ >> 6) * 8 + x_) * 2 + (loc_ >> 5);
    if (sidx_ >= 17 * 6) continue;
    const int sm_ = sidx_ / 6, sn_ = sidx_ - sm_ * 6;
    const int mt2 = sm_ * 4 + ((loc_ & 31) >> 3), nt = sn_ * 8 + (loc_ & 7);
    if (nt >= 46) continue;
    const int n0 = nt * 128;
    f32x16 acc2[2][2][2];
    zero_acc(acc2[0]); zero_acc(acc2[1]);
    {
      const bf16* Ab = X + (size_t)mt2 * 256 * 1024;
      const bf16* Bb = Wt + (size_t)n0 * 1024;
      gemm_kloop_tall(acc2,
        [&](int r, int kc) { return *(const uint4*)(Ab + (size_t)r * 1024 + kc * 8); },
        [&](int r, int kc) { return *(const uint4*)(Bb + (size_t)r * 1024 + kc * 8); }, 32, smem);
    }
   auto epilogue = [&](f32x16 (&acc)[2][2], const int m0) {
    EPI_BASE
    const int cb = n0 + wn * 64;
    if (cb >= C_QRET && cb < C_VRET) {
      const float sc = (cb < C_KRET) ? 0.125f : 1.f;
#pragma unroll
      for (int mi = 0; mi < 2; mi++)
#pragma unroll
        for (int r = 0; r < 16; r++) {
          int row = m0 + EPI_ROW(mi, r);
          int pos = row < NPTOK ? (row & 4095) : 2048 + ((row - NPTOK) & 63);
          float2 cs = rope[pos * 32 + (lane & 31)];
          float x1 = acc[mi][0][r], x2 = acc[mi][1][r];
          acc[mi][0][r] = (x1 * cs.x - x2 * cs.y) * sc;
          acc[mi][1][r] = (x1 * cs.y + x2 * cs.x) * sc;
        }
    }
    if (cb >= C_KATT && cb < C_QRET) {
      const bool isv = cb >= C_VATT;
      const int c0 = isv ? C_VATT : C_KATT;
#pragma unroll
      for (int mi = 0; mi < 2; mi++)
#pragma unroll
        for (int r = 0; r < 16; r++) {
          int row = m0 + EPI_ROW(mi, r);
#pragma unroll
          for (int ni = 0; ni < 2; ni++) {
            int col = n0 + EPI_COL(ni) - c0;
            if (row < NPTOK) {
              int b = row >> 12, tt = row & 4095;
              if (tt >= 3584) out[(isv ? O_AV_P : O_AK_P) + (((size_t)(li * 4 + b) * 512 + (tt - 3584)) * 512 + col)] = acc[mi][ni][r];
            } else {
              int rs = row - NPTOK;
              out[(isv ? O_AV_S : O_AK_S) + ((size_t)li * 1024 + rs) * 512 + col] = acc[mi][ni][r];
            }
          }
        }
    }
    int trow = -1;
    if (cb >= C_VATT && cb < C_QRET) trow = cb - C_VATT;
    else if (cb >= C_KRET && cb < C_VRET) trow = 512 + cb - C_KRET;
    else if (cb >= C_VRET && cb < C_GRET) trow = 768 + cb - C_VRET;
    if (trow >= 0) {
#pragma unroll
      for (int mi = 0; mi < 2; mi++)
#pragma unroll
        for (int ni = 0; ni < 2; ni++)
#pragma unroll
          for (int rg = 0; rg < 4; rg++) {
            int rowb = m0 + wm * 64 + mi * 32 + 8 * rg + 4 * (lane >> 5);
            uint2 o; o.x = pack2(acc[mi][ni][rg * 4], acc[mi][ni][rg * 4 + 1]); o.y = pack2(acc[mi][ni][rg * 4 + 2], acc[mi][ni][rg * 4 + 3]);
            *(uint2*)(HT + (size_t)(trow + ni * 32 + (lane & 31)) * NTOK + rowb) = o;
          }
    }
    const bool skipH = (n0 >= C_VATT && n0 < C_QRET) || (n0 >= C_VRET && n0 < C_GRET);
    if (!skipH) epi_rowmajor(acc, smem, [&](int row, int c8, float (&v)[8]) {
      uint4 o; o.x = pack2(v[0], v[1]); o.y = pack2(v[2], v[3]); o.z = pack2(v[4], v[5]); o.w = pack2(v[6], v[7]);
      *(uint4*)(H + (size_t)(m0 + row) * INC + n0 + c8) = o;
    });
   };
   epilogue(acc2[0], mt2 * 256);
   epilogue(acc2[1], mt2 * 256 + 128);
  }
}

#define AP_LD 72
__device__ __forceinline__ void attn_item(KP P, int li, int item, bf16* smem) {
  float* bias = (float*)smem;
  bf16* pbuf = smem + 2048;
  const bf16* H = (const bf16*)(P->ws + W_H);
  const bf16* HT = (const bf16*)(P->ws + W_HT);
  bf16* Yatt = (bf16*)(P->ws + W_YATT);
  const int h = item & 7, cidx = item >> 3;
  const float* tab = P->in[I_BIAS] + (size_t)li * 513 * 8;
  const int tid = opaque(tidx());
  const int lane = tid & 63, w = tid >> 6, l15 = lane & 15, g = lane >> 4;
  __syncthreads();
  for (int i = tid; i < 640; i += 256) bias[i] = tab[(min(i - 63, 256) + 256) * 8 + h];
  const int row0 = cidx * 64;
  const bf16* Qp = H + (size_t)(row0 + w * 16) * INC + C_QATT + h * 64;
  const bf16* Kcur = H + (size_t)row0 * INC + C_KATT + h * 64;
  const bf16* VTcur = HT + (size_t)(h * 64) * NTOK + row0;
  bf16* Yout = Yatt + (size_t)(row0 + w * 16) * 512 + h * 64;
  const bf16* Kpast; const bf16* VTpast; int kst; size_t vst; int jt_start, smin;
  if (cidx < 256) {
    int c = cidx & 63;
    jt_start = c >= 8 ? 0 : 32 - 4 * c;
    smin = c >= 8 ? 0 : 8 - c;
    Kpast = Kcur - (ptrdiff_t)512 * INC; kst = INC;
    VTpast = VTcur - 512; vst = NTOK;
  } else {
    int b = cidx - 256;
    jt_start = 0; smin = 0;
    Kpast = (const bf16*)(P->ws + W_CK) + (size_t)b * 512 * 512 + h * 64; kst = 512;
    VTpast = (const bf16*)(P->ws + W_CVT) + (size_t)b * 512 * 512 + (size_t)(h * 64) * 512; vst = 512;
  }
  const int lr = tid >> 2, lc = (tid & 3) * 16;
  bf16x8 qf[2];
#pragma unroll
  for (int ks = 0; ks < 2; ks++) qf[ks] = u4_to_frag(*(const uint4*)(Qp + (size_t)l15 * INC + ks * 32 + g * 8));
  uint4 r0a, r0b, r1a, r1b, r2a, r2b;
#define AP_LOAD(p, va, vb) { const int step_ = ((p) < 9) ? (p) : (p) - 9; const int se_ = max(step_, smin); const bf16* src_; \
    if ((p) < 9) src_ = (se_ < 8) ? (Kpast + (ptrdiff_t)(se_ * 64 + lr) * kst) : (Kcur + (size_t)lr * INC); \
    else src_ = (se_ < 8) ? (VTpast + (size_t)lr * vst + se_ * 64) : (VTcur + (size_t)lr * NTOK); \
    va = *(const uint4*)(src_ + lc); vb = *(const uint4*)(src_ + lc + 8); }
#define AP_STORE(p, va, vb) { bf16* dst_ = pbuf + ((p) & 1) * (64 * AP_LD) + lr * AP_LD + lc; *(uint4*)dst_ = va; *(uint4*)(dst_ + 8) = vb; }
  AP_LOAD(0, r0a, r0b) AP_LOAD(1, r1a, r1b) AP_LOAD(2, r2a, r2b)
  AP_STORE(0, r0a, r0b)
  __syncthreads();
  f32x4 s[36];
#pragma unroll
  for (int p = 0; p < 9; p++) {
    const bf16* pc = pbuf + (p & 1) * (64 * AP_LD);
#pragma unroll
    for (int t = 0; t < 4; t++) {
      const int jt = p * 4 + t;
      s[jt] = f32x4{0.f, 0.f, 0.f, 0.f};
#pragma unroll
      for (int ks = 0; ks < 2; ks++) {
        bf16x8 kf = *(const bf16x8*)(pc + (t * 16 + l15) * AP_LD + ks * 32 + g * 8);
        s[jt] = __builtin_amdgcn_mfma_f32_16x16x32_bf16(kf, qf[ks], s[jt], 0, 0, 0);
      }
    }
    AP_STORE(p + 1, r1a, r1b)
    r1a = r2a; r1b = r2b;
    AP_LOAD(p + 3, r2a, r2b)
    __syncthreads();
  }
  float inv;
  {
    const int iq = w * 16 + l15;
    const float* bq = bias + (iq - 4 * g + 575);
    float mx = -3.0e38f;
#pragma unroll
    for (int jt = 0; jt < 36; jt++) {
#pragma unroll
      for (int r = 0; r < 4; r++) {
        float v = s[jt][r] * 0.125f + bq[-(jt * 16 + r)];
        if (jt < 32) v = (jt < jt_start) ? -3.0e38f : v;
        s[jt][r] = v;
        mx = fmaxf(mx, v);
      }
    }
    mx = fmaxf(mx, __shfl_xor(mx, 16));
    mx = fmaxf(mx, __shfl_xor(mx, 32));
    float sum = 0.f;
#pragma unroll
    for (int jt = 0; jt < 36; jt++) {
#pragma unroll
      for (int r = 0; r < 4; r++) { float e = __expf(s[jt][r] - mx); s[jt][r] = e; sum += e; }
    }
    sum += __shfl_xor(sum, 16);
    sum += __shfl_xor(sum, 32);
    inv = 1.f / sum;
  }
  f32x4 o[4];
#pragma unroll
  for (int et = 0; et < 4; et++) o[et] = f32x4{0.f, 0.f, 0.f, 0.f};
#pragma unroll
  for (int p = 9; p < 18; p++) {
    const bf16* pc = pbuf + (p & 1) * (64 * AP_LD);
    const int step = p - 9;
#pragma unroll
    for (int u = 0; u < 2; u++) {
      const int kk = step * 2 + u;
      union { uint4 u4; bf16x8 f; } pf;
      pf.u4.x = pack2(s[2 * kk][0], s[2 * kk][1]); pf.u4.y = pack2(s[2 * kk][2], s[2 * kk][3]);
      pf.u4.z = pack2(s[2 * kk + 1][0], s[2 * kk + 1][1]); pf.u4.w = pack2(s[2 * kk + 1][2], s[2 * kk + 1][3]);
#pragma unroll
      for (int et = 0; et < 4; et++) {
        const bf16* vp = pc + (et * 16 + l15) * AP_LD + u * 32 + 4 * g;
        union { uint4 u4; bf16x8 f; } vf;
        uint2 a = *(const uint2*)vp, b = *(const uint2*)(vp + 16);
        vf.u4.x = a.x; vf.u4.y = a.y; vf.u4.z = b.x; vf.u4.w = b.y;
        o[et] = __builtin_amdgcn_mfma_f32_16x16x32_bf16(vf.f, pf.f, o[et], 0, 0, 0);
      }
    }
    if (p + 1 < 18) { AP_STORE(p + 1, r1a, r1b) }
    r1a = r2a; r1b = r2b;
    if (p + 3 < 18) { AP_LOAD(p + 3, r2a, r2b) }
    __syncthreads();
  }
#pragma unroll
  for (int et = 0; et < 4; et++) {
    uint2 ov; ov.x = pack2(o[et][0] * inv, o[et][1] * inv); ov.y = pack2(o[et][2] * inv, o[et][3] * inv);
    *(uint2*)(Yout + (size_t)l15 * 512 + et * 16 + 4 * g) = ov;
  }
}

__device__ __forceinline__ void ret_contrib_item(KP P, int item) {
  const bf16* HT = (const bf16*)(P->ws + W_HT);
  float* CT = (float*)(P->ws + W_CT);
  const int h = item & 3, cidx = item >> 2;
  const int lane = opaque(tidx() & 63), w = tidx() >> 6, l15 = lane & 15, g = lane >> 4;
  const float lg2 = log2f(1.f - exp2f(-5.f - (float)h));
  const int tok0 = cidx * 64;
  f32x4 acc[4];
#pragma unroll
  for (int dt = 0; dt < 4; dt++) acc[dt] = f32x4{0.f, 0.f, 0.f, 0.f};
#pragma unroll
  for (int ks = 0; ks < 2; ks++) {
    uint4 vr = *(const uint4*)(HT + (size_t)(768 + h * 64 + w * 16 + l15) * NTOK + tok0 + ks * 32 + g * 8);
    unsigned vv[4] = {vr.x, vr.y, vr.z, vr.w};
    union { uint4 u; bf16x8 f; } vf;
    unsigned oo[4];
#pragma unroll
    for (int q = 0; q < 4; q++) {
      int j = ks * 32 + g * 8 + 2 * q;
      float k0 = exp2f(lg2 * (float)(63 - j)), k1 = exp2f(lg2 * (float)(62 - j));
      oo[q] = pack2(bflo(vv[q]) * k0, bfhi(vv[q]) * k1);
    }
    vf.u = make_uint4(oo[0], oo[1], oo[2], oo[3]);
#pragma unroll
    for (int dt = 0; dt < 4; dt++) {
      bf16x8 kf = u4_to_frag(*(const uint4*)(HT + (size_t)(512 + h * 64 + dt * 16 + l15) * NTOK + tok0 + ks * 32 + g * 8));
      acc[dt] = __builtin_amdgcn_mfma_f32_16x16x32_bf16(vf.f, kf, acc[dt], 0, 0, 0);
    }
  }
#pragma unroll
  for (int dt = 0; dt < 4; dt++)
#pragma unroll
    for (int r = 0; r < 4; r++) {
      int e = w * 16 + 4 * g + r, d = dt * 16 + l15;
      CT[((size_t)(cidx * 4 + h) * 64 + e) * 64 + d] = acc[dt][r];
    }
}

__device__ __forceinline__ void ssm_state_tile(KP P, int t, bf16* smem) {
  EPI_VARS
  const bf16* H = (const bf16*)(P->ws + W_H);
  const bf16* Bst = (const bf16*)(P->ws + W_BST);
  float* SC = (float*)(P->ws + W_SC);
  const int g = t / 3, mt = t % 3;
  const int m0 = mt * 128;
  f32x16 acc[2][2];
  zero_acc(acc);
  const bf16* Bb = Bst + (size_t)g * 128 * 1024;
  gemm_kloop(acc,
    [&](int r, int kc) { int c = min(m0 + r, NCHUNK - 1); int s = kc >> 1, q0 = (kc & 1) * 8;
                         return *(const uint4*)(H + (size_t)(c * 64 + s) * INC + g * 16 + q0); },
    [&](int r, int kc) { return *(const uint4*)(Bb + (size_t)r * 1024 + kc * 8); }, 0, 16, smem);
    EPI_BASE
#pragma unroll
  for (int mi = 0; mi < 2; mi++)
#pragma unroll
    for (int ni = 0; ni < 2; ni++)
#pragma unroll
      for (int r = 0; r < 16; r++) {
        int c = m0 + EPI_ROW(mi, r), nn = EPI_COL(ni);
        if (c < NCHUNK) SC[((size_t)c * 16 + g) * 128 + nn] = acc[mi][ni][r];
      }
}

__device__ __forceinline__ void phase_A(KP P, int li, bf16* smem) {
  const int n_attn = NCHUNK * 8, n_ret = NCHUNK * 4, n_ssm = 48;
  const int total = n_attn + n_ret + n_ssm;
  for (int t = bidx(); t < total; t += gdim()) {
    if (t < n_ssm) ssm_state_tile(P, t, smem);
    else if (t < n_ssm + n_attn) attn_item(P, li, t - n_ssm, smem);
    else ret_contrib_item(P, t - n_ssm - n_attn);
  }
}

__device__ __forceinline__ void phase_B(KP P, int li) {
  const float* CT = (const float*)(P->ws + W_CT);
  bf16* SP = (bf16*)(P->ws + W_SPREV);
  const float* SC = (const float*)(P->ws + W_SC);
  bf16* HS = (bf16*)(P->ws + W_HS);
  float* out = P->out;
  const int gt = bidx() * 256 + tidx(), gn = gdim() * 256;
  for (int i = gt; i < 65536; i += gn) {
    int ed = i & 4095, h = (i >> 12) & 3, b = i >> 14;
    float g64 = exp2f(64.f * log2f(1.f - exp2f(-5.f - (float)h)));
    float S = 0.f;
    for (int c0 = 0; c0 < 64; c0 += 16) {
      float ct[16];
#pragma unroll
      for (int u = 0; u < 16; u++) ct[u] = CT[((size_t)((b * 64 + c0 + u) * 4 + h)) * 4096 + ed];
#pragma unroll
      for (int u = 0; u < 16; u++) {
        SP[((size_t)((b * 64 + c0 + u) * 4 + h)) * 4096 + ed] = f2bf(S);
        S = g64 * S + ct[u];
      }
    }
    int e = ed >> 6, d = ed & 63;
    out[O_RET_P + ((size_t)((li * 4 + b) * 4 + h)) * 4096 + d * 64 + e] = S;
  }
  for (int i = gt; i < 262144; i += gn) {
    int ed = i & 4095, h = (i >> 12) & 3, b = i >> 14;
    int e = ed >> 6, d = ed & 63;
    float g64 = exp2f(64.f * log2f(1.f - exp2f(-5.f - (float)h)));
    size_t sidx = ((size_t)((li * 16 + b) * 4 + h)) * 4096 + d * 64 + e;
    float S = P->in[I_SRET][sidx];
    size_t idx = ((size_t)((256 + b) * 4 + h)) * 4096 + ed;
    SP[idx] = f2bf(S);
    S = g64 * S + CT[idx];
    out[O_RET_S + sidx] = S;
  }
  for (int i = gt; i < 4096 + 16384; i += gn) {
    const bool prompt = i < 4096;
    int j = prompt ? i : i - 4096;
    int n = j & 63, g = (j >> 6) & 15, b = j >> 10;
    float dt = expf(P->in[I_LDT][li * 16 + g]);
    float ar = P->in[I_LRE][li * 1024 + g * 64 + n] * dt, ai = P->in[I_LIM][li * 1024 + g * 64 + n] * dt;
    float mag = expf(ar * 64.f); float sn, cs; sincosf(ai * 64.f, &sn, &cs);
    float a_r = mag * cs, a_i = mag * sn;
    if (prompt) {
      float hr = 0.f, hi = 0.f;
      for (int c0 = 0; c0 < 64; c0 += 16) {
        float2 cc[16];
#pragma unroll
        for (int u = 0; u < 16; u++) cc[u] = *(const float2*)(SC + ((size_t)(b * 64 + c0 + u) * 16 + g) * 128 + n * 2);
#pragma unroll
        for (int u = 0; u < 16; u++) {
          size_t idx = ((size_t)(b * 64 + c0 + u) * 16 + g) * 128 + n * 2;
          *(unsigned*)(HS + idx) = pack2(hr, hi);
          float nr = a_r * hr - a_i * hi + cc[u].x, ni = a_r * hi + a_i * hr + cc[u].y;
          hr = nr; hi = ni;
        }
      }
      out[O_SRE_P + ((size_t)(li * 4 + b) * 16 + g) * 64 + n] = hr;
      out[O_SIM_P + ((size_t)(li * 4 + b) * 16 + g) * 64 + n] = hi;
    } else {
      size_t sidx = ((size_t)(li * 16 + b) * 16 + g) * 64 + n;
      float hr = P->in[I_SRE][sidx], hi = P->in[I_SIM][sidx];
      size_t idx = ((size_t)(256 + b) * 16 + g) * 128 + n * 2;
      *(unsigned*)(HS + idx) = pack2(hr, hi);
      float cr = SC[idx], ci = SC[idx + 1];
      out[O_SRE_S + sidx] = a_r * hr - a_i * hi + cr;
      out[O_SIM_S + sidx] = a_r * hi + a_i * hr + ci;
    }
  }
}

__device__ __forceinline__ void ret_finish_item(KP P, int li, int item) {
  const bf16* H = (const bf16*)(P->ws + W_H);
  const bf16* HT = (const bf16*)(P->ws + W_HT);
  const bf16* SP = (const bf16*)(P->ws + W_SPREV);
  bf16* Yret = (bf16*)(P->ws + W_YRET);
  const float* gng = P->in[I_GNG] + li * 256;
  const int h = item & 3, cidx = item >> 2;
  const int lane = opaque(tidx() & 63), w = tidx() >> 6, l15 = lane & 15, g = lane >> 4;
  const float lg2 = log2f(1.f - exp2f(-5.f - (float)h));
  const int row0 = cidx * 64;
  const int iq = w * 16 + l15;
  bf16x8 qf[2];
#pragma unroll
  for (int ks = 0; ks < 2; ks++) qf[ks] = u4_to_frag(*(const uint4*)(H + (size_t)(row0 + iq) * INC + C_QRET + h * 64 + ks * 32 + g * 8));
  f32x4 s[4];
#pragma unroll
  for (int jt = 0; jt < 4; jt++) {
    s[jt] = f32x4{0.f, 0.f, 0.f, 0.f};
#pragma unroll
    for (int ks = 0; ks < 2; ks++) {
      bf16x8 kf = u4_to_frag(*(const uint4*)(H + (size_t)(row0 + jt * 16 + l15) * INC + C_KRET + h * 64 + ks * 32 + g * 8));
      s[jt] = __builtin_amdgcn_mfma_f32_16x16x32_bf16(kf, qf[ks], s[jt], 0, 0, 0);
    }
#pragma unroll
    for (int r = 0; r < 4; r++) {
      int j = jt * 16 + 4 * g + r;
      int dd = iq - j; dd = dd < 0 ? -dd : dd;
      s[jt][r] *= exp2f(lg2 * (float)dd);
    }
  }
  f32x4 o[4], oi[4];
#pragma unroll
  for (int et = 0; et < 4; et++) { o[et] = f32x4{0.f, 0.f, 0.f, 0.f}; oi[et] = f32x4{0.f, 0.f, 0.f, 0.f}; }
#pragma unroll
  for (int kk = 0; kk < 2; kk++) {
    union { uint4 u; bf16x8 f; } pf;
    pf.u.x = pack2(s[2 * kk][0], s[2 * kk][1]); pf.u.y = pack2(s[2 * kk][2], s[2 * kk][3]);
    pf.u.z = pack2(s[2 * kk + 1][0], s[2 * kk + 1][1]); pf.u.w = pack2(s[2 * kk + 1][2], s[2 * kk + 1][3]);
#pragma unroll
    for (int et = 0; et < 4; et++) {
      const bf16* vp = HT + (size_t)(768 + h * 64 + et * 16 + l15) * NTOK + row0 + kk * 32 + 4 * g;
      union { uint4 u; bf16x8 f; } vf;
      uint2 a = *(const uint2*)vp, b = *(const uint2*)(vp + 16);
      vf.u.x = a.x; vf.u.y = a.y; vf.u.z = b.x; vf.u.w = b.y;
      o[et] = __builtin_amdgcn_mfma_f32_16x16x32_bf16(vf.f, pf.f, o[et], 0, 0, 0);
    }
  }
#pragma unroll
  for (int ks = 0; ks < 2; ks++)
#pragma unroll
    for (int et = 0; et < 4; et++) {
      bf16x8 sf = u4_to_frag(*(const uint4*)(SP + ((size_t)(cidx * 4 + h) * 64 + et * 16 + l15) * 64 + ks * 32 + g * 8));
      oi[et] = __builtin_amdgcn_mfma_f32_16x16x32_bf16(sf, qf[ks], oi[et], 0, 0, 0);
    }
  const float qw = exp2f(lg2 * (float)(iq + 1));
  float sum = 0.f;
#pragma unroll
  for (int et = 0; et < 4; et++)
#pragma unroll
    for (int r = 0; r < 4; r++) { o[et][r] += qw * oi[et][r]; sum += o[et][r]; }
  sum += __shfl_xor(sum, 16); sum += __shfl_xor(sum, 32);
  const float mu = sum * (1.f / 64.f);
  float vs = 0.f;
#pragma unroll
  for (int et = 0; et < 4; et++)
#pragma unroll
    for (int r = 0; r < 4; r++) { float d = o[et][r] - mu; vs += d * d; }
  vs += __shfl_xor(vs, 16); vs += __shfl_xor(vs, 32);
  const float rstd = rsqrtf(vs * (1.f / 64.f) + LN_EPS);
#pragma unroll
  for (int et = 0; et < 4; et++) {
    int e0 = et * 16 + 4 * g;
    uint2 gr = *(const uint2*)(H + (size_t)(row0 + iq) * INC + C_GRET + h * 64 + e0);
    float gv[4] = {bflo(gr.x), bfhi(gr.x), bflo(gr.y), bfhi(gr.y)};
    float y[4];
#pragma unroll
    for (int r = 0; r < 4; r++) {
      float gg = gv[r];
      y[r] = (o[et][r] - mu) * rstd * gng[h * 64 + e0 + r] * (gg * sigmoidf_(gg));
    }
    uint2 ov; ov.x = pack2(y[0], y[1]); ov.y = pack2(y[2], y[3]);
    *(uint2*)(Yret + (size_t)(row0 + iq) * 256 + h * 64 + e0) = ov;
  }
}

__device__ __forceinline__ void ssm_toep_tile(KP P, int li, int t, bf16* smem) {
  EPI_VARS
  const bf16* H = (const bf16*)(P->ws + W_H);
  const bf16* Tt = (const bf16*)(P->ws + W_TT);
  const bf16* HS = (const bf16*)(P->ws + W_HS);
  bf16* Zs = (bf16*)(P->ws + W_CT);
  const float* dsk = P->in[I_SD] + li * 256;
  const int g = t / 24, r24 = t % 24, mt = r24 / 8, nt = r24 % 8;
  const int m0 = mt * 128, n0 = nt * 128;
  f32x16 acc[2][2];
  zero_acc(acc);
  const bf16* Kg = Tt + (size_t)g * 64 * 256;
  const bf16* Cg = Tt + KERN_ELEMS + ((size_t)g * 1024 + n0) * 128;
  auto al = [&](int r, int kc) {
    int c = min(m0 + r, NCHUNK - 1);
    if (kc < 128) { int s = kc >> 1, q0 = (kc & 1) * 8; return *(const uint4*)(H + (size_t)(c * 64 + s) * INC + g * 16 + q0); }
    return *(const uint4*)(HS + ((size_t)c * 16 + g) * 128 + (kc - 128) * 8);
  };
  auto bl = [&](int r, int kc) {
    if (kc < 128) {
      int n = n0 + r, tt = n >> 4, p = n & 15, ss = kc >> 1, q0 = (kc & 1) * 8;
      int d = tt - ss;
      uint4 v = *(const uint4*)(Kg + ((size_t)max(d, 0) * 16 + p) * 16 + q0);
      if (d < 0) v = make_uint4(0u, 0u, 0u, 0u);
      return v;
    }
    return *(const uint4*)(Cg + (size_t)r * 128 + (kc - 128) * 8);
  };
  gemm_kloop(acc, al, bl, 0, 2 * (nt + 1), smem);
  gemm_kloop(acc, al, bl, 16, 2, smem);
    EPI_BASE
#pragma unroll
  for (int mi = 0; mi < 2; mi++)
#pragma unroll
    for (int ni = 0; ni < 2; ni++)
#pragma unroll
      for (int r = 0; r < 16; r++) {
        int c = m0 + EPI_ROW(mi, r), n = n0 + EPI_COL(ni);
        if (c < NCHUNK) {
          int tt = n >> 4, p = n & 15;
          size_t tok = (size_t)c * 64 + tt;
          float u = bf2f(H[tok * INC + g * 16 + p]);
          float y = acc[mi][ni][r] + dsk[g * 16 + p] * u;
          Zs[tok * 256 + g * 16 + p] = f2bf(gelu_tanh(y));
        }
      }
}

__device__ __forceinline__ void phase_C(KP P, int li, bf16* smem) {
  const int n_toep = 16 * 24, n_ret = NCHUNK * 4;
  for (int t = bidx(); t < n_toep + n_ret; t += gdim()) {
    if (t < n_toep) ssm_toep_tile(P, li, t, smem);
    else ret_finish_item(P, li, t - n_toep);
  }
}

__device__ __forceinline__ void phase_D(KP P, int li, bf16* smem) {
  EPI_VARS
  const bf16* Zs = (const bf16*)(P->ws + W_CT);
  const bf16* Wt = (const bf16*)(P->ws + W_GLU);
  bf16* Yssm = (bf16*)(P->ws + W_YSSM);
  const float* bg = P->in[I_BGLU] + li * 256;
  for (int t = bidx(); t < 136 * 2; t += gdim()) {
    const int m0 = (t >> 1) * 128, n0 = (t & 1) * 128;
    f32x16 acc[2][2];
    zero_acc(acc);
    const bf16* Ab = Zs + (size_t)m0 * 256;
    const bf16* Bb = Wt + (size_t)n0 * 256;
    gemm_kloop(acc,
      [&](int r, int kc) { return *(const uint4*)(Ab + (size_t)r * 256 + kc * 8); },
      [&](int r, int kc) { return *(const uint4*)(Bb + (size_t)r * 256 + kc * 8); }, 0, 4, smem);
    EPI_BASE
#pragma unroll
    for (int mi = 0; mi < 2; mi++)
#pragma unroll
      for (int ni = 0; ni < 2; ni++)
#pragma unroll
        for (int r = 0; r < 16; r++) {
          int row = m0 + EPI_ROW(mi, r), col = n0 + EPI_COL(ni);
          float z = bf2f(Zs[(size_t)row * 256 + col]);
          Yssm[(size_t)row * 256 + col] = f2bf(z * sigmoidf_(acc[mi][ni][r] + bg[col]));
        }
  }
}

__device__ __forceinline__ void phase_E(KP P, int li, bf16* smem) {
  EPI_VARS
  const bf16* H = (const bf16*)(P->ws + W_H);
  bf16* MG = (bf16*)(P->ws + W_HT);
  for (int t = bidx(); t < SWZ_TOTAL(8); t += gdim()) {
    int mt_, nt_;
    if (!tile_swz(t, 8, mt_, nt_)) continue;
    const int m0 = mt_ * 128, n0 = nt_ * 128;
    f32x16 tot[2][2];
    zero_acc(tot);
#pragma unroll 1
    for (int br = 0; br < 3; br++) {
      const bf16* Y = (const bf16*)(P->ws + (br == 0 ? W_YSSM : (br == 1 ? W_YATT : W_YRET)));
      const bf16* Wt = (const bf16*)(P->ws + (br == 0 ? W_BRS : (br == 1 ? W_BRA : W_BRR)));
      const int K = (br == 1) ? 512 : 256;
      f32x16 acc[2][2];
      zero_acc(acc);
      const bf16* Ab = Y + (size_t)m0 * K;
      const bf16* Bb = Wt + (size_t)n0 * K;
      gemm_kloop_light(acc,
        [&](int r, int kc) { return *(const uint4*)(Ab + (size_t)r * K + kc * 8); },
        [&](int r, int kc) { return *(const uint4*)(Bb + (size_t)r * K + kc * 8); }, 0, K / 64, smem);
#pragma unroll
      for (int mi = 0; mi < 2; mi++)
#pragma unroll
        for (int ni = 0; ni < 2; ni++) {
          EPI_BASE
#pragma unroll
          for (int r = 0; r < 16; r++) {
            int row = m0 + EPI_ROW(mi, r), col = n0 + EPI_COL(ni);
            float gt = bf2f(H[(size_t)row * INC + C_GATE + br * 1024 + col]);
            tot[mi][ni][r] += sigmoidf_(gt) * acc[mi][ni][r];
          }
        }
    }
    EPI_BASE
#pragma unroll
    for (int mi = 0; mi < 2; mi++)
#pragma unroll
      for (int ni = 0; ni < 2; ni++)
#pragma unroll
        for (int r = 0; r < 16; r++) {
          int row = m0 + EPI_ROW(mi, r), col = n0 + EPI_COL(ni);
          MG[(size_t)row * 1024 + col] = f2bf(tot[mi][ni][r]);
        }
  }
  { int jb, jn; if (light_block(1, jb, jn)) convert_fp8_job(P->in[I_PU] + (size_t)li * 16384 * 1024, P->ws + W_U, 16384ull * 1024, 256.f, jb, jn); }
}

__device__ __forceinline__ void phase_WO(KP P, int li, bf16* smem) {
  EPI_VARS
  const bf16* MG = (const bf16*)(P->ws + W_HT);
  const bf16* Wt = (const bf16*)(P->ws + W_O);
  const bf16* X = (const bf16*)(P->ws + W_X);
  bf16* Z = (bf16*)(P->ws + W_H);
  for (int t = bidx(); t < SWZ_TOTAL(8); t += gdim()) {
    int mt_, nt_;
    if (!tile_swz(t, 8, mt_, nt_)) continue;
    const int m0 = mt_ * 128, n0 = nt_ * 128;
    f32x16 acc[2][2];
    zero_acc(acc);
    const bf16* Ab = MG + (size_t)m0 * 1024;
    const bf16* Bb = Wt + (size_t)n0 * 1024;
    gemm_kloop(acc,
      [&](int r, int kc) { return *(const uint4*)(Ab + (size_t)r * 1024 + kc * 8); },
      [&](int r, int kc) { return *(const uint4*)(Bb + (size_t)r * 1024 + kc * 8); }, 0, 16, smem);
    EPI_BASE
    epi_rowmajor(acc, smem, [&](int row, int c8, float (&v)[8]) {
      uint4 xr = *(const uint4*)(X + (size_t)(m0 + row) * 1024 + n0 + c8);
      uint4 o;
      o.x = pack2(DN_ALPHA * bflo(xr.x) + v[0], DN_ALPHA * bfhi(xr.x) + v[1]); o.y = pack2(DN_ALPHA * bflo(xr.y) + v[2], DN_ALPHA * bfhi(xr.y) + v[3]);
      o.z = pack2(DN_ALPHA * bflo(xr.z) + v[4], DN_ALPHA * bfhi(xr.z) + v[5]); o.w = pack2(DN_ALPHA * bflo(xr.w) + v[6], DN_ALPHA * bfhi(xr.w) + v[7]);
      *(uint4*)(Z + (size_t)(m0 + row) * 1024 + n0 + c8) = o;
    });
  }
  { int jb, jn; if (light_block(1, jb, jn)) convert_fp8_job(P->in[I_PV] + (size_t)li * 16384 * 1024, P->ws + W_V, 16384ull * 1024, 64.f, jb, jn); }
}

__device__ __forceinline__ void phase_LN(KP P, const float* gam, const float* bet, bool final_out, size_t xoff) {
  const bf16* Z = (const bf16*)(P->ws + W_H);
  bf16* X = (bf16*)(P->ws + xoff);
  const int lane = tidx() & 63;
  const int gw = bidx() * 4 + (tidx() >> 6), nw = gdim() * 4;
#pragma unroll 4
  for (int row = gw; row < NTOK; row += nw) {
    float4 v[4];
    float s = 0.f;
#pragma unroll
    for (int i = 0; i < 4; i++) {
      uint2 zr = *(const uint2*)(Z + (size_t)row * 1024 + i * 256 + lane * 4);
      v[i] = make_float4(bflo(zr.x), bfhi(zr.x), bflo(zr.y), bfhi(zr.y));
      s += v[i].x + v[i].y + v[i].z + v[i].w;
    }
    s = wsum(s);
    const float mu = s * (1.f / 1024.f);
    float q = 0.f;
#pragma unroll
    for (int i = 0; i < 4; i++) { float a = v[i].x - mu, b = v[i].y - mu, c = v[i].z - mu, d = v[i].w - mu; q += a * a + b * b + c * c + d * d; }
    q = wsum(q);
    const float rstd = rsqrtf(q * (1.f / 1024.f) + LN_EPS);
#pragma unroll
    for (int i = 0; i < 4; i++) {
      int col = i * 256 + lane * 4;
      float4 gg = *(const float4*)(gam + col), bb = *(const float4*)(bet + col);
      float4 y;
      y.x = (v[i].x - mu) * rstd * gg.x + bb.x; y.y = (v[i].y - mu) * rstd * gg.y + bb.y;
      y.z = (v[i].z - mu) * rstd * gg.z + bb.z; y.w = (v[i].w - mu) * rstd * gg.w + bb.w;
      uint2 o; o.x = pack2(y.x, y.y); o.y = pack2(y.z, y.w);
      if (!final_out) *(uint2*)(X + (size_t)row * 1024 + col) = o;
      else *(float4*)(P->out + (size_t)row * 1024 + col) = y;
    }
  }
}

__device__ __forceinline__ void phase_PQ(KP P, int li, bf16* smem) {
  EPI_VARS
  const bf16* X = (const bf16*)(P->ws + W_HT);
  const bf16* Wt = (const bf16*)(P->ws + W_QK);
  float* S = (float*)(P->ws + W_H);
  for (int t = bidx(); t < SWZ_TOTAL(16); t += gdim()) {
    int mt_, nt_;
    if (!tile_swz(t, 16, mt_, nt_)) continue;
    const int m0 = mt_ * 128, n0 = nt_ * 128;
    f32x16 acc[2][2];
    zero_acc(acc);
    const bf16* Ab = X + (size_t)m0 * 1024;
    const bf16* Bb = Wt + (size_t)n0 * 1024;
    gemm_kloop(acc,
      [&](int r, int kc) { return *(const uint4*)(Ab + (size_t)r * 1024 + kc * 8); },
      [&](int r, int kc) { return *(const uint4*)(Bb + (size_t)r * 1024 + kc * 8); }, 0, 16, smem);
    EPI_BASE
    epi_rowmajor(acc, smem, [&](int row, int c8, float (&v)[8]) {
      float* sp = S + (size_t)(m0 + row) * 2048 + n0 + c8;
      *(float4*)sp = make_float4(v[0], v[1], v[2], v[3]);
      *(float4*)(sp + 4) = make_float4(v[4], v[5], v[6], v[7]);
    });
  }
  { int jb, jn;
    if (light_block(2, jb, jn)) {
      float* lds = (float*)smem;
      convert_job(P->in[I_PP] + (size_t)li * NPTOK * 256, (bf16*)(P->ws + W_PE), (size_t)NPTOK * 256, jb, jn);
      convert_job(P->in[I_PS] + (size_t)li * 1024 * 256, (bf16*)(P->ws + W_PE) + (size_t)NPTOK * 256, 1024ull * 256, jb, jn);
      transpose_job(P->in[I_WG] + (size_t)li * 1024 * 1024, (bf16*)(P->ws + W_G), 1024, 1024, 1, lds, jb, jn);
      transpose_job(P->in[I_WP] + (size_t)li * 256 * 1024, (bf16*)(P->ws + W_P), 256, 1024, 1, lds, jb, jn);
      if (li == 0 && !MULTI_LAUNCH) pro_cache(P, 1, lds, jb, jn);
    }
  }
}

__device__ __forceinline__ float dpp_max_step(float v, const int ctrl_dummy);
#define DPP_MAX(v, ctrl) v = fmaxf(v, __int_as_float(__builtin_amdgcn_update_dpp(__float_as_int(v), __float_as_int(v), ctrl, 0xf, 0xf, false)))
__device__ __forceinline__ float wave_max(float v) {
  DPP_MAX(v, 0x111);
  DPP_MAX(v, 0x112);
  DPP_MAX(v, 0x114);
  DPP_MAX(v, 0x118);
  DPP_MAX(v, 0x142);
  DPP_MAX(v, 0x143);
  return __int_as_float(__builtin_amdgcn_readlane(__float_as_int(v), 63));
}

__device__ __forceinline__ void top16_of128(float v0, float v1, int lane, float& osc, int& oix) {
  osc = -3.0e38f; oix = 0;
#pragma unroll
  for (int r = 0; r < 16; r++) {
    float m = fmaxf(v0, v1);
    float wm = wave_max(m);
    unsigned long long bal = __ballot(m == wm);
    int src = __ffsll((long long)bal) - 1;
    int sel = (v0 == wm) ? 0 : 1;
    int selu = __builtin_amdgcn_readlane(sel, src);
    if (lane == src) { if (selu == 0) v0 = -3.0e38f; else v1 = -3.0e38f; }
    if (lane == r) { osc = wm; oix = src + 64 * selu; }
  }
}

typedef float f2v __attribute__((ext_vector_type(2)));
__device__ __forceinline__ unsigned fkey(float f) { unsigned u = __float_as_uint(f); return u ^ ((unsigned)((int)u >> 31) | 0x80000000u); }
__device__ __forceinline__ int mbcnt64(unsigned long long m) {
  return __builtin_amdgcn_mbcnt_hi((unsigned)(m >> 32), __builtin_amdgcn_mbcnt_lo((unsigned)m, 0u));
}
template <int NV>
__device__ __forceinline__ unsigned top16_threshold(const unsigned (&k)[NV]) {
  unsigned T = 0u;
#pragma unroll 1
  for (int bit = 31; bit >= 0; bit--) {
    const unsigned c = T | (1u << bit);
    int cnt = 0;
#pragma unroll
    for (int i = 0; i < NV; i++) cnt += __popcll(__ballot(k[i] >= c));
    if (cnt >= 16) T = c;
    if (cnt == 16) break;
  }
  return T;
}

__device__ __forceinline__ void phase_PEER(KP P, int li, bf16* smem) {
  const float* S = (const float*)(P->ws + W_H);
  bf16* X = (bf16*)(P->ws + W_X);
  const bf16* XA = (const bf16*)(P->ws + W_HT);
  const unsigned char* U = P->ws + W_U;
  const unsigned char* V = P->ws + W_V;
  const float* gam = P->in[I_L2G] + li * 1024;
  const float* bet = P->in[I_L2B] + li * 1024;
  const int lane = tidx() & 63;
  const int wv = tidx() >> 6;
  const int gw = bidx() * 4 + wv, nw = gdim() * 4;
  float* wl = (float*)smem + wv * 128;
  int* wli = (int*)wl;
  for (int tok = gw; tok < NTOK; tok += nw) {
    f2v xv[8];
    {
      uint4 a = *(const uint4*)(XA + (size_t)tok * 1024 + lane * 16);
      uint4 b = *(const uint4*)(XA + (size_t)tok * 1024 + lane * 16 + 8);
      xv[0] = f2v{bflo(a.x), bfhi(a.x)}; xv[1] = f2v{bflo(a.y), bfhi(a.y)}; xv[2] = f2v{bflo(a.z), bfhi(a.z)}; xv[3] = f2v{bflo(a.w), bfhi(a.w)};
      xv[4] = f2v{bflo(b.x), bfhi(b.x)}; xv[5] = f2v{bflo(b.y), bfhi(b.y)}; xv[6] = f2v{bflo(b.z), bfhi(b.z)}; xv[7] = f2v{bflo(b.w), bfhi(b.w)};
    }
    f2v outv[8];
#pragma unroll
    for (int i = 0; i < 8; i++) outv[i] = f2v{0.f, 0.f};
    const float* Srow = S + (size_t)tok * 2048;
#define PEER_ROUTE(sv, ts_out, eid_out) { \
      _Pragma("unroll") for (int side = 0; side < 2; side++) { \
        float v0 = sv[side * 2], v1 = sv[side * 2 + 1]; \
        unsigned kk[2] = {fkey(v0), fkey(v1)}; \
        unsigned T = top16_threshold<2>(kk); \
        bool s0 = kk[0] >= T, s1 = kk[1] >= T; \
        unsigned long long m0 = __ballot(s0), m1 = __ballot(s1); \
        int r0 = mbcnt64(m0), r1 = __popcll(m0) + mbcnt64(m1); \
        if (s0 && r0 < 16) { wl[side * 16 + r0] = v0; wli[32 + side * 16 + r0] = lane; } \
        if (s1 && r1 < 16) { wl[side * 16 + r1] = v1; wli[32 + side * 16 + r1] = lane + 64; } \
      } \
      { const int i = lane & 15, j0 = lane >> 4; \
        const float a = wl[i]; const int ai = wli[32 + i]; \
        float cs[4]; int ce[4]; unsigned kk[4]; \
        _Pragma("unroll") for (int m = 0; m < 4; m++) { cs[m] = a + wl[16 + j0 + 4 * m]; ce[m] = ai * 128 + wli[48 + j0 + 4 * m]; kk[m] = fkey(cs[m]); } \
        unsigned T = top16_threshold<4>(kk); \
        int base = 0; \
        _Pragma("unroll") for (int m = 0; m < 4; m++) { \
          bool sl = kk[m] >= T; unsigned long long mm = __ballot(sl); int r = base + mbcnt64(mm); \
          if (sl && r < 16) { wl[64 + r] = cs[m]; wli[80 + r] = ce[m]; } \
          base += __popcll(mm); } } \
      ts_out = wl[64 + (lane & 15)]; eid_out = wli[80 + (lane & 15)]; }
    float sva[4], svb[4];
#pragma unroll
    for (int i = 0; i < 4; i++) { sva[i] = __builtin_nontemporal_load(Srow + i * 64 + lane); svb[i] = __builtin_nontemporal_load(Srow + 256 + i * 64 + lane); }
    float ts; int eid;
    PEER_ROUTE(sva, ts, eid)
#pragma unroll 1
    for (int h = 0; h < 8; h++) {
#pragma unroll
      for (int i = 0; i < 4; i++) { sva[i] = svb[i]; }
      if (h + 2 < 8) {
#pragma unroll
        for (int i = 0; i < 4; i++) svb[i] = __builtin_nontemporal_load(Srow + (h + 2) * 256 + i * 64 + lane);
      }
      uint4 ub[16], vb[8];
#pragma unroll
      for (int k = 0; k < 16; k++) {
        int e = __builtin_amdgcn_readlane(eid, k);
        ub[k] = *(const uint4*)(U + (size_t)e * 1024 + lane * 16);
        if (k < 8) vb[k] = *(const uint4*)(V + (size_t)e * 1024 + lane * 16);
      }
      int eidc = eid;
      float tmax = ts;
      tmax = fmaxf(tmax, __shfl_xor(tmax, 1)); tmax = fmaxf(tmax, __shfl_xor(tmax, 2));
      tmax = fmaxf(tmax, __shfl_xor(tmax, 4)); tmax = fmaxf(tmax, __shfl_xor(tmax, 8));
      float ex = __expf(ts - tmax);
      float den = ex;
      den += __shfl_xor(den, 1); den += __shfl_xor(den, 2); den += __shfl_xor(den, 4); den += __shfl_xor(den, 8);
      float gate = ex / den;
      if (h + 1 < 8) { PEER_ROUTE(sva, ts, eid) }
      float dk[16];
#pragma unroll
      for (int k = 0; k < 16; k++) {
        f2v acc = f2v{0.f, 0.f};
        acc += __builtin_amdgcn_cvt_pk_f32_fp8((int)ub[k].x, false) * xv[0]; acc += __builtin_amdgcn_cvt_pk_f32_fp8((int)ub[k].x, true) * xv[1];
        acc += __builtin_amdgcn_cvt_pk_f32_fp8((int)ub[k].y, false) * xv[2]; acc += __builtin_amdgcn_cvt_pk_f32_fp8((int)ub[k].y, true) * xv[3];
        acc += __builtin_amdgcn_cvt_pk_f32_fp8((int)ub[k].z, false) * xv[4]; acc += __builtin_amdgcn_cvt_pk_f32_fp8((int)ub[k].z, true) * xv[5];
        acc += __builtin_amdgcn_cvt_pk_f32_fp8((int)ub[k].w, false) * xv[6]; acc += __builtin_amdgcn_cvt_pk_f32_fp8((int)ub[k].w, true) * xv[7];
        dk[k] = acc[0] + acc[1];
      }
      uint4 vc[8];
#pragma unroll
      for (int k = 0; k < 8; k++) {
        int e = __builtin_amdgcn_readlane(eidc, 8 + k);
        vc[k] = *(const uint4*)(V + (size_t)e * 1024 + lane * 16);
      }
      {
        bool hi = (lane & 32) != 0;
#pragma unroll
        for (int i = 0; i < 8; i++) { float send = hi ? dk[i] : dk[i + 8]; float keep = hi ? dk[i + 8] : dk[i]; dk[i] = keep + __shfl_xor(send, 32); }
        hi = (lane & 16) != 0;
#pragma unroll
        for (int i = 0; i < 4; i++) { float send = hi ? dk[i] : dk[i + 4]; float keep = hi ? dk[i + 4] : dk[i]; dk[i] = keep + __shfl_xor(send, 16); }
        hi = (lane & 8) != 0;
#pragma unroll
        for (int i = 0; i < 2; i++) { float send = hi ? dk[i] : dk[i + 2]; float keep = hi ? dk[i + 2] : dk[i]; dk[i] = keep + __shfl_xor(send, 8); }
        hi = (lane & 4) != 0;
        { float send = hi ? dk[0] : dk[1]; float keep = hi ? dk[1] : dk[0]; dk[0] = keep + __shfl_xor(send, 4); }
        dk[0] += __shfl_xor(dk[0], 2);
        dk[0] += __shfl_xor(dk[0], 1);
      }
      float wgt = __shfl(gate, (lane >> 2) & 15) * gelu_tanh(dk[0] * (1.f / 256.f)) * (1.f / 64.f);
#pragma unroll
      for (int k = 0; k < 16; k++) {
        float wk = __int_as_float(__builtin_amdgcn_readlane(__float_as_int(wgt), k * 4));
        const f2v wk2 = f2v{wk, wk};
        const uint4 vv = (k < 8) ? vb[k & 7] : vc[k & 7];
        outv[0] += wk2 * __builtin_amdgcn_cvt_pk_f32_fp8((int)vv.x, false); outv[1] += wk2 * __builtin_amdgcn_cvt_pk_f32_fp8((int)vv.x, true);
        outv[2] += wk2 * __builtin_amdgcn_cvt_pk_f32_fp8((int)vv.y, false); outv[3] += wk2 * __builtin_amdgcn_cvt_pk_f32_fp8((int)vv.y, true);
        outv[4] += wk2 * __builtin_amdgcn_cvt_pk_f32_fp8((int)vv.z, false); outv[5] += wk2 * __builtin_amdgcn_cvt_pk_f32_fp8((int)vv.z, true);
        outv[6] += wk2 * __builtin_amdgcn_cvt_pk_f32_fp8((int)vv.w, false); outv[7] += wk2 * __builtin_amdgcn_cvt_pk_f32_fp8((int)vv.w, true);
      }
    }
    float z[16];
    float s = 0.f;
#pragma unroll
    for (int i = 0; i < 8; i++) { z[2 * i] = outv[i][0] + DN_ALPHA * xv[i][0]; z[2 * i + 1] = outv[i][1] + DN_ALPHA * xv[i][1]; s += z[2 * i] + z[2 * i + 1]; }
    s = wsum(s);
    const float mu = s * (1.f / 1024.f);
    float q = 0.f;
#pragma unroll
    for (int i = 0; i < 16; i++) { float d = z[i] - mu; q += d * d; }
    q = wsum(q);
    const float rstd = rsqrtf(q * (1.f / 1024.f) + LN_EPS);
    float y[16];
    const int col = lane * 16;
#pragma unroll
    for (int i4 = 0; i4 < 4; i4++) {
      float4 g = *(const float4*)(gam + col + i4 * 4), b = *(const float4*)(bet + col + i4 * 4);
      y[i4 * 4 + 0] = (z[i4 * 4 + 0] - mu) * rstd * g.x + b.x; y[i4 * 4 + 1] = (z[i4 * 4 + 1] - mu) * rstd * g.y + b.y;
      y[i4 * 4 + 2] = (z[i4 * 4 + 2] - mu) * rstd * g.z + b.z; y[i4 * 4 + 3] = (z[i4 * 4 + 3] - mu) * rstd * g.w + b.w;
    }
    uint4 o0, o1;
    o0.x = pack2(y[0], y[1]); o0.y = pack2(y[2], y[3]); o0.z = pack2(y[4], y[5]); o0.w = pack2(y[6], y[7]);
    o1.x = pack2(y[8], y[9]); o1.y = pack2(y[10], y[11]); o1.z = pack2(y[12], y[13]); o1.w = pack2(y[14], y[15]);
    *(uint4*)(X + (size_t)tok * 1024 + col) = o0;
    *(uint4*)(X + (size_t)tok * 1024 + col + 8) = o1;
  }
}

__device__ __forceinline__ void phase_PLE(KP P, int li, bf16* smem) {
  EPI_VARS
  const bf16* X = (const bf16*)(P->ws + W_X);
  const bf16* PE = (const bf16*)(P->ws + W_PE);
  const bf16* Wg = (const bf16*)(P->ws + W_G);
  const bf16* Wp = (const bf16*)(P->ws + W_P);
  bf16* Z = (bf16*)(P->ws + W_H);
  for (int t = bidx(); t < SWZ_TOTAL(8); t += gdim()) {
    int mt_, nt_;
    if (!tile_swz(t, 8, mt_, nt_)) continue;
    const int m0 = mt_ * 128, n0 = nt_ * 128;
    f32x16 acc[2][2], acc2[2][2];
    zero_acc(acc); zero_acc(acc2);
    {
      const bf16* Ab = X + (size_t)m0 * 1024;
      const bf16* Bb = Wg + (size_t)n0 * 1024;
      gemm_kloop(acc,
        [&](int r, int kc) { return *(const uint4*)(Ab + (size_t)r * 1024 + kc * 8); },
        [&](int r, int kc) { return *(const uint4*)(Bb + (size_t)r * 1024 + kc * 8); }, 0, 16, smem);
    }
    {
      const bf16* Ab = PE + (size_t)m0 * 256;
      const bf16* Bb = Wp + (size_t)n0 * 256;
      gemm_kloop(acc2,
        [&](int r, int kc) { return *(const uint4*)(Ab + (size_t)r * 256 + kc * 8); },
        [&](int r, int kc) { return *(const uint4*)(Bb + (size_t)r * 256 + kc * 8); }, 0, 4, smem);
    }
    EPI_BASE
#pragma unroll
    for (int mi = 0; mi < 2; mi++)
#pragma unroll
      for (int ni = 0; ni < 2; ni++)
#pragma unroll
        for (int r = 0; r < 16; r++) acc[mi][ni][r] = sigmoidf_(acc[mi][ni][r]) * acc2[mi][ni][r];
    epi_rowmajor(acc, smem, [&](int row, int c8, float (&v)[8]) {
      uint4 xr = *(const uint4*)(X + (size_t)(m0 + row) * 1024 + n0 + c8);
      uint4 o;
      o.x = pack2(DN_ALPHA * bflo(xr.x) + v[0], DN_ALPHA * bfhi(xr.x) + v[1]); o.y = pack2(DN_ALPHA * bflo(xr.y) + v[2], DN_ALPHA * bfhi(xr.y) + v[3]);
      o.z = pack2(DN_ALPHA * bflo(xr.z) + v[4], DN_ALPHA * bfhi(xr.z) + v[5]); o.w = pack2(DN_ALPHA * bflo(xr.w) + v[6], DN_ALPHA * bfhi(xr.w) + v[7]);
      *(uint4*)(Z + (size_t)(m0 + row) * 1024 + n0 + c8) = o;
    });
  }
  if (li == 0 && !MULTI_LAUNCH) { int jb, jn; if (light_block(1, jb, jn)) pro_misc(P, 1, (float*)smem, jb, jn); }
}

__device__ __forceinline__ void run_phase(KP P, int li, int k, bf16* smem) {
  switch (k) {
    case PH_PRO: phase_prologue(P, li, smem); break;
    case PH_GIN: phase_gemm_in(P, li, smem); break;
    case PH_A: phase_A(P, li, smem); break;
    case PH_B: phase_B(P, li); break;
    case PH_C: phase_C(P, li, smem); break;
    case PH_D: phase_D(P, li, smem); break;
    case PH_E: phase_E(P, li, smem); break;
    case PH_WO: phase_WO(P, li, smem); break;
    case PH_LN1: phase_LN(P, P->in[I_L1G] + li * 1024, P->in[I_L1B] + li * 1024, false, W_HT); break;
    case PH_PQ: phase_PQ(P, li, smem); break;
    case PH_PEER: phase_PEER(P, li, smem); break;
    case PH_PLE: phase_PLE(P, li, smem); break;
    case PH_LN3: phase_LN(P, P->in[I_L3G] + li * 1024, P->in[I_L3B] + li * 1024, li == 1, W_X); break;
  }
}

#ifndef DUP_MASK
#define DUP_MASK 0
#endif
#define SYNC() xcd_barrier(xb)
#define RUN(k, call) { { KP P = kp_get(); call; } if ((DUP_MASK >> (k)) & 1) { SYNC(); KP P = kp_get(); call; } }
__global__ void __launch_bounds__(256, 2) fwd_kernel(Params Parg) {
  extern __shared__ __attribute__((aligned(16))) unsigned char lds_raw[];
  bf16* smem = (bf16*)lds_raw;
#if MULTI_LAUNCH
  { KP P = kp_get(); run_phase(P, P->pbeg / PH_N, P->pbeg % PH_N, smem); }
#else
  volatile LAS unsigned* st = (volatile LAS unsigned*)(lds_raw + LDS_TILE_BYTES);
  if (threadIdx.x == 0) { st[0] = 0u; st[1] = 0u; st[2] = 0u; st[3] = 0u; }
  __syncthreads();
  XcdBarrier xb;
  { KP P = kp_get(); xb = xcd_barrier_post((unsigned*)(P->ws + W_BAR), st);
    if (P->pad0 == 0x5eed) cg::this_grid().sync();
  }
#pragma unroll 1
  for (int li = 0; li < 2; li++) {
    if (li == 0) { RUN(PH_PRO, phase_prologue(P, li, smem)) SYNC(); }
    RUN(PH_GIN, phase_gemm_in(P, li, smem)) SYNC();
    RUN(PH_A, phase_A(P, li, smem)) SYNC();
    RUN(PH_B, phase_B(P, li)) SYNC();
    RUN(PH_C, phase_C(P, li, smem)) SYNC();
    RUN(PH_D, phase_D(P, li, smem)) SYNC();
    RUN(PH_E, phase_E(P, li, smem)) SYNC();
    RUN(PH_WO, phase_WO(P, li, smem)) SYNC();
    RUN(PH_LN1, phase_LN(P, P->in[I_L1G] + li * 1024, P->in[I_L1B] + li * 1024, false, W_HT)) SYNC();
    RUN(PH_PQ, phase_PQ(P, li, smem)) SYNC();
    RUN(PH_PEER, phase_PEER(P, li, smem)) SYNC();
    RUN(PH_PLE, phase_PLE(P, li, smem)) SYNC();
    RUN(PH_LN3, phase_LN(P, P->in[I_L3G] + li * 1024, P->in[I_L3B] + li * 1024, li == 1, W_X))
    if (li == 0) SYNC();
  }
#endif
}

extern "C" void kernel_launch(void* const* d_in, const int* in_sizes, int n_in, void* d_out, int out_size, void* d_ws,
                              size_t ws_size, hipStream_t stream) {
  static int grid_blocks = 0;
  if (grid_blocks == 0) {
    if (n_in != 38 || (size_t)out_size != O_END || ws_size < WS_END) {
      fprintf(stderr, "kernel_launch: unexpected sizes n_in=%d out=%d ws=%zu need %zu\n", n_in, out_size, ws_size, (size_t)WS_END);
      grid_blocks = -1; return;
    }
    int dev = 0, cus = 0, per_cu = 0;
    hipGetDevice(&dev);
    hipDeviceGetAttribute(&cus, hipDeviceAttributeMultiprocessorCount, dev);
    if (hipFuncSetAttribute((const void*)fwd_kernel, hipFuncAttributeMaxDynamicSharedMemorySize, LDS_BYTES) != hipSuccess) {
      fprintf(stderr, "kernel_launch: hipFuncSetAttribute failed\n"); grid_blocks = -1; return;
    }
    hipOccupancyMaxActiveBlocksPerMultiprocessor(&per_cu, (const void*)fwd_kernel, 256, LDS_BYTES);
    if (per_cu < 1) { fprintf(stderr, "kernel_launch: occupancy query gave %d\n", per_cu); grid_blocks = -1; return; }
    if (per_cu > 2) per_cu = 2;
    grid_blocks = cus * per_cu;
  }
  if (grid_blocks < 0) return;
  Params p{};
  for (int i = 0; i < 38; i++) p.in[i] = (const float*)d_in[i];
  p.out = (float*)d_out;
  p.ws = (unsigned char*)d_ws;
#if MULTI_LAUNCH
  for (int ph = 0; ph < 2 * PH_N; ph++) {
    p.pbeg = ph; p.pend = ph + 1;
    hipLaunchKernelGGL(fwd_kernel, dim3(grid_blocks), dim3(256), LDS_BYTES, stream, p);
  }
#else
  p.pbeg = 0; p.pend = 2 * PH_N;
  if (hipMemsetAsync((char*)d_ws + W_BAR, 0, 16384, stream) != hipSuccess) { fprintf(stderr, "memset failed\n"); return; }
  void* args[] = {&p};
#ifdef PLAIN_LAUNCH
  hipLaunchKernelGGL(fwd_kernel, dim3(grid_blocks), dim3(256), LDS_BYTES, stream, p);
  hipError_t e = hipSuccess; (void)args;
#else
  hipError_t e = hipLaunchCooperativeKernel((const void*)fwd_kernel, dim3(grid_blocks), dim3(256), args, LDS_BYTES, stream);
#endif
  if (e != hipSuccess) fprintf(stderr, "cooperative launch failed: %s (grid %d)\n", hipGetErrorString(e), grid_blocks);
#endif
}
```

```cpp
#include <hip/hip_runtime.h>
#include <hip/hip_cooperative_groups.h>
#include <cstdio>
#include <cstdint>
namespace cg = cooperative_groups;

#ifndef MULTI_LAUNCH
#define MULTI_LAUNCH 0
#endif

typedef unsigned short bf16;
using bf16x8 = __attribute__((ext_vector_type(8))) short;
using f32x16 = __attribute__((ext_vector_type(16))) float;
using f32x4 = __attribute__((ext_vector_type(4))) float;

#define NTOK 17408
#define NPTOK 16384
#define DM 1024
#define INC 5888
#define NCHUNK 272
#define C_USSM 0
#define C_QATT 256
#define C_KATT 768
#define C_VATT 1280
#define C_QRET 1792
#define C_KRET 2048
#define C_VRET 2304
#define C_GRET 2560
#define C_GATE 2816
#define DN_ALPHA 1.41421356237f
#define LN_EPS 1e-5f

constexpr size_t O_YP = 0;
constexpr size_t O_YS = O_YP + 4ull * 4096 * 1024;
constexpr size_t O_SRE_P = O_YS + 16ull * 64 * 1024;
constexpr size_t O_SIM_P = O_SRE_P + 2 * 4 * 16 * 64;
constexpr size_t O_AK_P = O_SIM_P + 2 * 4 * 16 * 64;
constexpr size_t O_AV_P = O_AK_P + 2ull * 4 * 512 * 512;
constexpr size_t O_RET_P = O_AV_P + 2ull * 4 * 512 * 512;
constexpr size_t O_SRE_S = O_RET_P + 2 * 4 * 4 * 4096;
constexpr size_t O_SIM_S = O_SRE_S + 2 * 16 * 16 * 64;
constexpr size_t O_AK_S = O_SIM_S + 2 * 16 * 16 * 64;
constexpr size_t O_AV_S = O_AK_S + 2ull * 16 * 64 * 512;
constexpr size_t O_RET_S = O_AV_S + 2ull * 16 * 64 * 512;
constexpr size_t O_END = O_RET_S + 2ull * 16 * 4 * 4096;

constexpr size_t W_IN = 0;
constexpr size_t W_BRS = W_IN + 5888ull * 1024 * 2;
constexpr size_t W_BRA = W_BRS + 1024ull * 256 * 2;
constexpr size_t W_BRR = W_BRA + 1024ull * 512 * 2;
constexpr size_t W_O = W_BRR + 1024ull * 256 * 2;
constexpr size_t W_QK = W_O + 1024ull * 1024 * 2;
constexpr size_t W_G = W_QK + 2048ull * 1024 * 2;
constexpr size_t W_P = W_G + 1024ull * 1024 * 2;
constexpr size_t W_GLU = W_P + 1024ull * 256 * 2;
constexpr size_t W_U = W_GLU + 256ull * 256 * 2;
constexpr size_t W_V = W_U + 16384ull * 1024 * 2;
constexpr size_t W_TT = W_V + 16384ull * 1024 * 2;
#define KERN_ELEMS (16 * 64 * 256)
constexpr size_t W_BST = W_TT + 16ull * 1024 * 1152 * 2;
constexpr size_t W_ROPE = W_BST + 16ull * 128 * 1024 * 2;
constexpr size_t W_X = W_ROPE + 4096ull * 32 * 8;
constexpr size_t W_PE = W_X + (size_t)NTOK * 1024 * 2;
constexpr size_t W_H = W_PE + (size_t)NTOK * 256 * 2;
constexpr size_t W_HT = W_H + (size_t)NTOK * 5888 * 2;
constexpr size_t W_YSSM = W_HT + 1024ull * NTOK * 2;
constexpr size_t W_YATT = W_YSSM + (size_t)NTOK * 256 * 2;
constexpr size_t W_YRET = W_YATT + (size_t)NTOK * 512 * 2;
constexpr size_t W_CK = W_YRET + (size_t)NTOK * 256 * 2;
constexpr size_t W_CVT = W_CK + 16ull * 512 * 512 * 2;
constexpr size_t W_CT = W_CVT + 16ull * 512 * 512 * 2;
constexpr size_t W_SPREV = W_CT + 272ull * 4 * 4096 * 4;
constexpr size_t W_SC = W_SPREV + 272ull * 4 * 4096 * 2;
constexpr size_t W_HS = W_SC + 272ull * 16 * 128 * 4;
constexpr size_t W_BAR = W_HS + 272ull * 16 * 128 * 2;
constexpr size_t WS_END = W_BAR + 16384;

#define LDS_TILE_BYTES 73728
#define LDS_BYTES (73728 + 16)
#define LDS_ROW 72
#define STAGE_ELEMS (128 * LDS_ROW)

struct Params {
  const float* in[38];
  float* out;
  unsigned char* ws;
  int pbeg, pend;
  int pad0, pad1;
};

typedef const __attribute__((address_space(4))) Params* KP;
__device__ __forceinline__ KP kp_get() { KP p = (KP)__builtin_amdgcn_kernarg_segment_ptr(); asm volatile("" : "+s"(p)); return p; }

enum { I_XP = 0, I_XS, I_PP, I_PS, I_SRE, I_SIM, I_CK, I_CV, I_SRET, I_WIN, I_LRE, I_LIM, I_BRE, I_BIM, I_CRE, I_CIM,
       I_LDT, I_SD, I_WGLU, I_BGLU, I_BIAS, I_GNG, I_WBS, I_WBA, I_WBR, I_WO, I_L1G, I_L1B, I_WQ, I_KEYS, I_PU, I_PV,
       I_L2G, I_L2B, I_WG, I_WP, I_L3G, I_L3B };

enum { PH_PRO = 0, PH_GIN, PH_A, PH_B, PH_C, PH_D, PH_E, PH_WO, PH_LN1, PH_PQ, PH_PEER, PH_PLE, PH_LN3, PH_N };

__device__ __forceinline__ bf16 f2bf(float f) {
  unsigned u = __float_as_uint(f);
  u += 0x7fffu + ((u >> 16) & 1u);
  return (bf16)(u >> 16);
}
__device__ __forceinline__ float bf2f(bf16 h) { return __uint_as_float(((unsigned)h) << 16); }
__device__ __forceinline__ unsigned pack2(float a, float b) { return (unsigned)f2bf(a) | ((unsigned)f2bf(b) << 16); }
__device__ __forceinline__ float bflo(unsigned u) { return __uint_as_float(u << 16); }
__device__ __forceinline__ float bfhi(unsigned u) { return __uint_as_float(u & 0xffff0000u); }
__device__ __forceinline__ float sigmoidf_(float x) { return __builtin_amdgcn_rcpf(1.f + __expf(-x)); }
__device__ __forceinline__ float gelu_tanh(float x) {
  float y = 0.7978845608028654f * (x + 0.044715f * x * x * x);
  float t = 1.f - 2.f * __builtin_amdgcn_rcpf(1.f + __expf(2.f * y));
  return 0.5f * x * (1.f + t);
}
__device__ __forceinline__ bf16x8 u4_to_frag(uint4 u) {
  union { uint4 u; bf16x8 f; } c; c.u = u; return c.f;
}
template <class T>
__device__ __forceinline__ T* launder(T* p) { asm volatile("" : "+s"(p)); return p; }
__device__ __forceinline__ int opaque(int v) { asm volatile("" : "+v"(v)); return v; }
__device__ __forceinline__ int bidx() { int v = blockIdx.x; asm volatile("" : "+s"(v)); return v; }
__device__ __forceinline__ int gdim() { int v = gridDim.x; asm volatile("" : "+s"(v)); return v; }
__device__ __forceinline__ int tidx() { int v = threadIdx.x; asm volatile("" : "+v"(v)); return v; }
__device__ __forceinline__ float wsum(float v) {
#pragma unroll
  for (int o = 32; o >= 1; o >>= 1) v += __shfl_xor(v, o);
  return v;
}


#define XB_TMO      128
#define XB_XCNT(j)  (256  + 64 * (j))
#define XB_XSUB(j)  (1280 + 64 * (j))
#define XB_XGEN(j)  (2304 + 64 * (j))
#define XB_TOP      3328
#define XB_TOPGEN   3392
#define XCD_BAR_WORDS 3456
#define XB_SPIN_CAP (1u << 20)
#define LAS __attribute__((address_space(3)))
__device__ __forceinline__ unsigned xb_ld(unsigned* p)              { return __hip_atomic_load(p, __ATOMIC_RELAXED, __HIP_MEMORY_SCOPE_AGENT); }
__device__ __forceinline__ unsigned xb_add(unsigned* p, unsigned v) { return __hip_atomic_fetch_add(p, v, __ATOMIC_RELAXED, __HIP_MEMORY_SCOPE_AGENT); }
__device__ __forceinline__ unsigned xb_xcc_id() { return (unsigned)__builtin_amdgcn_s_getreg((3 << 11) | 20) & 0xFu; }
#define XB_SPIN(cond, bar) do { unsigned _sp = 0; while (cond) { __builtin_amdgcn_s_sleep(1); \
    if ((++_sp & 255u) == 0u) { if (xb_ld(&(bar)[XB_TMO])) break; if (_sp > XB_SPIN_CAP) { atomicAdd(&(bar)[XB_TMO], 1u); break; } } } } while (0)
struct XcdBarrier { unsigned* bar; unsigned x; volatile LAS unsigned* st; };
__device__ __forceinline__ XcdBarrier xcd_barrier_post(unsigned* bar, volatile LAS unsigned* st) {
    XcdBarrier b; b.bar = bar; b.x = xb_xcc_id(); b.st = st;
    if (threadIdx.x == 0) (void)xb_add(&bar[XB_XCNT(b.x)], 1u);
    return b;
}
__device__ __forceinline__ void xcd_barrier_complete(unsigned* bar, unsigned x, unsigned& nloc, unsigned& nx) {
    const unsigned G = gridDim.x * gridDim.y * gridDim.z;
    unsigned sum, cnt, mine, sp = 0u;
    for (;;) {
        sum = 0u; cnt = 0u; mine = 0u;
#pragma unroll
        for (unsigned j = 0; j < 16; ++j) { const unsigned c = xb_ld(&bar[XB_XCNT(j)]); sum += c; cnt += (c > 0u) ? 1u : 0u; mine = (j == x) ? c : mine; }
        if (sum == G) break;
        __builtin_amdgcn_s_sleep(1);
        if ((++sp & 255u) == 0u) { if (xb_ld(&bar[XB_TMO])) break; if (sp > XB_SPIN_CAP) { atomicAdd(&bar[XB_TMO], 1u); break; } }
    }
    nloc = mine > 0u ? mine : 1u; nx = cnt > 0u ? cnt : 1u;
}
__device__ __forceinline__ void xcd_barrier(const XcdBarrier& b) {
    asm volatile("s_waitcnt vmcnt(0)" ::: "memory");
    __syncthreads();
    if (threadIdx.x == 0) {
        unsigned* bar = b.bar;
        __builtin_amdgcn_s_waitcnt(0);
        unsigned nloc = b.st[0], nx = b.st[1];
        if (nloc == 0u) { xcd_barrier_complete(bar, b.x, nloc, nx); b.st[0] = nloc; b.st[1] = nx; }
        const unsigned old = xb_add(&bar[XB_XSUB(b.x)], 1u);
        const unsigned gen = old / nloc;
        if (old + 1u == (gen + 1u) * nloc) {
            __builtin_amdgcn_fence(__ATOMIC_RELEASE, "agent");
            asm volatile("s_waitcnt vmcnt(0)" ::: "memory");
            const unsigned og = xb_add(&bar[XB_TOP], 1u);
            const unsigned tg = og / nx;
            if (og + 1u == (tg + 1u) * nx) xb_add(&bar[XB_TOPGEN], 1u);
            else XB_SPIN(xb_ld(&bar[XB_TOPGEN]) == tg, bar);
            __builtin_amdgcn_fence(__ATOMIC_ACQUIRE, "agent");
            xb_add(&bar[XB_XGEN(b.x)], 1u);
            asm volatile("s_waitcnt vmcnt(0)" ::: "memory");
        } else {
            XB_SPIN(xb_ld(&bar[XB_XGEN(b.x)]) == gen, bar);
            __builtin_amdgcn_fence(__ATOMIC_ACQUIRE, "agent");
            asm volatile("s_waitcnt vmcnt(0)" ::: "memory");
        }
    }
    __syncthreads();
}

__device__ __forceinline__ void gemm_compute_stage(f32x16 (&acc)[2][2], const bf16* Ac, const bf16* Bc, int wm, int wn, int lane) {
#pragma unroll
  for (int kk = 0; kk < 4; kk++) {
    bf16x8 a[2], b[2];
#pragma unroll
    for (int mi = 0; mi < 2; mi++) a[mi] = *(const bf16x8*)(Ac + (wm * 64 + mi * 32 + (lane & 31)) * LDS_ROW + kk * 16 + (lane >> 5) * 8);
#pragma unroll
    for (int ni = 0; ni < 2; ni++) b[ni] = *(const bf16x8*)(Bc + (wn * 64 + ni * 32 + (lane & 31)) * LDS_ROW + kk * 16 + (lane >> 5) * 8);
#pragma unroll
    for (int mi = 0; mi < 2; mi++)
#pragma unroll
      for (int ni = 0; ni < 2; ni++) acc[mi][ni] = __builtin_amdgcn_mfma_f32_32x32x16_bf16(a[mi], b[ni], acc[mi][ni], 0, 0, 0);
  }
}

template <class AL, class BL>
__device__ __forceinline__ void gemm_kloop(f32x16 (&acc)[2][2], AL aload, BL bload, int kt0, int nkt, bf16* smem) {
  const int tid = tidx(), lane = tid & 63, w = tid >> 6;
  const int wm = w >> 1, wn = w & 1;
  const int lr = tid >> 3, lc = tid & 7;
  uint4 a0[4], b0[4], a1[4], b1[4];
  bf16* const buf0 = smem;
  bf16* const buf1 = smem + 2 * STAGE_ELEMS;
#define KL_LOAD(A_, B_, st) { _Pragma("unroll") for (int i = 0; i < 4; i++) { A_[i] = aload(lr + 32 * i, (kt0 + (st)) * 8 + lc); B_[i] = bload(lr + 32 * i, (kt0 + (st)) * 8 + lc); } }
#define KL_STORE(A_, B_, buf) { _Pragma("unroll") for (int i = 0; i < 4; i++) { \
    *(uint4*)((buf) + (lr + 32 * i) * LDS_ROW + lc * 8) = A_[i]; *(uint4*)((buf) + STAGE_ELEMS + (lr + 32 * i) * LDS_ROW + lc * 8) = B_[i]; } }
  KL_LOAD(a0, b0, 0)
  KL_STORE(a0, b0, buf0)
  if (nkt > 1) KL_LOAD(a0, b0, 1)
  if (nkt > 2) KL_LOAD(a1, b1, 2)
  __syncthreads();
  int kt = 0;
  for (; kt + 4 < nkt; kt += 2) {
    KL_STORE(a0, b0, buf1)
    KL_LOAD(a0, b0, kt + 3)
    gemm_compute_stage(acc, buf0, buf0 + STAGE_ELEMS, wm, wn, lane);
    __syncthreads();
    KL_STORE(a1, b1, buf0)
    KL_LOAD(a1, b1, kt + 4)
    gemm_compute_stage(acc, buf1, buf1 + STAGE_ELEMS, wm, wn, lane);
    __syncthreads();
  }
  for (; kt < nkt; kt += 2) {
    if (kt + 1 < nkt) KL_STORE(a0, b0, buf1)
    if (kt + 3 < nkt) KL_LOAD(a0, b0, kt + 3)
    gemm_compute_stage(acc, buf0, buf0 + STAGE_ELEMS, wm, wn, lane);
    __syncthreads();
    if (kt + 1 >= nkt) break;
    if (kt + 2 < nkt) KL_STORE(a1, b1, buf0)
    if (kt + 4 < nkt) KL_LOAD(a1, b1, kt + 4)
    gemm_compute_stage(acc, buf1, buf1 + STAGE_ELEMS, wm, wn, lane);
    __syncthreads();
  }
#undef KL_LOAD
#undef KL_STORE
}

#define TL_ROW 40
#define TL_STAGE (384 * TL_ROW)
__device__ __forceinline__ void gemm_tall_compute(f32x16 (&acc)[2][2][2], const bf16* St, int wm, int wn, int lane) {
  const bf16* Ac = St; const bf16* Bc = St + 256 * TL_ROW;
#pragma unroll
  for (int kk = 0; kk < 2; kk++) {
    bf16x8 a[2][2], b[2];
#pragma unroll
    for (int h = 0; h < 2; h++)
#pragma unroll
      for (int mi = 0; mi < 2; mi++) a[h][mi] = *(const bf16x8*)(Ac + (h * 128 + wm * 64 + mi * 32 + (lane & 31)) * TL_ROW + kk * 16 + (lane >> 5) * 8);
#pragma unroll
    for (int ni = 0; ni < 2; ni++) b[ni] = *(const bf16x8*)(Bc + (wn * 64 + ni * 32 + (lane & 31)) * TL_ROW + kk * 16 + (lane >> 5) * 8);
#pragma unroll
    for (int h = 0; h < 2; h++)
#pragma unroll
      for (int mi = 0; mi < 2; mi++)
#pragma unroll
        for (int ni = 0; ni < 2; ni++) acc[h][mi][ni] = __builtin_amdgcn_mfma_f32_32x32x16_bf16(a[h][mi], b[ni], acc[h][mi][ni], 0, 0, 0);
  }
}
template <class AL, class BL>
__device__ __forceinline__ void gemm_kloop_tall(f32x16 (&acc)[2][2][2], AL aload, BL bload, int nkt, bf16* smem) {
  const int tid = tidx(), lane = tid & 63, w = tid >> 6;
  const int wm = w >> 1, wn = w & 1;
  const int lr = tid >> 2, lc = tid & 3;
  uint4 a0[4], b0[2], a1[4], b1[2];
  bf16* const buf0 = smem;
  bf16* const buf1 = smem + TL_STAGE;
#define TL_LOAD(A_, B_, st) { _Pragma("unroll") for (int i = 0; i < 4; i++) A_[i] = aload(lr + 64 * i, (st) * 4 + lc); \
                              _Pragma("unroll") for (int i = 0; i < 2; i++) B_[i] = bload(lr + 64 * i, (st) * 4 + lc); }
#define TL_STORE(A_, B_, buf) { _Pragma("unroll") for (int i = 0; i < 4; i++) *(uint4*)((buf) + (lr + 64 * i) * TL_ROW + lc * 8) = A_[i]; \
                                _Pragma("unroll") for (int i = 0; i < 2; i++) *(uint4*)((buf) + (256 + lr + 64 * i) * TL_ROW + lc * 8) = B_[i]; }
  TL_LOAD(a0, b0, 0)
  TL_STORE(a0, b0, buf0)
  if (nkt > 1) TL_LOAD(a0, b0, 1)
  if (nkt > 2) TL_LOAD(a1, b1, 2)
  __syncthreads();
  int kt = 0;
  for (; kt + 4 < nkt; kt += 2) {
    TL_STORE(a0, b0, buf1)
    TL_LOAD(a0, b0, kt + 3)
    gemm_tall_compute(acc, buf0, wm, wn, lane);
    __syncthreads();
    TL_STORE(a1, b1, buf0)
    TL_LOAD(a1, b1, kt + 4)
    gemm_tall_compute(acc, buf1, wm, wn, lane);
    __syncthreads();
  }
  for (; kt < nkt; kt += 2) {
    if (kt + 1 < nkt) TL_STORE(a0, b0, buf1)
    if (kt + 3 < nkt) TL_LOAD(a0, b0, kt + 3)
    gemm_tall_compute(acc, buf0, wm, wn, lane);
    __syncthreads();
    if (kt + 1 >= nkt) break;
    if (kt + 2 < nkt) TL_STORE(a1, b1, buf0)
    if (kt + 4 < nkt) TL_LOAD(a1, b1, kt + 4)
    gemm_tall_compute(acc, buf1, wm, wn, lane);
    __syncthreads();
  }
#undef TL_LOAD
#undef TL_STORE
}

template <class AL, class BL>
__device__ __forceinline__ void gemm_kloop_light(f32x16 (&acc)[2][2], AL aload, BL bload, int kt0, int nkt, bf16* smem) {
  const int tid = tidx(), lane = tid & 63, w = tid >> 6;
  const int wm = w >> 1, wn = w & 1;
  const int lr = tid >> 3, lc = tid & 7;
  uint4 a0[4], b0[4];
#define KL_LOAD(A_, B_, st) { _Pragma("unroll") for (int i = 0; i < 4; i++) { A_[i] = aload(lr + 32 * i, (kt0 + (st)) * 8 + lc); B_[i] = bload(lr + 32 * i, (kt0 + (st)) * 8 + lc); } }
#define KL_STORE(A_, B_, buf) { _Pragma("unroll") for (int i = 0; i < 4; i++) { \
    *(uint4*)((buf) + (lr + 32 * i) * LDS_ROW + lc * 8) = A_[i]; *(uint4*)((buf) + STAGE_ELEMS + (lr + 32 * i) * LDS_ROW + lc * 8) = B_[i]; } }
  KL_LOAD(a0, b0, 0)
  KL_STORE(a0, b0, smem)
  if (nkt > 1) KL_LOAD(a0, b0, 1)
  __syncthreads();
  for (int kt = 0; kt < nkt; kt++) {
    bf16* cur = smem + (kt & 1) * 2 * STAGE_ELEMS;
    bf16* nxt = smem + ((kt + 1) & 1) * 2 * STAGE_ELEMS;
    if (kt + 1 < nkt) KL_STORE(a0, b0, nxt)
    if (kt + 2 < nkt) KL_LOAD(a0, b0, kt + 2)
    gemm_compute_stage(acc, cur, cur + STAGE_ELEMS, wm, wn, lane);
    __syncthreads();
  }
#undef KL_LOAD
#undef KL_STORE
}

__device__ __forceinline__ void zero_acc(f32x16 (&acc)[2][2]) {
#pragma unroll
  for (int mi = 0; mi < 2; mi++)
#pragma unroll
    for (int ni = 0; ni < 2; ni++)
#pragma unroll
      for (int r = 0; r < 16; r++) acc[mi][ni][r] = 0.f;
}

#define EPI_ROW(mi, r) (erb + (mi) * 32 + ((r) & 3) + 8 * ((r) >> 2))
#define EPI_BASE int erb = opaque(wm * 64 + 4 * (lane >> 5));
#define EPI_COL(ni) (wn * 64 + (ni) * 32 + (lane & 31))
#define EPI_VARS const int lane = tidx() & 63, w = tidx() >> 6, wm = w >> 1, wn = w & 1;


#define CS_LD 132
template <class F>
__device__ __forceinline__ void epi_rowmajor(const f32x16 (&acc)[2][2], bf16* smem, F f) {
  const int tid = tidx(), lane = tid & 63, w = tid >> 6, wm = w >> 1, wn = w & 1;
  float* Cs = (float*)smem;
#pragma unroll
  for (int mi = 0; mi < 2; mi++)
#pragma unroll
    for (int ni = 0; ni < 2; ni++)
#pragma unroll
      for (int r = 0; r < 16; r++) {
        int row = wm * 64 + mi * 32 + (r & 3) + 8 * (r >> 2) + 4 * (lane >> 5), col = wn * 64 + ni * 32 + (lane & 31);
        Cs[row * CS_LD + col] = acc[mi][ni][r];
      }
  __syncthreads();
#pragma unroll
  for (int it = 0; it < 8; it++) {
    int ch = tid + 256 * it;
    int row = ch >> 4, c8 = (ch & 15) * 8;
    float4 a = *(const float4*)(Cs + row * CS_LD + c8), b = *(const float4*)(Cs + row * CS_LD + c8 + 4);
    float v[8] = {a.x, a.y, a.z, a.w, b.x, b.y, b.z, b.w};
    f(row, c8, v);
  }
  __syncthreads();
}


__device__ __forceinline__ bool tile_swz(int t, int NT, int& mt, int& nt) {
  const int SN = (NT + 7) >> 3;
  {
    const int full = (16 * SN / 8) * 512;
    if ((16 * SN) % 8 == 0 && t >= full) {
      const int x8 = t & 7, jl = (t - full) >> 3;
      mt = 128 + x8; nt = jl;
      return jl < NT;
    }
  }
  const int x = t & 7, q = t >> 3;
  const int sidx = (q >> 6) * 8 + x, loc = q & 63;
  const int sm = sidx / SN, sn = sidx - sm * SN;
  mt = sm * 8 + (loc >> 3); nt = sn * 8 + (loc & 7);
  return (mt < 136) && (nt < NT);
}
#define SWZ_TOTAL(NT) (((17 * (((NT) + 7) >> 3) + 7) >> 3) * 512)

__device__ __forceinline__ void transpose_tile(const float* __restrict__ src, int ldsrc, bf16* __restrict__ dst, int lddst, int k0, int n0, float* lds) {
  const int tid = tidx();
  const int tx = tid & 15, ty = tid >> 4;
#pragma unroll
  for (int i = 0; i < 4; i++) {
    int k = ty + 16 * i;
    float4 v = *(const float4*)(src + (size_t)(k0 + k) * ldsrc + n0 + tx * 4);
    lds[k * 65 + tx * 4 + 0] = v.x; lds[k * 65 + tx * 4 + 1] = v.y; lds[k * 65 + tx * 4 + 2] = v.z; lds[k * 65 + tx * 4 + 3] = v.w;
  }
  __syncthreads();
#pragma unroll
  for (int i = 0; i < 2; i++) {
    int ch = tid + 256 * i;
    int n = ch >> 3, kc = (ch & 7) * 8;
    uint4 o;
    o.x = pack2(lds[(kc + 0) * 65 + n], lds[(kc + 1) * 65 + n]); o.y = pack2(lds[(kc + 2) * 65 + n], lds[(kc + 3) * 65 + n]);
    o.z = pack2(lds[(kc + 4) * 65 + n], lds[(kc + 5) * 65 + n]); o.w = pack2(lds[(kc + 6) * 65 + n], lds[(kc + 7) * 65 + n]);
    *(uint4*)(dst + (size_t)(n0 + n) * lddst + k0 + kc) = o;
  }
  __syncthreads();
}

__device__ __forceinline__ void transpose_job(const float* src, bf16* dst, int K, int N, int batch, float* lds, int jb, int jn) {
  const int tk = K / 64, tn = N / 64;
  const int ntiles = tk * tn * batch;
  for (int t = jb; t < ntiles; t += jn) {
    int b = t / (tk * tn), r = t % (tk * tn);
    int kt = r / tn, nt = r % tn;
    transpose_tile(src + (size_t)b * K * N, N, dst + (size_t)b * K * N, K, kt * 64, nt * 64, lds);
  }
}

__device__ __forceinline__ void convert_job(const float* __restrict__ src, bf16* __restrict__ dst, size_t n, int jb, int jn) {
  size_t n8 = n / 8;
#pragma unroll 4
  for (size_t i = (size_t)jb * 256 + tidx(); i < n8; i += (size_t)jn * 256) {
    float4 a = ((const float4*)src)[2 * i], b = ((const float4*)src)[2 * i + 1];
    uint4 o;
    o.x = pack2(a.x, a.y); o.y = pack2(a.z, a.w); o.z = pack2(b.x, b.y); o.w = pack2(b.z, b.w);
    ((uint4*)dst)[i] = o;
  }
}

__device__ __forceinline__ void convert_fp8_job(const float* __restrict__ src, unsigned char* __restrict__ dst, size_t n, float scale, int jb, int jn) {
  size_t n16 = n / 16;
#pragma unroll 2
  for (size_t i = (size_t)jb * 256 + tidx(); i < n16; i += (size_t)jn * 256) {
    const float4* sp = (const float4*)src + 4 * i;
    unsigned o[4];
#pragma unroll
    for (int q = 0; q < 4; q++) {
      float4 a = sp[q];
      float f0 = fminf(fmaxf(a.x * scale, -448.f), 448.f), f1 = fminf(fmaxf(a.y * scale, -448.f), 448.f);
      float f2 = fminf(fmaxf(a.z * scale, -448.f), 448.f), f3 = fminf(fmaxf(a.w * scale, -448.f), 448.f);
      int wv = 0;
      wv = __builtin_amdgcn_cvt_pk_fp8_f32(f0, f1, wv, false);
      wv = __builtin_amdgcn_cvt_pk_fp8_f32(f2, f3, wv, true);
      o[q] = (unsigned)wv;
    }
    ((uint4*)dst)[i] = make_uint4(o[0], o[1], o[2], o[3]);
  }
}

__device__ __forceinline__ bool light_block(int heavy_x, int& jb, int& jn) {
  const int b = bidx(), g = gdim();
  if ((g & 7) || g < 128) { jb = b; jn = g; return true; }
  {
    const int nh = heavy_x == 1 ? 8 : 16;
    const int jl = b >> 3;
    jn = ((g >> 3) - nh) * 8;
    jb = (jl - nh) * 8 + (b & 7);
    return jl >= nh;
  }
  const int x = b & 7;
  jn = (g >> 3) * (8 - heavy_x);
  jb = (b >> 3) * (8 - heavy_x) + (x - heavy_x);
  return x >= heavy_x;
}

__device__ __forceinline__ void wqk_job(const float* __restrict__ wq, const float* __restrict__ keys, bf16* __restrict__ dst, float* lds, int jb, int jn) {
  float* Ks = lds;
  float* Ws = lds + 64 * 129;
  const int tid = tidx();
  for (int t = jb; t < 32 * 16; t += jn) {
    int n0 = (t / 16) * 64, k0 = (t % 16) * 64;
    int hs = n0 / 128, key0 = n0 % 128;
    for (int i = tid; i < 64 * 128; i += 256) {
      int r = i / 128, d = i % 128;
      Ks[r * 129 + d] = keys[((size_t)hs * 128 + key0 + r) * 128 + d];
      Ws[r * 129 + d] = wq[(size_t)(k0 + r) * 2048 + hs * 128 + d];
    }
    __syncthreads();
    int tx = tid & 15, ty = tid >> 4;
    float acc[4][4];
#pragma unroll
    for (int i = 0; i < 4; i++)
#pragma unroll
      for (int j = 0; j < 4; j++) acc[i][j] = 0.f;
    for (int d = 0; d < 128; d++) {
      float kv[4], wv[4];
#pragma unroll
      for (int i = 0; i < 4; i++) { kv[i] = Ks[(ty * 4 + i) * 129 + d]; wv[i] = Ws[(tx * 4 + i) * 129 + d]; }
#pragma unroll
      for (int i = 0; i < 4; i++)
#pragma unroll
        for (int j = 0; j < 4; j++) acc[i][j] += kv[i] * wv[j];
    }
#pragma unroll
    for (int i = 0; i < 4; i++) {
      uint2 o; o.x = pack2(acc[i][0], acc[i][1]); o.y = pack2(acc[i][2], acc[i][3]);
      *(uint2*)(dst + (size_t)(n0 + ty * 4 + i) * 1024 + k0 + tx * 4) = o;
    }
    __syncthreads();
  }
}

__device__ __forceinline__ void ssm_tables(KP P, int li, float* lds, int jb, int jn) {
  const float* lam_re = P->in[I_LRE] + li * 1024;
  const float* lam_im = P->in[I_LIM] + li * 1024;
  const float* b_re = P->in[I_BRE] + (size_t)li * 16 * 64 * 16;
  const float* b_im = P->in[I_BIM] + (size_t)li * 16 * 64 * 16;
  const float* c_re = P->in[I_CRE] + (size_t)li * 16 * 16 * 64;
  const float* c_im = P->in[I_CIM] + (size_t)li * 16 * 16 * 64;
  const float* log_dt = P->in[I_LDT] + li * 16;
  bf16* Tt = (bf16*)(P->ws + W_TT);
  bf16* Bst = (bf16*)(P->ws + W_BST);
  float* wr = lds; float* wi = lds + 64;
  const int tid = tidx();
  const int NT1 = 16 * 64, NT2 = 16 * 64, NT3 = 16 * 64;
  for (int t = jb; t < NT1 + NT2 + NT3; t += jn) {
    int kind, g, idx;
    if (t < NT1) { kind = 0; g = t / 64; idx = t % 64; }
    else if (t < NT1 + NT2) { kind = 1; g = (t - NT1) / 64; idx = (t - NT1) % 64; }
    else { kind = 2; g = (t - NT1 - NT2) / 64; idx = (t - NT1 - NT2) % 64; }
    int d = (kind == 0) ? idx : (kind == 1 ? idx + 1 : 63 - idx);
    const bool need_coef = (kind != 1);
    if (tid < 64) {
      int n = tid;
      float dt = expf(log_dt[g]);
      float lr = lam_re[g * 64 + n], lim = lam_im[g * 64 + n];
      float ar = lr * dt, ai = lim * dt;
      float dd = (float)(d < 0 ? 0 : d);
      float mag = expf(ar * dd);
      float sn, cs;
      sincosf(ai * dd, &sn, &cs);
      float pr = mag * cs, pi = mag * sn;
      if (need_coef) {
        float m1 = expf(ar); float s1, c1; sincosf(ai, &s1, &c1);
        float nr = m1 * c1 - 1.f, ni = m1 * s1;
        float den = lr * lr + lim * lim;
        float cr = (nr * lr + ni * lim) / den, ci = (ni * lr - nr * lim) / den;
        float xr = pr * cr - pi * ci, xi = pr * ci + pi * cr;
        pr = xr; pi = xi;
      }
      wr[n] = pr; wi[n] = pi;
    }
    __syncthreads();
    if (kind == 0) {
      int p = tid >> 4, q = tid & 15;
      if (d >= 0) {
        float* lcr = lds + 128; float* lci = lcr + 1024; float* lbr = lci + 1024; float* lbi = lbr + 1024;
        for (int i = tid; i < 1024; i += 256) {
          lcr[i] = c_re[(size_t)g * 1024 + i]; lci[i] = c_im[(size_t)g * 1024 + i];
          lbr[i] = b_re[(size_t)g * 1024 + i]; lbi[i] = b_im[(size_t)g * 1024 + i];
        }
        __syncthreads();
        float s = 0.f;
#pragma unroll 8
        for (int n = 0; n < 64; n++) {
          float cr = lcr[p * 64 + n], ci = lci[p * 64 + n];
          float xr = cr * wr[n] - ci * wi[n], xi = cr * wi[n] + ci * wr[n];
          float br = lbr[n * 16 + q], bi = lbi[n * 16 + q];
          s += xr * br - xi * bi;
        }
        Tt[(((size_t)g * 64 + d) * 16 + p) * 16 + q] = f2bf(s);
      }
    } else if (kind == 1) {
      int tt = idx;
      for (int i = tid; i < 2048; i += 256) {
        int p = i >> 7, nn = i & 127, n = nn >> 1, ri = nn & 1;
        float cr = c_re[((size_t)g * 16 + p) * 64 + n], ci = c_im[((size_t)g * 16 + p) * 64 + n];
        float v = ri == 0 ? (cr * wr[n] - ci * wi[n]) : -(cr * wi[n] + ci * wr[n]);
        Tt[KERN_ELEMS + ((size_t)g * 1024 + tt * 16 + p) * 128 + nn] = f2bf(v);
      }
    } else {
      int ss = idx;
      for (int i = tid; i < 2048; i += 256) {
        int nn = i >> 4, q = i & 15, n = nn >> 1, ri = nn & 1;
        float br = b_re[((size_t)g * 64 + n) * 16 + q], bi = b_im[((size_t)g * 64 + n) * 16 + q];
        float v = ri == 0 ? (wr[n] * br - wi[n] * bi) : (wr[n] * bi + wi[n] * br);
        Bst[((size_t)g * 128 + nn) * 1024 + ss * 16 + q] = f2bf(v);
      }
    }
    __syncthreads();
  }
}

__device__ __forceinline__ void pro_misc(KP P, int li, float* lds, int jb, int jn) {
  unsigned char* ws = P->ws;
  transpose_job(P->in[I_WIN] + (size_t)li * 1024 * 5888, (bf16*)(ws + W_IN), 1024, 5888, 1, lds, jb, jn);
  transpose_job(P->in[I_WBS] + (size_t)li * 256 * 1024, (bf16*)(ws + W_BRS), 256, 1024, 1, lds, jb, jn);
  transpose_job(P->in[I_WBA] + (size_t)li * 512 * 1024, (bf16*)(ws + W_BRA), 512, 1024, 1, lds, jb, jn);
  transpose_job(P->in[I_WBR] + (size_t)li * 256 * 1024, (bf16*)(ws + W_BRR), 256, 1024, 1, lds, jb, jn);
  transpose_job(P->in[I_WO] + (size_t)li * 1024 * 1024, (bf16*)(ws + W_O), 1024, 1024, 1, lds, jb, jn);
  transpose_job(P->in[I_WGLU] + (size_t)li * 256 * 256, (bf16*)(ws + W_GLU), 256, 256, 1, lds, jb, jn);
  wqk_job(P->in[I_WQ] + (size_t)li * 1024 * 2048, P->in[I_KEYS] + (size_t)li * 16 * 128 * 128, (bf16*)(ws + W_QK), lds, jb, jn);
  ssm_tables(P, li, lds, jb, jn);
}
__device__ __forceinline__ void pro_cache(KP P, int li, float* lds, int jb, int jn) {
  unsigned char* ws = P->ws;
  transpose_job(P->in[I_CV] + (size_t)li * 16 * 512 * 512, (bf16*)(ws + W_CVT), 512, 512, 16, lds, jb, jn);
  convert_job(P->in[I_CK] + (size_t)li * 16 * 512 * 512, (bf16*)(ws + W_CK), 16ull * 512 * 512, jb, jn);
}

__device__ __forceinline__ void phase_prologue(KP P, int li, bf16* smem) {
  float* lds = (float*)smem;
  unsigned char* ws = P->ws;
  pro_misc(P, li, lds, bidx(), gdim());
  pro_cache(P, li, lds, bidx(), gdim());
  if (li == 0) {
    convert_job(P->in[I_XP], (bf16*)(ws + W_X), (size_t)NPTOK * 1024, bidx(), gdim());
    convert_job(P->in[I_XS], (bf16*)(ws + W_X) + (size_t)NPTOK * 1024, 1024ull * 1024, bidx(), gdim());
    float2* rope = (float2*)(ws + W_ROPE);
    for (int i = bidx() * 256 + tidx(); i < 4096 * 32; i += gdim() * 256) {
      int pos = i >> 5, j = i & 31;
      float freq = expf(-(float)j * (9.210340371976184f / 32.f));
      float ang = (float)pos * freq;
      float sn, cs; sincosf(ang, &sn, &cs);
      rope[i] = make_float2(cs, sn);
    }
  }
}

__device__ __forceinline__ void phase_gemm_in(KP P, int li, bf16* smem) {
  EPI_VARS
  const bf16* X = (const bf16*)(P->ws + W_X);
  const bf16* Wt = (const bf16*)(P->ws + W_IN);
  bf16* H = (bf16*)(P->ws + W_H);
  bf16* HT = (bf16*)(P->ws + W_HT);
  const float2* rope = (const float2*)(P->ws + W_ROPE);
  float* out = P->out;
  for (int t = bidx(); t < 7 * 512; t += gdim()) {
    const int x_ = t & 7, q_ = t >> 3;
    const int loc_ = q_ & 63;
    int mt2, nt;
    if (t < 6 * 512) {
      const int sidx_ = ((q_ >> 6) * 8 + x_) * 2 + (loc_ >> 5);
      const int sm_ = sidx_ / 6, sn_ = sidx_ - sm_ * 6;
      mt2 = sm_ * 4 + ((loc_ & 31) >> 3); nt = sn_ * 8 + (loc_ & 7);
    } else {
      if (loc_ >= 24) continue;
      const int id_ = loc_ * 8 + x_;
      mt2 = 64 + (id_ & 3); nt = id_ >> 2;
    }
    if (nt >= 46) continue;
    const int n0 = nt * 128;
    f32x16 acc2[2][2][2];
    zero_acc(acc2[0]); zero_acc(acc2[1]);
    {
      const bf16* Ab = X + (size_t)mt2 * 256 * 1024;
      const bf16* Bb = Wt + (size_t)n0 * 1024;
      gemm_kloop_tall(acc2,
        [&](int r, int kc) { return *(const uint4*)(Ab + (size_t)r * 1024 + kc * 8); },
        [&](int r, int kc) { return *(const uint4*)(Bb + (size_t)r * 1024 + kc * 8); }, 32, smem);
    }
   auto epilogue = [&](f32x16 (&acc)[2][2], const int m0) {
    EPI_BASE
    const int cb = n0 + wn * 64;
    if (cb >= C_QRET && cb < C_VRET) {
      const float sc = (cb < C_KRET) ? 0.125f : 1.f;
#pragma unroll
      for (int mi = 0; mi < 2; mi++)
#pragma unroll
        for (int r = 0; r < 16; r++) {
          int row = m0 + EPI_ROW(mi, r);
          int pos = row < NPTOK ? (row & 4095) : 2048 + ((row - NPTOK) & 63);
          float2 cs = rope[pos * 32 + (lane & 31)];
          float x1 = acc[mi][0][r], x2 = acc[mi][1][r];
          acc[mi][0][r] = (x1 * cs.x - x2 * cs.y) * sc;
          acc[mi][1][r] = (x1 * cs.y + x2 * cs.x) * sc;
        }
    }
    if (cb >= C_KATT && cb < C_QRET) {
      const bool isv = cb >= C_VATT;
      const int c0 = isv ? C_VATT : C_KATT;
#pragma unroll
      for (int mi = 0; mi < 2; mi++)
#pragma unroll
        for (int r = 0; r < 16; r++) {
          int row = m0 + EPI_ROW(mi, r);
#pragma unroll
          for (int ni = 0; ni < 2; ni++) {
            int col = n0 + EPI_COL(ni) - c0;
            if (row < NPTOK) {
              int b = row >> 12, tt = row & 4095;
              if (tt >= 3584) out[(isv ? O_AV_P : O_AK_P) + (((size_t)(li * 4 + b) * 512 + (tt - 3584)) * 512 + col)] = acc[mi][ni][r];
            } else {
              int rs = row - NPTOK;
              out[(isv ? O_AV_S : O_AK_S) + ((size_t)li * 1024 + rs) * 512 + col] = acc[mi][ni][r];
            }
          }
        }
    }
    int trow = -1;
    if (cb >= C_VATT && cb < C_QRET) trow = cb - C_VATT;
    else if (cb >= C_KRET && cb < C_VRET) trow = 512 + cb - C_KRET;
    else if (cb >= C_VRET && cb < C_GRET) trow = 768 + cb - C_VRET;
    if (trow >= 0) {
#pragma unroll
      for (int mi = 0; mi < 2; mi++)
#pragma unroll
        for (int ni = 0; ni < 2; ni++)
#pragma unroll
          for (int rg = 0; rg < 4; rg++) {
            int rowb = m0 + wm * 64 + mi * 32 + 8 * rg + 4 * (lane >> 5);
            uint2 o; o.x = pack2(acc[mi][ni][rg * 4], acc[mi][ni][rg * 4 + 1]); o.y = pack2(acc[mi][ni][rg * 4 + 2], acc[mi][ni][rg * 4 + 3]);
            *(uint2*)(HT + (size_t)(trow + ni * 32 + (lane & 31)) * NTOK + rowb) = o;
          }
    }
    const bool skipH = (n0 >= C_VATT && n0 < C_QRET) || (n0 >= C_VRET && n0 < C_GRET);
    if (!skipH) epi_rowmajor(acc, smem, [&](int row, int c8, float (&v)[8]) {
      uint4 o; o.x = pack2(v[0], v[1]); o.y = pack2(v[2], v[3]); o.z = pack2(v[4], v[5]); o.w = pack2(v[6], v[7]);
      *(uint4*)(H + (size_t)(m0 + row) * INC + n0 + c8) = o;
    });
   };
   epilogue(acc2[0], mt2 * 256);
   epilogue(acc2[1], mt2 * 256 + 128);
  }
}

#define AP_LD 72
__device__ __forceinline__ void attn_item(KP P, int li, int item, bf16* smem) {
  float* bias = (float*)smem;
  bf16* pbuf = smem + 2048;
  const bf16* H = (const bf16*)(P->ws + W_H);
  const bf16* HT = (const bf16*)(P->ws + W_HT);
  bf16* Yatt = (bf16*)(P->ws + W_YATT);
  const int h = item & 7, cidx = item >> 3;
  const float* tab = P->in[I_BIAS] + (size_t)li * 513 * 8;
  const int tid = opaque(tidx());
  const int lane = tid & 63, w = tid >> 6, l15 = lane & 15, g = lane >> 4;
  __syncthreads();
  for (int i = tid; i < 640; i += 256) bias[i] = tab[(min(i - 63, 256) + 256) * 8 + h];
  const int row0 = cidx * 64;
  const bf16* Qp = H + (size_t)(row0 + w * 16) * INC + C_QATT + h * 64;
  const bf16* Kcur = H + (size_t)row0 * INC + C_KATT + h * 64;
  const bf16* VTcur = HT + (size_t)(h * 64) * NTOK + row0;
  bf16* Yout = Yatt + (size_t)(row0 + w * 16) * 512 + h * 64;
  const bf16* Kpast; const bf16* VTpast; int kst; size_t vst; int jt_start, smin;
  if (cidx < 256) {
    int c = cidx & 63;
    jt_start = c >= 8 ? 0 : 32 - 4 * c;
    smin = c >= 8 ? 0 : 8 - c;
    Kpast = Kcur - (ptrdiff_t)512 * INC; kst = INC;
    VTpast = VTcur - 512; vst = NTOK;
  } else {
    int b = cidx - 256;
    jt_start = 0; smin = 0;
    Kpast = (const bf16*)(P->ws + W_CK) + (size_t)b * 512 * 512 + h * 64; kst = 512;
    VTpast = (const bf16*)(P->ws + W_CVT) + (size_t)b * 512 * 512 + (size_t)(h * 64) * 512; vst = 512;
  }
  const int lr = tid >> 2, lc = (tid & 3) * 16;
  bf16x8 qf[2];
#pragma unroll
  for (int ks = 0; ks < 2; ks++) qf[ks] = u4_to_frag(*(const uint4*)(Qp + (size_t)l15 * INC + ks * 32 + g * 8));
  uint4 r0a, r0b, r1a, r1b, r2a, r2b;
#define AP_LOAD(p, va, vb) { const int step_ = ((p) < 9) ? (p) : (p) - 9; const int se_ = max(step_, smin); const bf16* src_; \
    if ((p) < 9) src_ = (se_ < 8) ? (Kpast + (ptrdiff_t)(se_ * 64 + lr) * kst) : (Kcur + (size_t)lr * INC); \
    else src_ = (se_ < 8) ? (VTpast + (size_t)lr * vst + se_ * 64) : (VTcur + (size_t)lr * NTOK); \
    va = *(const uint4*)(src_ + lc); vb = *(const uint4*)(src_ + lc + 8); }
#define AP_STORE(p, va, vb) { bf16* dst_ = pbuf + ((p) & 1) * (64 * AP_LD) + lr * AP_LD + lc; *(uint4*)dst_ = va; *(uint4*)(dst_ + 8) = vb; }
  AP_LOAD(0, r0a, r0b) AP_LOAD(1, r1a, r1b) AP_LOAD(2, r2a, r2b)
  AP_STORE(0, r0a, r0b)
  __syncthreads();
  f32x4 s[36];
#pragma unroll
  for (int p = 0; p < 9; p++) {
    const bf16* pc = pbuf + (p & 1) * (64 * AP_LD);
#pragma unroll
    for (int t = 0; t < 4; t++) {
      const int jt = p * 4 + t;
      s[jt] = f32x4{0.f, 0.f, 0.f, 0.f};
#pragma unroll
      for (int ks = 0; ks < 2; ks++) {
        bf16x8 kf = *(const bf16x8*)(pc + (t * 16 + l15) * AP_LD + ks * 32 + g * 8);
        s[jt] = __builtin_amdgcn_mfma_f32_16x16x32_bf16(kf, qf[ks], s[jt], 0, 0, 0);
      }
    }
    AP_STORE(p + 1, r1a, r1b)
    r1a = r2a; r1b = r2b;
    AP_LOAD(p + 3, r2a, r2b)
    __syncthreads();
  }
  float inv;
  {
    const int iq = w * 16 + l15;
    const float* bq = bias + (iq - 4 * g + 575);
    float mx = -3.0e38f;
#pragma unroll
    for (int jt = 0; jt < 36; jt++) {
#pragma unroll
      for (int r = 0; r < 4; r++) {
        float v = s[jt][r] * 0.125f + bq[-(jt * 16 + r)];
        if (jt < 32) v = (jt < jt_start) ? -3.0e38f : v;
        s[jt][r] = v;
        mx = fmaxf(mx, v);
      }
    }
    mx = fmaxf(mx, __shfl_xor(mx, 16));
    mx = fmaxf(mx, __shfl_xor(mx, 32));
    float sum = 0.f;
#pragma unroll
    for (int jt = 0; jt < 36; jt++) {
#pragma unroll
      for (int r = 0; r < 4; r++) { float e = __expf(s[jt][r] - mx); s[jt][r] = e; sum += e; }
    }
    sum += __shfl_xor(sum, 16);
    sum += __shfl_xor(sum, 32);
    inv = 1.f / sum;
  }
  f32x4 o[4];
#pragma unroll
  for (int et = 0; et < 4; et++) o[et] = f32x4{0.f, 0.f, 0.f, 0.f};
#pragma unroll
  for (int p = 9; p < 18; p++) {
    const bf16* pc = pbuf + (p & 1) * (64 * AP_LD);
    const int step = p - 9;
#pragma unroll
    for (int u = 0; u < 2; u++) {
      const int kk = step * 2 + u;
      union { uint4 u4; bf16x8 f; } pf;
      pf.u4.x = pack2(s[2 * kk][0], s[2 * kk][1]); pf.u4.y = pack2(s[2 * kk][2], s[2 * kk][3]);
      pf.u4.z = pack2(s[2 * kk + 1][0], s[2 * kk + 1][1]); pf.u4.w = pack2(s[2 * kk + 1][2], s[2 * kk + 1][3]);
#pragma unroll
      for (int et = 0; et < 4; et++) {
        const bf16* vp = pc + (et * 16 + l15) * AP_LD + u * 32 + 4 * g;
        union { uint4 u4; bf16x8 f; } vf;
        uint2 a = *(const uint2*)vp, b = *(const uint2*)(vp + 16);
        vf.u4.x = a.x; vf.u4.y = a.y; vf.u4.z = b.x; vf.u4.w = b.y;
        o[et] = __builtin_amdgcn_mfma_f32_16x16x32_bf16(vf.f, pf.f, o[et], 0, 0, 0);
      }
    }
    if (p + 1 < 18) { AP_STORE(p + 1, r1a, r1b) }
    r1a = r2a; r1b = r2b;
    if (p + 3 < 18) { AP_LOAD(p + 3, r2a, r2b) }
    __syncthreads();
  }
#pragma unroll
  for (int et = 0; et < 4; et++) {
    uint2 ov; ov.x = pack2(o[et][0] * inv, o[et][1] * inv); ov.y = pack2(o[et][2] * inv, o[et][3] * inv);
    *(uint2*)(Yout + (size_t)l15 * 512 + et * 16 + 4 * g) = ov;
  }
}

__device__ __forceinline__ void ret_contrib_item(KP P, int item) {
  const bf16* HT = (const bf16*)(P->ws + W_HT);
  float* CT = (float*)(P->ws + W_CT);
  const int h = item & 3, cidx = item >> 2;
  const int lane = opaque(tidx() & 63), w = tidx() >> 6, l15 = lane & 15, g = lane >> 4;
  const float lg2 = log2f(1.f - exp2f(-5.f - (float)h));
  const int tok0 = cidx * 64;
  f32x4 acc[4];
#pragma unroll
  for (int dt = 0; dt < 4; dt++) acc[dt] = f32x4{0.f, 0.f, 0.f, 0.f};
#pragma unroll
  for (int ks = 0; ks < 2; ks++) {
    uint4 vr = *(const uint4*)(HT + (size_t)(768 + h * 64 + w * 16 + l15) * NTOK + tok0 + ks * 32 + g * 8);
    unsigned vv[4] = {vr.x, vr.y, vr.z, vr.w};
    union { uint4 u; bf16x8 f; } vf;
    unsigned oo[4];
#pragma unroll
    for (int q = 0; q < 4; q++) {
      int j = ks * 32 + g * 8 + 2 * q;
      float k0 = exp2f(lg2 * (float)(63 - j)), k1 = exp2f(lg2 * (float)(62 - j));
      oo[q] = pack2(bflo(vv[q]) * k0, bfhi(vv[q]) * k1);
    }
    vf.u = make_uint4(oo[0], oo[1], oo[2], oo[3]);
#pragma unroll
    for (int dt = 0; dt < 4; dt++) {
      bf16x8 kf = u4_to_frag(*(const uint4*)(HT + (size_t)(512 + h * 64 + dt * 16 + l15) * NTOK + tok0 + ks * 32 + g * 8));
      acc[dt] = __builtin_amdgcn_mfma_f32_16x16x32_bf16(vf.f, kf, acc[dt], 0, 0, 0);
    }
  }
#pragma unroll
  for (int dt = 0; dt < 4; dt++)
#pragma unroll
    for (int r = 0; r < 4; r++) {
      int e = w * 16 + 4 * g + r, d = dt * 16 + l15;
      CT[((size_t)(cidx * 4 + h) * 64 + e) * 64 + d] = acc[dt][r];
    }
}

__device__ __forceinline__ void ssm_state_tile(KP P, int t, bf16* smem) {
  EPI_VARS
  const bf16* H = (const bf16*)(P->ws + W_H);
  const bf16* Bst = (const bf16*)(P->ws + W_BST);
  float* SC = (float*)(P->ws + W_SC);
  const int g = t / 3, mt = t % 3;
  const int m0 = mt * 128;
  f32x16 acc[2][2];
  zero_acc(acc);
  const bf16* Bb = Bst + (size_t)g * 128 * 1024;
  gemm_kloop(acc,
    [&](int r, int kc) { int c = min(m0 + r, NCHUNK - 1); int s = kc >> 1, q0 = (kc & 1) * 8;
                         return *(const uint4*)(H + (size_t)(c * 64 + s) * INC + g * 16 + q0); },
    [&](int r, int kc) { return *(const uint4*)(Bb + (size_t)r * 1024 + kc * 8); }, 0, 16, smem);
    EPI_BASE
#pragma unroll
  for (int mi = 0; mi < 2; mi++)
#pragma unroll
    for (int ni = 0; ni < 2; ni++)
#pragma unroll
      for (int r = 0; r < 16; r++) {
        int c = m0 + EPI_ROW(mi, r), nn = EPI_COL(ni);
        if (c < NCHUNK) SC[((size_t)c * 16 + g) * 128 + nn] = acc[mi][ni][r];
      }
}

__device__ __forceinline__ void phase_A(KP P, int li, bf16* smem) {
  const int n_attn = NCHUNK * 8, n_ret = NCHUNK * 4, n_ssm = 48;
  const int total = n_attn + n_ret + n_ssm;
  for (int t = bidx(); t < total; t += gdim()) {
    if (t < n_ssm) ssm_state_tile(P, t, smem);
    else if (t < n_ssm + n_attn) attn_item(P, li, t - n_ssm, smem);
    else ret_contrib_item(P, t - n_ssm - n_attn);
  }
}

__device__ __forceinline__ void phase_B(KP P, int li) {
  const float* CT = (const float*)(P->ws + W_CT);
  bf16* SP = (bf16*)(P->ws + W_SPREV);
  const float* SC = (const float*)(P->ws + W_SC);
  bf16* HS = (bf16*)(P->ws + W_HS);
  float* out = P->out;
  const int gt = bidx() * 256 + tidx(), gn = gdim() * 256;
  for (int i = gt; i < 65536; i += gn) {
    int ed = i & 4095, h = (i >> 12) & 3, b = i >> 14;
    float g64 = exp2f(64.f * log2f(1.f - exp2f(-5.f - (float)h)));
    float S = 0.f;
    for (int c0 = 0; c0 < 64; c0 += 16) {
      float ct[16];
#pragma unroll
      for (int u = 0; u < 16; u++) ct[u] = CT[((size_t)((b * 64 + c0 + u) * 4 + h)) * 4096 + ed];
#pragma unroll
      for (int u = 0; u < 16; u++) {
        SP[((size_t)((b * 64 + c0 + u) * 4 + h)) * 4096 + ed] = f2bf(S);
        S = g64 * S + ct[u];
      }
    }
    int e = ed >> 6, d = ed & 63;
    out[O_RET_P + ((size_t)((li * 4 + b) * 4 + h)) * 4096 + d * 64 + e] = S;
  }
  for (int i = gt; i < 262144; i += gn) {
    int ed = i & 4095, h = (i >> 12) & 3, b = i >> 14;
    int e = ed >> 6, d = ed & 63;
    float g64 = exp2f(64.f * log2f(1.f - exp2f(-5.f - (float)h)));
    size_t sidx = ((size_t)((li * 16 + b) * 4 + h)) * 4096 + d * 64 + e;
    float S = P->in[I_SRET][sidx];
    size_t idx = ((size_t)((256 + b) * 4 + h)) * 4096 + ed;
    SP[idx] = f2bf(S);
    S = g64 * S + CT[idx];
    out[O_RET_S + sidx] = S;
  }
  for (int i = gt; i < 4096 + 16384; i += gn) {
    const bool prompt = i < 4096;
    int j = prompt ? i : i - 4096;
    int n = j & 63, g = (j >> 6) & 15, b = j >> 10;
    float dt = expf(P->in[I_LDT][li * 16 + g]);
    float ar = P->in[I_LRE][li * 1024 + g * 64 + n] * dt, ai = P->in[I_LIM][li * 1024 + g * 64 + n] * dt;
    float mag = expf(ar * 64.f); float sn, cs; sincosf(ai * 64.f, &sn, &cs);
    float a_r = mag * cs, a_i = mag * sn;
    if (prompt) {
      float hr = 0.f, hi = 0.f;
      for (int c0 = 0; c0 < 64; c0 += 16) {
        float2 cc[16];
#pragma unroll
        for (int u = 0; u < 16; u++) cc[u] = *(const float2*)(SC + ((size_t)(b * 64 + c0 + u) * 16 + g) * 128 + n * 2);
#pragma unroll
        for (int u = 0; u < 16; u++) {
          size_t idx = ((size_t)(b * 64 + c0 + u) * 16 + g) * 128 + n * 2;
          *(unsigned*)(HS + idx) = pack2(hr, hi);
          float nr = a_r * hr - a_i * hi + cc[u].x, ni = a_r * hi + a_i * hr + cc[u].y;
          hr = nr; hi = ni;
        }
      }
      out[O_SRE_P + ((size_t)(li * 4 + b) * 16 + g) * 64 + n] = hr;
      out[O_SIM_P + ((size_t)(li * 4 + b) * 16 + g) * 64 + n] = hi;
    } else {
      size_t sidx = ((size_t)(li * 16 + b) * 16 + g) * 64 + n;
      float hr = P->in[I_SRE][sidx], hi = P->in[I_SIM][sidx];
      size_t idx = ((size_t)(256 + b) * 16 + g) * 128 + n * 2;
      *(unsigned*)(HS + idx) = pack2(hr, hi);
      float cr = SC[idx], ci = SC[idx + 1];
      out[O_SRE_S + sidx] = a_r * hr - a_i * hi + cr;
      out[O_SIM_S + sidx] = a_r * hi + a_i * hr + ci;
    }
  }
}

__device__ __forceinline__ void ret_finish_item(KP P, int li, int item) {
  const bf16* H = (const bf16*)(P->ws + W_H);
  const bf16* HT = (const bf16*)(P->ws + W_HT);
  const bf16* SP = (const bf16*)(P->ws + W_SPREV);
  bf16* Yret = (bf16*)(P->ws + W_YRET);
  const float* gng = P->in[I_GNG] + li * 256;
  const int h = item & 3, cidx = item >> 2;
  const int lane = opaque(tidx() & 63), w = tidx() >> 6, l15 = lane & 15, g = lane >> 4;
  const float lg2 = log2f(1.f - exp2f(-5.f - (float)h));
  const int row0 = cidx * 64;
  const int iq = w * 16 + l15;
  bf16x8 qf[2];
#pragma unroll
  for (int ks = 0; ks < 2; ks++) qf[ks] = u4_to_frag(*(const uint4*)(H + (size_t)(row0 + iq) * INC + C_QRET + h * 64 + ks * 32 + g * 8));
  f32x4 s[4];
#pragma unroll
  for (int jt = 0; jt < 4; jt++) {
    s[jt] = f32x4{0.f, 0.f, 0.f, 0.f};
#pragma unroll
    for (int ks = 0; ks < 2; ks++) {
      bf16x8 kf = u4_to_frag(*(const uint4*)(H + (size_t)(row0 + jt * 16 + l15) * INC + C_KRET + h * 64 + ks * 32 + g * 8));
      s[jt] = __builtin_amdgcn_mfma_f32_16x16x32_bf16(kf, qf[ks], s[jt], 0, 0, 0);
    }
#pragma unroll
    for (int r = 0; r < 4; r++) {
      int j = jt * 16 + 4 * g + r;
      int dd = iq - j; dd = dd < 0 ? -dd : dd;
      s[jt][r] *= exp2f(lg2 * (float)dd);
    }
  }
  f32x4 o[4], oi[4];
#pragma unroll
  for (int et = 0; et < 4; et++) { o[et] = f32x4{0.f, 0.f, 0.f, 0.f}; oi[et] = f32x4{0.f, 0.f, 0.f, 0.f}; }
#pragma unroll
  for (int kk = 0; kk < 2; kk++) {
    union { uint4 u; bf16x8 f; } pf;
    pf.u.x = pack2(s[2 * kk][0], s[2 * kk][1]); pf.u.y = pack2(s[2 * kk][2], s[2 * kk][3]);
    pf.u.z = pack2(s[2 * kk + 1][0], s[2 * kk + 1][1]); pf.u.w = pack2(s[2 * kk + 1][2], s[2 * kk + 1][3]);
#pragma unroll
    for (int et = 0; et < 4; et++) {
      const bf16* vp = HT + (size_t)(768 + h * 64 + et * 16 + l15) * NTOK + row0 + kk * 32 + 4 * g;
      union { uint4 u; bf16x8 f; } vf;
      uint2 a = *(const uint2*)vp, b = *(const uint2*)(vp + 16);
      vf.u.x = a.x; vf.u.y = a.y; vf.u.z = b.x; vf.u.w = b.y;
      o[et] = __builtin_amdgcn_mfma_f32_16x16x32_bf16(vf.f, pf.f, o[et], 0, 0, 0);
    }
  }
#pragma unroll
  for (int ks = 0; ks < 2; ks++)
#pragma unroll
    for (int et = 0; et < 4; et++) {
      bf16x8 sf = u4_to_frag(*(const uint4*)(SP + ((size_t)(cidx * 4 + h) * 64 + et * 16 + l15) * 64 + ks * 32 + g * 8));
      oi[et] = __builtin_amdgcn_mfma_f32_16x16x32_bf16(sf, qf[ks], oi[et], 0, 0, 0);
    }
  const float qw = exp2f(lg2 * (float)(iq + 1));
  float sum = 0.f;
#pragma unroll
  for (int et = 0; et < 4; et++)
#pragma unroll
    for (int r = 0; r < 4; r++) { o[et][r] += qw * oi[et][r]; sum += o[et][r]; }
  sum += __shfl_xor(sum, 16); sum += __shfl_xor(sum, 32);
  const float mu = sum * (1.f / 64.f);
  float vs = 0.f;
#pragma unroll
  for (int et = 0; et < 4; et++)
#pragma unroll
    for (int r = 0; r < 4; r++) { float d = o[et][r] - mu; vs += d * d; }
  vs += __shfl_xor(vs, 16); vs += __shfl_xor(vs, 32);
  const float rstd = rsqrtf(vs * (1.f / 64.f) + LN_EPS);
#pragma unroll
  for (int et = 0; et < 4; et++) {
    int e0 = et * 16 + 4 * g;
    uint2 gr = *(const uint2*)(H + (size_t)(row0 + iq) * INC + C_GRET + h * 64 + e0);
    float gv[4] = {bflo(gr.x), bfhi(gr.x), bflo(gr.y), bfhi(gr.y)};
    float y[4];
#pragma unroll
    for (int r = 0; r < 4; r++) {
      float gg = gv[r];
      y[r] = (o[et][r] - mu) * rstd * gng[h * 64 + e0 + r] * (gg * sigmoidf_(gg));
    }
    uint2 ov; ov.x = pack2(y[0], y[1]); ov.y = pack2(y[2], y[3]);
    *(uint2*)(Yret + (size_t)(row0 + iq) * 256 + h * 64 + e0) = ov;
  }
}

__device__ __forceinline__ void ssm_toep_tile(KP P, int li, int t, bf16* smem) {
  EPI_VARS
  const bf16* H = (const bf16*)(P->ws + W_H);
  const bf16* Tt = (const bf16*)(P->ws + W_TT);
  const bf16* HS = (const bf16*)(P->ws + W_HS);
  bf16* Zs = (bf16*)(P->ws + W_CT);
  const float* dsk = P->in[I_SD] + li * 256;
  const int g = t / 24, r24 = t % 24, mt = r24 / 8, nt = r24 % 8;
  const int m0 = mt * 128, n0 = nt * 128;
  f32x16 acc[2][2];
  zero_acc(acc);
  const bf16* Kg = Tt + (size_t)g * 64 * 256;
  const bf16* Cg = Tt + KERN_ELEMS + ((size_t)g * 1024 + n0) * 128;
  auto al = [&](int r, int kc) {
    int c = min(m0 + r, NCHUNK - 1);
    if (kc < 128) { int s = kc >> 1, q0 = (kc & 1) * 8; return *(const uint4*)(H + (size_t)(c * 64 + s) * INC + g * 16 + q0); }
    return *(const uint4*)(HS + ((size_t)c * 16 + g) * 128 + (kc - 128) * 8);
  };
  auto bl = [&](int r, int kc) {
    if (kc < 128) {
      int n = n0 + r, tt = n >> 4, p = n & 15, ss = kc >> 1, q0 = (kc & 1) * 8;
      int d = tt - ss;
      uint4 v = *(const uint4*)(Kg + ((size_t)max(d, 0) * 16 + p) * 16 + q0);
      if (d < 0) v = make_uint4(0u, 0u, 0u, 0u);
      return v;
    }
    return *(const uint4*)(Cg + (size_t)r * 128 + (kc - 128) * 8);
  };
  gemm_kloop(acc, al, bl, 0, 2 * (nt + 1), smem);
  gemm_kloop(acc, al, bl, 16, 2, smem);
    EPI_BASE
#pragma unroll
  for (int mi = 0; mi < 2; mi++)
#pragma unroll
    for (int ni = 0; ni < 2; ni++)
#pragma unroll
      for (int r = 0; r < 16; r++) {
        int c = m0 + EPI_ROW(mi, r), n = n0 + EPI_COL(ni);
        if (c < NCHUNK) {
          int tt = n >> 4, p = n & 15;
          size_t tok = (size_t)c * 64 + tt;
          float u = bf2f(H[tok * INC + g * 16 + p]);
          float y = acc[mi][ni][r] + dsk[g * 16 + p] * u;
          Zs[tok * 256 + g * 16 + p] = f2bf(gelu_tanh(y));
        }
      }
}

__device__ __forceinline__ void phase_C(KP P, int li, bf16* smem) {
  const int n_toep = 16 * 24, n_ret = NCHUNK * 4;
  for (int t = bidx(); t < n_toep + n_ret; t += gdim()) {
    if (t < n_toep) ssm_toep_tile(P, li, t, smem);
    else ret_finish_item(P, li, t - n_toep);
  }
}

__device__ __forceinline__ void phase_D(KP P, int li, bf16* smem) {
  EPI_VARS
  const bf16* Zs = (const bf16*)(P->ws + W_CT);
  const bf16* Wt = (const bf16*)(P->ws + W_GLU);
  bf16* Yssm = (bf16*)(P->ws + W_YSSM);
  const float* bg = P->in[I_BGLU] + li * 256;
  for (int t = bidx(); t < 136 * 2; t += gdim()) {
    const int m0 = (t >> 1) * 128, n0 = (t & 1) * 128;
    f32x16 acc[2][2];
    zero_acc(acc);
    const bf16* Ab = Zs + (size_t)m0 * 256;
    const bf16* Bb = Wt + (size_t)n0 * 256;
    gemm_kloop(acc,
      [&](int r, int kc) { return *(const uint4*)(Ab + (size_t)r * 256 + kc * 8); },
      [&](int r, int kc) { return *(const uint4*)(Bb + (size_t)r * 256 + kc * 8); }, 0, 4, smem);
    EPI_BASE
#pragma unroll
    for (int mi = 0; mi < 2; mi++)
#pragma unroll
      for (int ni = 0; ni < 2; ni++)
#pragma unroll
        for (int r = 0; r < 16; r++) {
          int row = m0 + EPI_ROW(mi, r), col = n0 + EPI_COL(ni);
          float z = bf2f(Zs[(size_t)row * 256 + col]);
          Yssm[(size_t)row * 256 + col] = f2bf(z * sigmoidf_(acc[mi][ni][r] + bg[col]));
        }
  }
}

__device__ __forceinline__ void phase_E(KP P, int li, bf16* smem) {
  EPI_VARS
  const bf16* H = (const bf16*)(P->ws + W_H);
  bf16* MG = (bf16*)(P->ws + W_HT);
  for (int t = bidx(); t < SWZ_TOTAL(8); t += gdim()) {
    int mt_, nt_;
    if (!tile_swz(t, 8, mt_, nt_)) continue;
    const int m0 = mt_ * 128, n0 = nt_ * 128;
    f32x16 tot[2][2];
    zero_acc(tot);
#pragma unroll 1
    for (int br = 0; br < 3; br++) {
      const bf16* Y = (const bf16*)(P->ws + (br == 0 ? W_YSSM : (br == 1 ? W_YATT : W_YRET)));
      const bf16* Wt = (const bf16*)(P->ws + (br == 0 ? W_BRS : (br == 1 ? W_BRA : W_BRR)));
      const int K = (br == 1) ? 512 : 256;
      f32x16 acc[2][2];
      zero_acc(acc);
      const bf16* Ab = Y + (size_t)m0 * K;
      const bf16* Bb = Wt + (size_t)n0 * K;
      gemm_kloop_light(acc,
        [&](int r, int kc) { return *(const uint4*)(Ab + (size_t)r * K + kc * 8); },
        [&](int r, int kc) { return *(const uint4*)(Bb + (size_t)r * K + kc * 8); }, 0, K / 64, smem);
#pragma unroll
      for (int mi = 0; mi < 2; mi++)
#pragma unroll
        for (int ni = 0; ni < 2; ni++) {
          EPI_BASE
#pragma unroll
          for (int r = 0; r < 16; r++) {
            int row = m0 + EPI_ROW(mi, r), col = n0 + EPI_COL(ni);
            float gt = bf2f(H[(size_t)row * INC + C_GATE + br * 1024 + col]);
            tot[mi][ni][r] += sigmoidf_(gt) * acc[mi][ni][r];
          }
        }
    }
    EPI_BASE
#pragma unroll
    for (int mi = 0; mi < 2; mi++)
#pragma unroll
      for (int ni = 0; ni < 2; ni++)
#pragma unroll
        for (int r = 0; r < 16; r++) {
          int row = m0 + EPI_ROW(mi, r), col = n0 + EPI_COL(ni);
          MG[(size_t)row * 1024 + col] = f2bf(tot[mi][ni][r]);
        }
  }
  { int jb, jn; if (light_block(1, jb, jn)) convert_fp8_job(P->in[I_PU] + (size_t)li * 16384 * 1024, P->ws + W_U, 16384ull * 1024, 256.f, jb, jn); }
}

__device__ __forceinline__ void phase_WO(KP P, int li, bf16* smem) {
  EPI_VARS
  const bf16* MG = (const bf16*)(P->ws + W_HT);
  const bf16* Wt = (const bf16*)(P->ws + W_O);
  const bf16* X = (const bf16*)(P->ws + W_X);
  bf16* Z = (bf16*)(P->ws + W_H);
  for (int t = bidx(); t < SWZ_TOTAL(8); t += gdim()) {
    int mt_, nt_;
    if (!tile_swz(t, 8, mt_, nt_)) continue;
    const int m0 = mt_ * 128, n0 = nt_ * 128;
    f32x16 acc[2][2];
    zero_acc(acc);
    const bf16* Ab = MG + (size_t)m0 * 1024;
    const bf16* Bb = Wt + (size_t)n0 * 1024;
    gemm_kloop(acc,
      [&](int r, int kc) { return *(const uint4*)(Ab + (size_t)r * 1024 + kc * 8); },
      [&](int r, int kc) { return *(const uint4*)(Bb + (size_t)r * 1024 + kc * 8); }, 0, 16, smem);
    EPI_BASE
    epi_rowmajor(acc, smem, [&](int row, int c8, float (&v)[8]) {
      uint4 xr = *(const uint4*)(X + (size_t)(m0 + row) * 1024 + n0 + c8);
      uint4 o;
      o.x = pack2(DN_ALPHA * bflo(xr.x) + v[0], DN_ALPHA * bfhi(xr.x) + v[1]); o.y = pack2(DN_ALPHA * bflo(xr.y) + v[2], DN_ALPHA * bfhi(xr.y) + v[3]);
      o.z = pack2(DN_ALPHA * bflo(xr.z) + v[4], DN_ALPHA * bfhi(xr.z) + v[5]); o.w = pack2(DN_ALPHA * bflo(xr.w) + v[6], DN_ALPHA * bfhi(xr.w) + v[7]);
      *(uint4*)(Z + (size_t)(m0 + row) * 1024 + n0 + c8) = o;
    });
  }
  { int jb, jn; if (light_block(1, jb, jn)) convert_fp8_job(P->in[I_PV] + (size_t)li * 16384 * 1024, P->ws + W_V, 16384ull * 1024, 64.f, jb, jn); }
}

__device__ __forceinline__ void phase_LN(KP P, const float* gam, const float* bet, bool final_out, size_t xoff) {
  const bf16* Z = (const bf16*)(P->ws + W_H);
  bf16* X = (bf16*)(P->ws + xoff);
  const int lane = tidx() & 63;
  const int gw = bidx() * 4 + (tidx() >> 6), nw = gdim() * 4;
#pragma unroll 4
  for (int row = gw; row < NTOK; row += nw) {
    float4 v[4];
    float s = 0.f;
#pragma unroll
    for (int i = 0; i < 4; i++) {
      uint2 zr = *(const uint2*)(Z + (size_t)row * 1024 + i * 256 + lane * 4);
      v[i] = make_float4(bflo(zr.x), bfhi(zr.x), bflo(zr.y), bfhi(zr.y));
      s += v[i].x + v[i].y + v[i].z + v[i].w;
    }
    s = wsum(s);
    const float mu = s * (1.f / 1024.f);
    float q = 0.f;
#pragma unroll
    for (int i = 0; i < 4; i++) { float a = v[i].x - mu, b = v[i].y - mu, c = v[i].z - mu, d = v[i].w - mu; q += a * a + b * b + c * c + d * d; }
    q = wsum(q);
    const float rstd = rsqrtf(q * (1.f / 1024.f) + LN_EPS);
#pragma unroll
    for (int i = 0; i < 4; i++) {
      int col = i * 256 + lane * 4;
      float4 gg = *(const float4*)(gam + col), bb = *(const float4*)(bet + col);
      float4 y;
      y.x = (v[i].x - mu) * rstd * gg.x + bb.x; y.y = (v[i].y - mu) * rstd * gg.y + bb.y;
      y.z = (v[i].z - mu) * rstd * gg.z + bb.z; y.w = (v[i].w - mu) * rstd * gg.w + bb.w;
      uint2 o; o.x = pack2(y.x, y.y); o.y = pack2(y.z, y.w);
      if (!final_out) *(uint2*)(X + (size_t)row * 1024 + col) = o;
      else *(float4*)(P->out + (size_t)row * 1024 + col) = y;
    }
  }
}

__device__ __forceinline__ void phase_PQ(KP P, int li, bf16* smem) {
  EPI_VARS
  const bf16* X = (const bf16*)(P->ws + W_HT);
  const bf16* Wt = (const bf16*)(P->ws + W_QK);
  float* S = (float*)(P->ws + W_H);
  for (int t = bidx(); t < SWZ_TOTAL(16); t += gdim()) {
    int mt_, nt_;
    if (!tile_swz(t, 16, mt_, nt_)) continue;
    const int m0 = mt_ * 128, n0 = nt_ * 128;
    f32x16 acc[2][2];
    zero_acc(acc);
    const bf16* Ab = X + (size_t)m0 * 1024;
    const bf16* Bb = Wt + (size_t)n0 * 1024;
    gemm_kloop(acc,
      [&](int r, int kc) { return *(const uint4*)(Ab + (size_t)r * 1024 + kc * 8); },
      [&](int r, int kc) { return *(const uint4*)(Bb + (size_t)r * 1024 + kc * 8); }, 0, 16, smem);
    EPI_BASE
    epi_rowmajor(acc, smem, [&](int row, int c8, float (&v)[8]) {
      float* sp = S + (size_t)(m0 + row) * 2048 + n0 + c8;
      *(float4*)sp = make_float4(v[0], v[1], v[2], v[3]);
      *(float4*)(sp + 4) = make_float4(v[4], v[5], v[6], v[7]);
    });
  }
  { int jb, jn;
    if (light_block(2, jb, jn)) {
      float* lds = (float*)smem;
      convert_job(P->in[I_PP] + (size_t)li * NPTOK * 256, (bf16*)(P->ws + W_PE), (size_t)NPTOK * 256, jb, jn);
      convert_job(P->in[I_PS] + (size_t)li * 1024 * 256, (bf16*)(P->ws + W_PE) + (size_t)NPTOK * 256, 1024ull * 256, jb, jn);
      transpose_job(P->in[I_WG] + (size_t)li * 1024 * 1024, (bf16*)(P->ws + W_G), 1024, 1024, 1, lds, jb, jn);
      transpose_job(P->in[I_WP] + (size_t)li * 256 * 1024, (bf16*)(P->ws + W_P), 256, 1024, 1, lds, jb, jn);
      if (li == 0 && !MULTI_LAUNCH) pro_cache(P, 1, lds, jb, jn);
    }
  }
}

__device__ __forceinline__ float dpp_max_step(float v, const int ctrl_dummy);
#define DPP_MAX(v, ctrl) v = fmaxf(v, __int_as_float(__builtin_amdgcn_update_dpp(__float_as_int(v), __float_as_int(v), ctrl, 0xf, 0xf, false)))
__device__ __forceinline__ float wave_max(float v) {
  DPP_MAX(v, 0x111);
  DPP_MAX(v, 0x112);
  DPP_MAX(v, 0x114);
  DPP_MAX(v, 0x118);
  DPP_MAX(v, 0x142);
  DPP_MAX(v, 0x143);
  return __int_as_float(__builtin_amdgcn_readlane(__float_as_int(v), 63));
}

__device__ __forceinline__ void top16_of128(float v0, float v1, int lane, float& osc, int& oix) {
  osc = -3.0e38f; oix = 0;
#pragma unroll
  for (int r = 0; r < 16; r++) {
    float m = fmaxf(v0, v1);
    float wm = wave_max(m);
    unsigned long long bal = __ballot(m == wm);
    int src = __ffsll((long long)bal) - 1;
    int sel = (v0 == wm) ? 0 : 1;
    int selu = __builtin_amdgcn_readlane(sel, src);
    if (lane == src) { if (selu == 0) v0 = -3.0e38f; else v1 = -3.0e38f; }
    if (lane == r) { osc = wm; oix = src + 64 * selu; }
  }
}

typedef float f2v __attribute__((ext_vector_type(2)));
__device__ __forceinline__ unsigned fkey(float f) { unsigned u = __float_as_uint(f); return u ^ ((unsigned)((int)u >> 31) | 0x80000000u); }
__device__ __forceinline__ int mbcnt64(unsigned long long m) {
  return __builtin_amdgcn_mbcnt_hi((unsigned)(m >> 32), __builtin_amdgcn_mbcnt_lo((unsigned)m, 0u));
}
template <int NV>
__device__ __forceinline__ unsigned top16_threshold(const unsigned (&k)[NV]) {
  unsigned T = 0u;
#pragma unroll 1
  for (int bit = 31; bit >= 0; bit--) {
    const unsigned c = T | (1u << bit);
    int cnt = 0;
#pragma unroll
    for (int i = 0; i < NV; i++) cnt += __popcll(__ballot(k[i] >= c));
    if (cnt >= 16) T = c;
    if (cnt == 16) break;
  }
  return T;
}

__device__ __forceinline__ void phase_PEER(KP P, int li, bf16* smem) {
  const float* S = (const float*)(P->ws + W_H);
  bf16* X = (bf16*)(P->ws + W_X);
  const bf16* XA = (const bf16*)(P->ws + W_HT);
  const unsigned char* U = P->ws + W_U;
  const unsigned char* V = P->ws + W_V;
  const float* gam = P->in[I_L2G] + li * 1024;
  const float* bet = P->in[I_L2B] + li * 1024;
  const int lane = tidx() & 63;
  const int wv = tidx() >> 6;
  const int gw = bidx() * 4 + wv, nw = gdim() * 4;
  float* wl = (float*)smem + wv * 128;
  int* wli = (int*)wl;
  for (int tok = gw; tok < NTOK; tok += nw) {
    f2v xv[8];
    {
      uint4 a = *(const uint4*)(XA + (size_t)tok * 1024 + lane * 16);
      uint4 b = *(const uint4*)(XA + (size_t)tok * 1024 + lane * 16 + 8);
      xv[0] = f2v{bflo(a.x), bfhi(a.x)}; xv[1] = f2v{bflo(a.y), bfhi(a.y)}; xv[2] = f2v{bflo(a.z), bfhi(a.z)}; xv[3] = f2v{bflo(a.w), bfhi(a.w)};
      xv[4] = f2v{bflo(b.x), bfhi(b.x)}; xv[5] = f2v{bflo(b.y), bfhi(b.y)}; xv[6] = f2v{bflo(b.z), bfhi(b.z)}; xv[7] = f2v{bflo(b.w), bfhi(b.w)};
    }
    f2v outv[8];
#pragma unroll
    for (int i = 0; i < 8; i++) outv[i] = f2v{0.f, 0.f};
    const float* Srow = S + (size_t)tok * 2048;
#define PEER_ROUTE(sv, ts_out, eid_out) { \
      _Pragma("unroll") for (int side = 0; side < 2; side++) { \
        float v0 = sv[side * 2], v1 = sv[side * 2 + 1]; \
        unsigned kk[2] = {fkey(v0), fkey(v1)}; \
        unsigned T = top16_threshold<2>(kk); \
        bool s0 = kk[0] >= T, s1 = kk[1] >= T; \
        unsigned long long m0 = __ballot(s0), m1 = __ballot(s1); \
        int r0 = mbcnt64(m0), r1 = __popcll(m0) + mbcnt64(m1); \
        if (s0 && r0 < 16) { wl[side * 16 + r0] = v0; wli[32 + side * 16 + r0] = lane; } \
        if (s1 && r1 < 16) { wl[side * 16 + r1] = v1; wli[32 + side * 16 + r1] = lane + 64; } \
      } \
      { const int i = lane & 15, j0 = lane >> 4; \
        const float a = wl[i]; const int ai = wli[32 + i]; \
        float cs[4]; int ce[4]; unsigned kk[4]; \
        _Pragma("unroll") for (int m = 0; m < 4; m++) { cs[m] = a + wl[16 + j0 + 4 * m]; ce[m] = ai * 128 + wli[48 + j0 + 4 * m]; kk[m] = fkey(cs[m]); } \
        unsigned T = top16_threshold<4>(kk); \
        int base = 0; \
        _Pragma("unroll") for (int m = 0; m < 4; m++) { \
          bool sl = kk[m] >= T; unsigned long long mm = __ballot(sl); int r = base + mbcnt64(mm); \
          if (sl && r < 16) { wl[64 + r] = cs[m]; wli[80 + r] = ce[m]; } \
          base += __popcll(mm); } } \
      ts_out = wl[64 + (lane & 15)]; eid_out = wli[80 + (lane & 15)]; }
    float sva[4], svb[4];
#pragma unroll
    for (int i = 0; i < 4; i++) { sva[i] = __builtin_nontemporal_load(Srow + i * 64 + lane); svb[i] = __builtin_nontemporal_load(Srow + 256 + i * 64 + lane); }
    float ts; int eid;
    PEER_ROUTE(sva, ts, eid)
#pragma unroll 1
    for (int h = 0; h < 8; h++) {
#pragma unroll
      for (int i = 0; i < 4; i++) { sva[i] = svb[i]; }
      if (h + 2 < 8) {
#pragma unroll
        for (int i = 0; i < 4; i++) svb[i] = __builtin_nontemporal_load(Srow + (h + 2) * 256 + i * 64 + lane);
      }
      uint4 ub[16], vb[8];
#pragma unroll
      for (int k = 0; k < 16; k++) {
        int e = __builtin_amdgcn_readlane(eid, k);
        ub[k] = *(const uint4*)(U + (size_t)e * 1024 + lane * 16);
        if (k < 8) vb[k] = *(const uint4*)(V + (size_t)e * 1024 + lane * 16);
      }
      int eidc = eid;
      float tmax = ts;
      tmax = fmaxf(tmax, __shfl_xor(tmax, 1)); tmax = fmaxf(tmax, __shfl_xor(tmax, 2));
      tmax = fmaxf(tmax, __shfl_xor(tmax, 4)); tmax = fmaxf(tmax, __shfl_xor(tmax, 8));
      float ex = __expf(ts - tmax);
      float den = ex;
      den += __shfl_xor(den, 1); den += __shfl_xor(den, 2); den += __shfl_xor(den, 4); den += __shfl_xor(den, 8);
      float gate = ex / den;
      if (h + 1 < 8) { PEER_ROUTE(sva, ts, eid) }
      float dk[16];
#pragma unroll
      for (int k = 0; k < 16; k++) {
        f2v acc = f2v{0.f, 0.f};
        acc += __builtin_amdgcn_cvt_pk_f32_fp8((int)ub[k].x, false) * xv[0]; acc += __builtin_amdgcn_cvt_pk_f32_fp8((int)ub[k].x, true) * xv[1];
        acc += __builtin_amdgcn_cvt_pk_f32_fp8((int)ub[k].y, false) * xv[2]; acc += __builtin_amdgcn_cvt_pk_f32_fp8((int)ub[k].y, true) * xv[3];
        acc += __builtin_amdgcn_cvt_pk_f32_fp8((int)ub[k].z, false) * xv[4]; acc += __builtin_amdgcn_cvt_pk_f32_fp8((int)ub[k].z, true) * xv[5];
        acc += __builtin_amdgcn_cvt_pk_f32_fp8((int)ub[k].w, false) * xv[6]; acc += __builtin_amdgcn_cvt_pk_f32_fp8((int)ub[k].w, true) * xv[7];
        dk[k] = acc[0] + acc[1];
      }
      uint4 vc[8];
#pragma unroll
      for (int k = 0; k < 8; k++) {
        int e = __builtin_amdgcn_readlane(eidc, 8 + k);
        vc[k] = *(const uint4*)(V + (size_t)e * 1024 + lane * 16);
      }
      {
        bool hi = (lane & 32) != 0;
#pragma unroll
        for (int i = 0; i < 8; i++) { float send = hi ? dk[i] : dk[i + 8]; float keep = hi ? dk[i + 8] : dk[i]; dk[i] = keep + __shfl_xor(send, 32); }
        hi = (lane & 16) != 0;
#pragma unroll
        for (int i = 0; i < 4; i++) { float send = hi ? dk[i] : dk[i + 4]; float keep = hi ? dk[i + 4] : dk[i]; dk[i] = keep + __shfl_xor(send, 16); }
        hi = (lane & 8) != 0;
#pragma unroll
        for (int i = 0; i < 2; i++) { float send = hi ? dk[i] : dk[i + 2]; float keep = hi ? dk[i + 2] : dk[i]; dk[i] = keep + __shfl_xor(send, 8); }
        hi = (lane & 4) != 0;
        { float send = hi ? dk[0] : dk[1]; float keep = hi ? dk[1] : dk[0]; dk[0] = keep + __shfl_xor(send, 4); }
        dk[0] += __shfl_xor(dk[0], 2);
        dk[0] += __shfl_xor(dk[0], 1);
      }
      float wgt = __shfl(gate, (lane >> 2) & 15) * gelu_tanh(dk[0] * (1.f / 256.f)) * (1.f / 64.f);
#pragma unroll
      for (int k = 0; k < 16; k++) {
        float wk = __int_as_float(__builtin_amdgcn_readlane(__float_as_int(wgt), k * 4));
        const f2v wk2 = f2v{wk, wk};
        const uint4 vv = (k < 8) ? vb[k & 7] : vc[k & 7];
        outv[0] += wk2 * __builtin_amdgcn_cvt_pk_f32_fp8((int)vv.x, false); outv[1] += wk2 * __builtin_amdgcn_cvt_pk_f32_fp8((int)vv.x, true);
        outv[2] += wk2 * __builtin_amdgcn_cvt_pk_f32_fp8((int)vv.y, false); outv[3] += wk2 * __builtin_amdgcn_cvt_pk_f32_fp8((int)vv.y, true);
        outv[4] += wk2 * __builtin_amdgcn_cvt_pk_f32_fp8((int)vv.z, false); outv[5] += wk2 * __builtin_amdgcn_cvt_pk_f32_fp8((int)vv.z, true);
        outv[6] += wk2 * __builtin_amdgcn_cvt_pk_f32_fp8((int)vv.w, false); outv[7] += wk2 * __builtin_amdgcn_cvt_pk_f32_fp8((int)vv.w, true);
      }
    }
    float z[16];
    float s = 0.f;
#pragma unroll
    for (int i = 0; i < 8; i++) { z[2 * i] = outv[i][0] + DN_ALPHA * xv[i][0]; z[2 * i + 1] = outv[i][1] + DN_ALPHA * xv[i][1]; s += z[2 * i] + z[2 * i + 1]; }
    s = wsum(s);
    const float mu = s * (1.f / 1024.f);
    float q = 0.f;
#pragma unroll
    for (int i = 0; i < 16; i++) { float d = z[i] - mu; q += d * d; }
    q = wsum(q);
    const float rstd = rsqrtf(q * (1.f / 1024.f) + LN_EPS);
    float y[16];
    const int col = lane * 16;
#pragma unroll
    for (int i4 = 0; i4 < 4; i4++) {
      float4 g = *(const float4*)(gam + col + i4 * 4), b = *(const float4*)(bet + col + i4 * 4);
      y[i4 * 4 + 0] = (z[i4 * 4 + 0] - mu) * rstd * g.x + b.x; y[i4 * 4 + 1] = (z[i4 * 4 + 1] - mu) * rstd * g.y + b.y;
      y[i4 * 4 + 2] = (z[i4 * 4 + 2] - mu) * rstd * g.z + b.z; y[i4 * 4 + 3] = (z[i4 * 4 + 3] - mu) * rstd * g.w + b.w;
    }
    uint4 o0, o1;
    o0.x = pack2(y[0], y[1]); o0.y = pack2(y[2], y[3]); o0.z = pack2(y[4], y[5]); o0.w = pack2(y[6], y[7]);
    o1.x = pack2(y[8], y[9]); o1.y = pack2(y[10], y[11]); o1.z = pack2(y[12], y[13]); o1.w = pack2(y[14], y[15]);
    *(uint4*)(X + (size_t)tok * 1024 + col) = o0;
    *(uint4*)(X + (size_t)tok * 1024 + col + 8) = o1;
  }
}

__device__ __forceinline__ void phase_PLE(KP P, int li, bf16* smem) {
  EPI_VARS
  const bf16* X = (const bf16*)(P->ws + W_X);
  const bf16* PE = (const bf16*)(P->ws + W_PE);
  const bf16* Wg = (const bf16*)(P->ws + W_G);
  const bf16* Wp = (const bf16*)(P->ws + W_P);
  bf16* Z = (bf16*)(P->ws + W_H);
  for (int t = bidx(); t < SWZ_TOTAL(8); t += gdim()) {
    int mt_, nt_;
    if (!tile_swz(t, 8, mt_, nt_)) continue;
    const int m0 = mt_ * 128, n0 = nt_ * 128;
    f32x16 acc[2][2], acc2[2][2];
    zero_acc(acc); zero_acc(acc2);
    {
      const bf16* Ab = X + (size_t)m0 * 1024;
      const bf16* Bb = Wg + (size_t)n0 * 1024;
      gemm_kloop(acc,
        [&](int r, int kc) { return *(const uint4*)(Ab + (size_t)r * 1024 + kc * 8); },
        [&](int r, int kc) { return *(const uint4*)(Bb + (size_t)r * 1024 + kc * 8); }, 0, 16, smem);
    }
    {
      const bf16* Ab = PE + (size_t)m0 * 256;
      const bf16* Bb = Wp + (size_t)n0 * 256;
      gemm_kloop(acc2,
        [&](int r, int kc) { return *(const uint4*)(Ab + (size_t)r * 256 + kc * 8); },
        [&](int r, int kc) { return *(const uint4*)(Bb + (size_t)r * 256 + kc * 8); }, 0, 4, smem);
    }
    EPI_BASE
#pragma unroll
    for (int mi = 0; mi < 2; mi++)
#pragma unroll
      for (int ni = 0; ni < 2; ni++)
#pragma unroll
        for (int r = 0; r < 16; r++) acc[mi][ni][r] = sigmoidf_(acc[mi][ni][r]) * acc2[mi][ni][r];
    epi_rowmajor(acc, smem, [&](int row, int c8, float (&v)[8]) {
      uint4 xr = *(const uint4*)(X + (size_t)(m0 + row) * 1024 + n0 + c8);
      uint4 o;
      o.x = pack2(DN_ALPHA * bflo(xr.x) + v[0], DN_ALPHA * bfhi(xr.x) + v[1]); o.y = pack2(DN_ALPHA * bflo(xr.y) + v[2], DN_ALPHA * bfhi(xr.y) + v[3]);
      o.z = pack2(DN_ALPHA * bflo(xr.z) + v[4], DN_ALPHA * bfhi(xr.z) + v[5]); o.w = pack2(DN_ALPHA * bflo(xr.w) + v[6], DN_ALPHA * bfhi(xr.w) + v[7]);
      *(uint4*)(Z + (size_t)(m0 + row) * 1024 + n0 + c8) = o;
    });
  }
  if (li == 0 && !MULTI_LAUNCH) { int jb, jn; if (light_block(1, jb, jn)) pro_misc(P, 1, (float*)smem, jb, jn); }
}

__device__ __forceinline__ void run_phase(KP P, int li, int k, bf16* smem) {
  switch (k) {
    case PH_PRO: phase_prologue(P, li, smem); break;
    case PH_GIN: phase_gemm_in(P, li, smem); break;
    case PH_A: phase_A(P, li, smem); break;
    case PH_B: phase_B(P, li); break;
    case PH_C: phase_C(P, li, smem); break;
    case PH_D: phase_D(P, li, smem); break;
    case PH_E: phase_E(P, li, smem); break;
    case PH_WO: phase_WO(P, li, smem); break;
    case PH_LN1: phase_LN(P, P->in[I_L1G] + li * 1024, P->in[I_L1B] + li * 1024, false, W_HT); break;
    case PH_PQ: phase_PQ(P, li, smem); break;
    case PH_PEER: phase_PEER(P, li, smem); break;
    case PH_PLE: phase_PLE(P, li, smem); break;
    case PH_LN3: phase_LN(P, P->in[I_L3G] + li * 1024, P->in[I_L3B] + li * 1024, li == 1, W_X); break;
  }
}

#ifndef DUP_MASK
#define DUP_MASK 0
#endif
#define SYNC() xcd_barrier(xb)
#define RUN(k, call) { { KP P = kp_get(); call; } if ((DUP_MASK >> (k)) & 1) { SYNC(); KP P = kp_get(); call; } }
__global__ void __launch_bounds__(256, 2) fwd_kernel(Params Parg) {
  extern __shared__ __attribute__((aligned(16))) unsigned char lds_raw[];
  bf16* smem = (bf16*)lds_raw;
#if MULTI_LAUNCH
  { KP P = kp_get(); run_phase(P, P->pbeg / PH_N, P->pbeg % PH_N, smem); }
#else
  volatile LAS unsigned* st = (volatile LAS unsigned*)(lds_raw + LDS_TILE_BYTES);
  if (threadIdx.x == 0) { st[0] = 0u; st[1] = 0u; st[2] = 0u; st[3] = 0u; }
  __syncthreads();
  XcdBarrier xb;
  { KP P = kp_get(); xb = xcd_barrier_post((unsigned*)(P->ws + W_BAR), st);
    if (P->pad0 == 0x5eed) cg::this_grid().sync();
  }
#pragma unroll 1
  for (int li = 0; li < 2; li++) {
    if (li == 0) { RUN(PH_PRO, phase_prologue(P, li, smem)) SYNC(); }
    RUN(PH_GIN, phase_gemm_in(P, li, smem)) SYNC();
    RUN(PH_A, phase_A(P, li, smem)) SYNC();
    RUN(PH_B, phase_B(P, li)) SYNC();
    RUN(PH_C, phase_C(P, li, smem)) SYNC();
    RUN(PH_D, phase_D(P, li, smem)) SYNC();
    RUN(PH_E, phase_E(P, li, smem)) SYNC();
    RUN(PH_WO, phase_WO(P, li, smem)) SYNC();
    RUN(PH_LN1, phase_LN(P, P->in[I_L1G] + li * 1024, P->in[I_L1B] + li * 1024, false, W_HT)) SYNC();
    RUN(PH_PQ, phase_PQ(P, li, smem)) SYNC();
    RUN(PH_PEER, phase_PEER(P, li, smem)) SYNC();
    RUN(PH_PLE, phase_PLE(P, li, smem)) SYNC();
    RUN(PH_LN3, phase_LN(P, P->in[I_L3G] + li * 1024, P->in[I_L3B] + li * 1024, li == 1, W_X))
    if (li == 0) SYNC();
  }
#endif
}

extern "C" void kernel_launch(void* const* d_in, const int* in_sizes, int n_in, void* d_out, int out_size, void* d_ws,
                              size_t ws_size, hipStream_t stream) {
  static int grid_blocks = 0;
  if (grid_blocks == 0) {
    if (n_in != 38 || (size_t)out_size != O_END || ws_size < WS_END) {
      fprintf(stderr, "kernel_launch: unexpected sizes n_in=%d out=%d ws=%zu need %zu\n", n_in, out_size, ws_size, (size_t)WS_END);
      grid_blocks = -1; return;
    }
    int dev = 0, cus = 0, per_cu = 0;
    hipGetDevice(&dev);
    hipDeviceGetAttribute(&cus, hipDeviceAttributeMultiprocessorCount, dev);
    if (hipFuncSetAttribute((const void*)fwd_kernel, hipFuncAttributeMaxDynamicSharedMemorySize, LDS_BYTES) != hipSuccess) {
      fprintf(stderr, "kernel_launch: hipFuncSetAttribute failed\n"); grid_blocks = -1; return;
    }
    hipOccupancyMaxActiveBlocksPerMultiprocessor(&per_cu, (const void*)fwd_kernel, 256, LDS_BYTES);
    if (per_cu < 1) { fprintf(stderr, "kernel_launch: occupancy query gave %d\n", per_cu); grid_blocks = -1; return; }
    if (per_cu > 2) per_cu = 2;
    grid_blocks = cus * per_cu;
  }
  if (grid_blocks < 0) return;
  Params p{};
  for (int i = 0; i < 38; i++) p.in[i] = (const float*)d_in[i];
  p.out = (float*)d_out;
  p.ws = (unsigned char*)d_ws;
#if MULTI_LAUNCH
  for (int ph = 0; ph < 2 * PH_N; ph++) {
    p.pbeg = ph; p.pend = ph + 1;
    hipLaunchKernelGGL(fwd_kernel, dim3(grid_blocks), dim3(256), LDS_BYTES, stream, p);
  }
#else
  p.pbeg = 0; p.pend = 2 * PH_N;
  if (hipMemsetAsync((char*)d_ws + W_BAR, 0, 16384, stream) != hipSuccess) { fprintf(stderr, "memset failed\n"); return; }
  void* args[] = {&p};
#ifdef PLAIN_LAUNCH
  hipLaunchKernelGGL(fwd_kernel, dim3(grid_blocks), dim3(256), LDS_BYTES, stream, p);
  hipError_t e = hipSuccess; (void)args;
#else
  hipError_t e = hipLaunchCooperativeKernel((const void*)fwd_kernel, dim3(grid_blocks), dim3(256), args, LDS_BYTES, stream);
#endif
  if (e != hipSuccess) fprintf(stderr, "cooperative launch failed: %s (grid %d)\n", hipGetErrorString(e), grid_blocks);
#endif
}
```

```cpp
#include <hip/hip_runtime.h>
#include <hip/hip_cooperative_groups.h>
#include <cstdio>
#include <cstdint>
namespace cg = cooperative_groups;

#ifndef MULTI_LAUNCH
#define MULTI_LAUNCH 0
#endif

typedef unsigned short bf16;
using bf16x8 = __attribute__((ext_vector_type(8))) short;
using f32x16 = __attribute__((ext_vector_type(16))) float;
using f32x4 = __attribute__((ext_vector_type(4))) float;

#define NTOK 17408
#define NPTOK 16384
#define DM 1024
#define INC 5888
#define NCHUNK 272
#define C_USSM 0
#define C_QATT 256
#define C_KATT 768
#define C_VATT 1280
#define C_QRET 1792
#define C_KRET 2048
#define C_VRET 2304
#define C_GRET 2560
#define C_GATE 2816
#define DN_ALPHA 1.41421356237f
#define LN_EPS 1e-5f

constexpr size_t O_YP = 0;
constexpr size_t O_YS = O_YP + 4ull * 4096 * 1024;
constexpr size_t O_SRE_P = O_YS + 16ull * 64 * 1024;
constexpr size_t O_SIM_P = O_SRE_P + 2 * 4 * 16 * 64;
constexpr size_t O_AK_P = O_SIM_P + 2 * 4 * 16 * 64;
constexpr size_t O_AV_P = O_AK_P + 2ull * 4 * 512 * 512;
constexpr size_t O_RET_P = O_AV_P + 2ull * 4 * 512 * 512;
constexpr size_t O_SRE_S = O_RET_P + 2 * 4 * 4 * 4096;
constexpr size_t O_SIM_S = O_SRE_S + 2 * 16 * 16 * 64;
constexpr size_t O_AK_S = O_SIM_S + 2 * 16 * 16 * 64;
constexpr size_t O_AV_S = O_AK_S + 2ull * 16 * 64 * 512;
constexpr size_t O_RET_S = O_AV_S + 2ull * 16 * 64 * 512;
constexpr size_t O_END = O_RET_S + 2ull * 16 * 4 * 4096;

constexpr size_t W_IN = 0;
constexpr size_t W_BRS = W_IN + 5888ull * 1024 * 2;
constexpr size_t W_BRA = W_BRS + 1024ull * 256 * 2;
constexpr size_t W_BRR = W_BRA + 1024ull * 512 * 2;
constexpr size_t W_O = W_BRR + 1024ull * 256 * 2;
constexpr size_t W_QK = W_O + 1024ull * 1024 * 2;
constexpr size_t W_G = W_QK + 2048ull * 1024 * 2;
constexpr size_t W_P = W_G + 1024ull * 1024 * 2;
constexpr size_t W_GLU = W_P + 1024ull * 256 * 2;
constexpr size_t W_U = W_GLU + 256ull * 256 * 2;
constexpr size_t W_V = W_U + 16384ull * 1024 * 2;
constexpr size_t W_TT = W_V + 16384ull * 1024 * 2;
#define KERN_ELEMS (16 * 64 * 256)
constexpr size_t W_BST = W_TT + 16ull * 1024 * 1152 * 2;
constexpr size_t W_ROPE = W_BST + 16ull * 128 * 1024 * 2;
constexpr size_t W_X = W_ROPE + 4096ull * 32 * 8;
constexpr size_t W_PE = W_X + (size_t)NTOK * 1024 * 2;
constexpr size_t W_H = W_PE + (size_t)NTOK * 256 * 2;
constexpr size_t W_HT = W_H + (size_t)NTOK * 5888 * 2;
constexpr size_t W_YSSM = W_HT + 1024ull * NTOK * 2;
constexpr size_t W_YATT = W_YSSM + (size_t)NTOK * 256 * 2;
constexpr size_t W_YRET = W_YATT + (size_t)NTOK * 512 * 2;
constexpr size_t W_CK = W_YRET + (size_t)NTOK * 256 * 2;
constexpr size_t W_CVT = W_CK + 16ull * 512 * 512 * 2;
constexpr size_t W_CT = W_CVT + 16ull * 512 * 512 * 2;
constexpr size_t W_SPREV = W_CT + 272ull * 4 * 4096 * 4;
constexpr size_t W_SC = W_SPREV + 272ull * 4 * 4096 * 2;
constexpr size_t W_HS = W_SC + 272ull * 16 * 128 * 4;
constexpr size_t W_BAR = W_HS + 272ull * 16 * 128 * 2;
constexpr size_t WS_END = W_BAR + 16384;

#define LDS_TILE_BYTES 73728
#define LDS_BYTES (73728 + 16)
#define LDS_ROW 72
#define STAGE_ELEMS (128 * LDS_ROW)

struct Params {
  const float* in[38];
  float* out;
  unsigned char* ws;
  int pbeg, pend;
  int pad0, pad1;
};

typedef const __attribute__((address_space(4))) Params* KP;
__device__ __forceinline__ KP kp_get() { KP p = (KP)__builtin_amdgcn_kernarg_segment_ptr(); asm volatile("" : "+s"(p)); return p; }

enum { I_XP = 0, I_XS, I_PP, I_PS, I_SRE, I_SIM, I_CK, I_CV, I_SRET, I_WIN, I_LRE, I_LIM, I_BRE, I_BIM, I_CRE, I_CIM,
       I_LDT, I_SD, I_WGLU, I_BGLU, I_BIAS, I_GNG, I_WBS, I_WBA, I_WBR, I_WO, I_L1G, I_L1B, I_WQ, I_KEYS, I_PU, I_PV,
       I_L2G, I_L2B, I_WG, I_WP, I_L3G, I_L3B };

enum { PH_PRO = 0, PH_GIN, PH_A, PH_B, PH_C, PH_D, PH_E, PH_WO, PH_LN1, PH_PQ, PH_PEER, PH_PLE, PH_LN3, PH_N };

__device__ __forceinline__ bf16 f2bf(float f) {
  unsigned u = __float_as_uint(f);
  u += 0x7fffu + ((u >> 16) & 1u);
  return (bf16)(u >> 16);
}
__device__ __forceinline__ float bf2f(bf16 h) { return __uint_as_float(((unsigned)h) << 16); }
__device__ __forceinline__ unsigned pack2(float a, float b) { return (unsigned)f2bf(a) | ((unsigned)f2bf(b) << 16); }
__device__ __forceinline__ float bflo(unsigned u) { return __uint_as_float(u << 16); }
__device__ __forceinline__ float bfhi(unsigned u) { return __uint_as_float(u & 0xffff0000u); }
__device__ __forceinline__ float sigmoidf_(float x) { return __builtin_amdgcn_rcpf(1.f + __expf(-x)); }
__device__ __forceinline__ float gelu_tanh(float x) {
  float y = 0.7978845608028654f * (x + 0.044715f * x * x * x);
  float t = 1.f - 2.f * __builtin_amdgcn_rcpf(1.f + __expf(2.f * y));
  return 0.5f * x * (1.f + t);
}
__device__ __forceinline__ bf16x8 u4_to_frag(uint4 u) {
  union { uint4 u; bf16x8 f; } c; c.u = u; return c.f;
}
template <class T>
__device__ __forceinline__ T* launder(T* p) { asm volatile("" : "+s"(p)); return p; }
__device__ __forceinline__ int opaque(int v) { asm volatile("" : "+v"(v)); return v; }
__device__ __forceinline__ int bidx() { int v = blockIdx.x; asm volatile("" : "+s"(v)); return v; }
__device__ __forceinline__ int gdim() { int v = gridDim.x; asm volatile("" : "+s"(v)); return v; }
__device__ __forceinline__ int tidx() { int v = threadIdx.x; asm volatile("" : "+v"(v)); return v; }
__device__ __forceinline__ float wsum(float v) {
#pragma unroll
  for (int o = 32; o >= 1; o >>= 1) v += __shfl_xor(v, o);
  return v;
}


#define XB_TMO      128
#define XB_XCNT(j)  (256  + 64 * (j))
#define XB_XSUB(j)  (1280 + 64 * (j))
#define XB_XGEN(j)  (2304 + 64 * (j))
#define XB_TOP      3328
#define XB_TOPGEN   3392
#define XCD_BAR_WORDS 3456
#define XB_SPIN_CAP (1u << 20)
#define LAS __attribute__((address_space(3)))
__device__ __forceinline__ unsigned xb_ld(unsigned* p)              { return __hip_atomic_load(p, __ATOMIC_RELAXED, __HIP_MEMORY_SCOPE_AGENT); }
__device__ __forceinline__ unsigned xb_add(unsigned* p, unsigned v) { return __hip_atomic_fetch_add(p, v, __ATOMIC_RELAXED, __HIP_MEMORY_SCOPE_AGENT); }
__device__ __forceinline__ unsigned xb_xcc_id() { return (unsigned)__builtin_amdgcn_s_getreg((3 << 11) | 20) & 0xFu; }
#define XB_SPIN(cond, bar) do { unsigned _sp = 0; while (cond) { __builtin_amdgcn_s_sleep(1); \
    if ((++_sp & 255u) == 0u) { if (xb_ld(&(bar)[XB_TMO])) break; if (_sp > XB_SPIN_CAP) { atomicAdd(&(bar)[XB_TMO], 1u); break; } } } } while (0)
struct XcdBarrier { unsigned* bar; unsigned x; volatile LAS unsigned* st; };
__device__ __forceinline__ XcdBarrier xcd_barrier_post(unsigned* bar, volatile LAS unsigned* st) {
    XcdBarrier b; b.bar = bar; b.x = xb_xcc_id(); b.st = st;
    if (threadIdx.x == 0) (void)xb_add(&bar[XB_XCNT(b.x)], 1u);
    return b;
}
__device__ __forceinline__ void xcd_barrier_complete(unsigned* bar, unsigned x, unsigned& nloc, unsigned& nx) {
    const unsigned G = gridDim.x * gridDim.y * gridDim.z;
    unsigned sum, cnt, mine, sp = 0u;
    for (;;) {
        sum = 0u; cnt = 0u; mine = 0u;
#pragma unroll
        for (unsigned j = 0; j < 16; ++j) { const unsigned c = xb_ld(&bar[XB_XCNT(j)]); sum += c; cnt += (c > 0u) ? 1u : 0u; mine = (j == x) ? c : mine; }
        if (sum == G) break;
        __builtin_amdgcn_s_sleep(1);
        if ((++sp & 255u) == 0u) { if (xb_ld(&bar[XB_TMO])) break; if (sp > XB_SPIN_CAP) { atomicAdd(&bar[XB_TMO], 1u); break; } }
    }
    nloc = mine > 0u ? mine : 1u; nx = cnt > 0u ? cnt : 1u;
}
__device__ __forceinline__ void xcd_barrier(const XcdBarrier& b) {
    asm volatile("s_waitcnt vmcnt(0)" ::: "memory");
    __syncthreads();
    if (threadIdx.x == 0) {
        unsigned* bar = b.bar;
        __builtin_amdgcn_s_waitcnt(0);
        unsigned nloc = b.st[0], nx = b.st[1];
        if (nloc == 0u) { xcd_barrier_complete(bar, b.x, nloc, nx); b.st[0] = nloc; b.st[1] = nx; }
        const unsigned old = xb_add(&bar[XB_XSUB(b.x)], 1u);
        const unsigned gen = old / nloc;
        if (old + 1u == (gen + 1u) * nloc) {
            __builtin_amdgcn_fence(__ATOMIC_RELEASE, "agent");
            asm volatile("s_waitcnt vmcnt(0)" ::: "memory");
            const unsigned og = xb_add(&bar[XB_TOP], 1u);
            const unsigned tg = og / nx;
            if (og + 1u == (tg + 1u) * nx) xb_add(&bar[XB_TOPGEN], 1u);
            else XB_SPIN(xb_ld(&bar[XB_TOPGEN]) == tg, bar);
            __builtin_amdgcn_fence(__ATOMIC_ACQUIRE, "agent");
            xb_add(&bar[XB_XGEN(b.x)], 1u);
            asm volatile("s_waitcnt vmcnt(0)" ::: "memory");
        } else {
            XB_SPIN(xb_ld(&bar[XB_XGEN(b.x)]) == gen, bar);
            __builtin_amdgcn_fence(__ATOMIC_ACQUIRE, "agent");
            asm volatile("s_waitcnt vmcnt(0)" ::: "memory");
        }
    }
    __syncthreads();
}

__device__ __forceinline__ void gemm_compute_stage(f32x16 (&acc)[2][2], const bf16* Ac, const bf16* Bc, int wm, int wn, int lane) {
#pragma unroll
  for (int kk = 0; kk < 4; kk++) {
    bf16x8 a[2], b[2];
#pragma unroll
    for (int mi = 0; mi < 2; mi++) a[mi] = *(const bf16x8*)(Ac + (wm * 64 + mi * 32 + (lane & 31)) * LDS_ROW + kk * 16 + (lane >> 5) * 8);
#pragma unroll
    for (int ni = 0; ni < 2; ni++) b[ni] = *(const bf16x8*)(Bc + (wn * 64 + ni * 32 + (lane & 31)) * LDS_ROW + kk * 16 + (lane >> 5) * 8);
#pragma unroll
    for (int mi = 0; mi < 2; mi++)
#pragma unroll
      for (int ni = 0; ni < 2; ni++) acc[mi][ni] = __builtin_amdgcn_mfma_f32_32x32x16_bf16(a[mi], b[ni], acc[mi][ni], 0, 0, 0);
  }
}

template <class AL, class BL>
__device__ __forceinline__ void gemm_kloop(f32x16 (&acc)[2][2], AL aload, BL bload, int kt0, int nkt, bf16* smem) {
  const int tid = tidx(), lane = tid & 63, w = tid >> 6;
  const int wm = w >> 1, wn = w & 1;
  const int lr = tid >> 3, lc = tid & 7;
  uint4 a0[4], b0[4], a1[4], b1[4];
  bf16* const buf0 = smem;
  bf16* const buf1 = smem + 2 * STAGE_ELEMS;
#define KL_LOAD(A_, B_, st) { _Pragma("unroll") for (int i = 0; i < 4; i++) { A_[i] = aload(lr + 32 * i, (kt0 + (st)) * 8 + lc); B_[i] = bload(lr + 32 * i, (kt0 + (st)) * 8 + lc); } }
#define KL_STORE(A_, B_, buf) { _Pragma("unroll") for (int i = 0; i < 4; i++) { \
    *(uint4*)((buf) + (lr + 32 * i) * LDS_ROW + lc * 8) = A_[i]; *(uint4*)((buf) + STAGE_ELEMS + (lr + 32 * i) * LDS_ROW + lc * 8) = B_[i]; } }
  KL_LOAD(a0, b0, 0)
  KL_STORE(a0, b0, buf0)
  if (nkt > 1) KL_LOAD(a0, b0, 1)
  if (nkt > 2) KL_LOAD(a1, b1, 2)
  __syncthreads();
  int kt = 0;
  for (; kt + 4 < nkt; kt += 2) {
    KL_STORE(a0, b0, buf1)
    KL_LOAD(a0, b0, kt + 3)
    gemm_compute_stage(acc, buf0, buf0 + STAGE_ELEMS, wm, wn, lane);
    __syncthreads();
    KL_STORE(a1, b1, buf0)
    KL_LOAD(a1, b1, kt + 4)
    gemm_compute_stage(acc, buf1, buf1 + STAGE_ELEMS, wm, wn, lane);
    __syncthreads();
  }
  for (; kt < nkt; kt += 2) {
    if (kt + 1 < nkt) KL_STORE(a0, b0, buf1)
    if (kt + 3 < nkt) KL_LOAD(a0, b0, kt + 3)
    gemm_compute_stage(acc, buf0, buf0 + STAGE_ELEMS, wm, wn, lane);
    __syncthreads();
    if (kt + 1 >= nkt) break;
    if (kt + 2 < nkt) KL_STORE(a1, b1, buf0)
    if (kt + 4 < nkt) KL_LOAD(a1, b1, kt + 4)
    gemm_compute_stage(acc, buf1, buf1 + STAGE_ELEMS, wm, wn, lane);
    __syncthreads();
  }
#undef KL_LOAD
#undef KL_STORE
}

#define TL_ROW 40
#define TL_STAGE (384 * TL_ROW)
__device__ __forceinline__ void gemm_tall_compute(f32x16 (&acc)[2][2][2], const bf16* St, int wm, int wn, int lane) {
  const bf16* Ac = St; const bf16* Bc = St + 256 * TL_ROW;
#pragma unroll
  for (int kk = 0; kk < 2; kk++) {
    bf16x8 a[2][2], b[2];
#pragma unroll
    for (int h = 0; h < 2; h++)
#pragma unroll
      for (int mi = 0; mi < 2; mi++) a[h][mi] = *(const bf16x8*)(Ac + (h * 128 + wm * 64 + mi * 32 + (lane & 31)) * TL_ROW + kk * 16 + (lane >> 5) * 8);
#pragma unroll
    for (int ni = 0; ni < 2; ni++) b[ni] = *(const bf16x8*)(Bc + (wn * 64 + ni * 32 + (lane & 31)) * TL_ROW + kk * 16 + (lane >> 5) * 8);
#pragma unroll
    for (int h = 0; h < 2; h++)
#pragma unroll
      for (int mi = 0; mi < 2; mi++)
#pragma unroll
        for (int ni = 0; ni < 2; ni++) acc[h][mi][ni] = __builtin_amdgcn_mfma_f32_32x32x16_bf16(a[h][mi], b[ni], acc[h][mi][ni], 0, 0, 0);
  }
}
template <class AL, class BL>
__device__ __forceinline__ void gemm_kloop_tall(f32x16 (&acc)[2][2][2], AL aload, BL bload, int nkt, bf16* smem) {
  const int tid = tidx(), lane = tid & 63, w = tid >> 6;
  const int wm = w >> 1, wn = w & 1;
  const int lr = tid >> 2, lc = tid & 3;
  uint4 a0[4], b0[2], a1[4], b1[2];
  bf16* const buf0 = smem;
  bf16* const buf1 = smem + TL_STAGE;
#define TL_LOAD(A_, B_, st) { _Pragma("unroll") for (int i = 0; i < 4; i++) A_[i] = aload(lr + 64 * i, (st) * 4 + lc); \
                              _Pragma("unroll") for (int i = 0; i < 2; i++) B_[i] = bload(lr + 64 * i, (st) * 4 + lc); }
#define TL_STORE(A_, B_, buf) { _Pragma("unroll") for (int i = 0; i < 4; i++) *(uint4*)((buf) + (lr + 64 * i) * TL_ROW + lc * 8) = A_[i]; \
                                _Pragma("unroll") for (int i = 0; i < 2; i++) *(uint4*)((buf) + (256 + lr + 64 * i) * TL_ROW + lc * 8) = B_[i]; }
  TL_LOAD(a0, b0, 0)
  TL_STORE(a0, b0, buf0)
  if (nkt > 1) TL_LOAD(a0, b0, 1)
  if (nkt > 2) TL_LOAD(a1, b1, 2)
  __syncthreads();
  int kt = 0;
  for (; kt + 4 < nkt; kt += 2) {
    TL_STORE(a0, b0, buf1)
    TL_LOAD(a0, b0, kt + 3)
    gemm_tall_compute(acc, buf0, wm, wn, lane);
    __syncthreads();
    TL_STORE(a1, b1, buf0)
    TL_LOAD(a1, b1, kt + 4)
    gemm_tall_compute(acc, buf1, wm, wn, lane);
    __syncthreads();
  }
  for (; kt < nkt; kt += 2) {
    if (kt + 1 < nkt) TL_STORE(a0, b0, buf1)
    if (kt + 3 < nkt) TL_LOAD(a0, b0, kt + 3)
    gemm_tall_compute(acc, buf0, wm, wn, lane);
    __syncthreads();
    if (kt + 1 >= nkt) break;
    if (kt + 2 < nkt) TL_STORE(a1, b1, buf0)
    if (kt + 4 < nkt) TL_LOAD(a1, b1, kt + 4)
    gemm_tall_compute(acc, buf1, wm, wn, lane);
    __syncthreads();
  }
#undef TL_LOAD
#undef TL_STORE
}

template <class AL, class BL>
__device__ __forceinline__ void gemm_kloop_light(f32x16 (&acc)[2][2], AL aload, BL bload, int kt0, int nkt, bf16* smem) {
  const int tid = tidx(), lane = tid & 63, w = tid >> 6;
  const int wm = w >> 1, wn = w & 1;
  const int lr = tid >> 3, lc = tid & 7;
  uint4 a0[4], b0[4];
#define KL_LOAD(A_, B_, st) { _Pragma("unroll") for (int i = 0; i < 4; i++) { A_[i] = aload(lr + 32 * i, (kt0 + (st)) * 8 + lc); B_[i] = bload(lr + 32 * i, (kt0 + (st)) * 8 + lc); } }
#define KL_STORE(A_, B_, buf) { _Pragma("unroll") for (int i = 0; i < 4; i++) { \
    *(uint4*)((buf) + (lr + 32 * i) * LDS_ROW + lc * 8) = A_[i]; *(uint4*)((buf) + STAGE_ELEMS + (lr + 32 * i) * LDS_ROW + lc * 8) = B_[i]; } }
  KL_LOAD(a0, b0, 0)
  KL_STORE(a0, b0, smem)
  if (nkt > 1) KL_LOAD(a0, b0, 1)
  __syncthreads();
  for (int kt = 0; kt < nkt; kt++) {
    bf16* cur = smem + (kt & 1) * 2 * STAGE_ELEMS;
    bf16* nxt = smem + ((kt + 1) & 1) * 2 * STAGE_ELEMS;
    if (kt + 1 < nkt) KL_STORE(a0, b0, nxt)
    if (kt + 2 < nkt) KL_LOAD(a0, b0, kt + 2)
    gemm_compute_stage(acc, cur, cur + STAGE_ELEMS, wm, wn, lane);
    __syncthreads();
  }
#undef KL_LOAD
#undef KL_STORE
}

__device__ __forceinline__ void zero_acc(f32x16 (&acc)[2][2]) {
#pragma unroll
  for (int mi = 0; mi < 2; mi++)
#pragma unroll
    for (int ni = 0; ni < 2; ni++)
#pragma unroll
      for (int r = 0; r < 16; r++) acc[mi][ni][r] = 0.f;
}

#define EPI_ROW(mi, r) (erb + (mi) * 32 + ((r) & 3) + 8 * ((r) >> 2))
#define EPI_BASE int erb = opaque(wm * 64 + 4 * (lane >> 5));
#define EPI_COL(ni) (wn * 64 + (ni) * 32 + (lane & 31))
#define EPI_VARS const int lane = tidx() & 63, w = tidx() >> 6, wm = w >> 1, wn = w & 1;


#define CS_LD 132
template <class F>
__device__ __forceinline__ void epi_rowmajor(const f32x16 (&acc)[2][2], bf16* smem, F f) {
  const int tid = tidx(), lane = tid & 63, w = tid >> 6, wm = w >> 1, wn = w & 1;
  float* Cs = (float*)smem;
#pragma unroll
  for (int mi = 0; mi < 2; mi++)
#pragma unroll
    for (int ni = 0; ni < 2; ni++)
#pragma unroll
      for (int r = 0; r < 16; r++) {
        int row = wm * 64 + mi * 32 + (r & 3) + 8 * (r >> 2) + 4 * (lane >> 5), col = wn * 64 + ni * 32 + (lane & 31);
        Cs[row * CS_LD + col] = acc[mi][ni][r];
      }
  __syncthreads();
#pragma unroll
  for (int it = 0; it < 8; it++) {
    int ch = tid + 256 * it;
    int row = ch >> 4, c8 = (ch & 15) * 8;
    float4 a = *(const float4*)(Cs + row * CS_LD + c8), b = *(const float4*)(Cs + row * CS_LD + c8 + 4);
    float v[8] = {a.x, a.y, a.z, a.w, b.x, b.y, b.z, b.w};
    f(row, c8, v);
  }
  __syncthreads();
}


__device__ __forceinline__ bool tile_swz(int t, int NT, int& mt, int& nt) {
  const int SN = (NT + 7) >> 3;
  {
    const int full = (16 * SN / 8) * 512;
    if ((16 * SN) % 8 == 0 && t >= full) {
      const int x8 = t & 7, jl = (t - full) >> 3;
      mt = 128 + x8; nt = jl;
      return jl < NT;
    }
  }
  const int x = t & 7, q = t >> 3;
  const int sidx = (q >> 6) * 8 + x, loc = q & 63;
  const int sm = sidx / SN, sn = sidx - sm * SN;
  mt = sm * 8 + (loc >> 3); nt = sn * 8 + (loc & 7);
  return (mt < 136) && (nt < NT);
}
#define SWZ_TOTAL(NT) (((17 * (((NT) + 7) >> 3) + 7) >> 3) * 512)

__device__ __forceinline__ void transpose_tile(const float* __restrict__ src, int ldsrc, bf16* __restrict__ dst, int lddst, int k0, int n0, float* lds) {
  const int tid = tidx();
  const int tx = tid & 15, ty = tid >> 4;
#pragma unroll
  for (int i = 0; i < 4; i++) {
    int k = ty + 16 * i;
    float4 v = *(const float4*)(src + (size_t)(k0 + k) * ldsrc + n0 + tx * 4);
    lds[k * 65 + tx * 4 + 0] = v.x; lds[k * 65 + tx * 4 + 1] = v.y; lds[k * 65 + tx * 4 + 2] = v.z; lds[k * 65 + tx * 4 + 3] = v.w;
  }
  __syncthreads();
#pragma unroll
  for (int i = 0; i < 2; i++) {
    int ch = tid + 256 * i;
    int n = ch >> 3, kc = (ch & 7) * 8;
    uint4 o;
    o.x = pack2(lds[(kc + 0) * 65 + n], lds[(kc + 1) * 65 + n]); o.y = pack2(lds[(kc + 2) * 65 + n], lds[(kc + 3) * 65 + n]);
    o.z = pack2(lds[(kc + 4) * 65 + n], lds[(kc + 5) * 65 + n]); o.w = pack2(lds[(kc + 6) * 65 + n], lds[(kc + 7) * 65 + n]);
    *(uint4*)(dst + (size_t)(n0 + n) * lddst + k0 + kc) = o;
  }
  __syncthreads();
}

__device__ __forceinline__ void transpose_job(const float* src, bf16* dst, int K, int N, int batch, float* lds, int jb, int jn) {
  const int tk = K / 64, tn = N / 64;
  const int ntiles = tk * tn * batch;
  for (int t = jb; t < ntiles; t += jn) {
    int b = t / (tk * tn), r = t % (tk * tn);
    int kt = r / tn, nt = r % tn;
    transpose_tile(src + (size_t)b * K * N, N, dst + (size_t)b * K * N, K, kt * 64, nt * 64, lds);
  }
}

__device__ __forceinline__ void convert_job(const float* __restrict__ src, bf16* __restrict__ dst, size_t n, int jb, int jn) {
  size_t n8 = n / 8;
#pragma unroll 4
  for (size_t i = (size_t)jb * 256 + tidx(); i < n8; i += (size_t)jn * 256) {
    float4 a = ((const float4*)src)[2 * i], b = ((const float4*)src)[2 * i + 1];
    uint4 o;
    o.x = pack2(a.x, a.y); o.y = pack2(a.z, a.w); o.z = pack2(b.x, b.y); o.w = pack2(b.z, b.w);
    ((uint4*)dst)[i] = o;
  }
}

__device__ __forceinline__ void convert_fp8_job(const float* __restrict__ src, unsigned char* __restrict__ dst, size_t n, float scale, int jb, int jn) {
  size_t n16 = n / 16;
#pragma unroll 2
  for (size_t i = (size_t)jb * 256 + tidx(); i < n16; i += (size_t)jn * 256) {
    const float4* sp = (const float4*)src + 4 * i;
    unsigned o[4];
#pragma unroll
    for (int q = 0; q < 4; q++) {
      float4 a = sp[q];
      float f0 = fminf(fmaxf(a.x * scale, -448.f), 448.f), f1 = fminf(fmaxf(a.y * scale, -448.f), 448.f);
      float f2 = fminf(fmaxf(a.z * scale, -448.f), 448.f), f3 = fminf(fmaxf(a.w * scale, -448.f), 448.f);
      int wv = 0;
      wv = __builtin_amdgcn_cvt_pk_fp8_f32(f0, f1, wv, false);
      wv = __builtin_amdgcn_cvt_pk_fp8_f32(f2, f3, wv, true);
      o[q] = (unsigned)wv;
    }
    ((uint4*)dst)[i] = make_uint4(o[0], o[1], o[2], o[3]);
  }
}

__device__ __forceinline__ bool light_block(int heavy_x, int& jb, int& jn) {
  const int b = bidx(), g = gdim();
  if ((g & 7) || g < 128) { jb = b; jn = g; return true; }
  {
    const int nh = heavy_x == 1 ? 8 : 16;
    const int jl = b >> 3;
    jn = ((g >> 3) - nh) * 8;
    jb = (jl - nh) * 8 + (b & 7);
    return jl >= nh;
  }
  const int x = b & 7;
  jn = (g >> 3) * (8 - heavy_x);
  jb = (b >> 3) * (8 - heavy_x) + (x - heavy_x);
  return x >= heavy_x;
}

__device__ __forceinline__ void wqk_job(const float* __restrict__ wq, const float* __restrict__ keys, bf16* __restrict__ dst, float* lds, int jb, int jn) {
  float* Ks = lds;
  float* Ws = lds + 64 * 129;
  const int tid = tidx();
  for (int t = jb; t < 32 * 16; t += jn) {
    int n0 = (t / 16) * 64, k0 = (t % 16) * 64;
    int hs = n0 / 128, key0 = n0 % 128;
    for (int i = tid; i < 64 * 128; i += 256) {
      int r = i / 128, d = i % 128;
      Ks[r * 129 + d] = keys[((size_t)hs * 128 + key0 + r) * 128 + d];
      Ws[r * 129 + d] = wq[(size_t)(k0 + r) * 2048 + hs * 128 + d];
    }
    __syncthreads();
    int tx = tid & 15, ty = tid >> 4;
    float acc[4][4];
#pragma unroll
    for (int i = 0; i < 4; i++)
#pragma unroll
      for (int j = 0; j < 4; j++) acc[i][j] = 0.f;
    for (int d = 0; d < 128; d++) {
      float kv[4], wv[4];
#pragma unroll
      for (int i = 0; i < 4; i++) { kv[i] = Ks[(ty * 4 + i) * 129 + d]; wv[i] = Ws[(tx * 4 + i) * 129 + d]; }
#pragma unroll
      for (int i = 0; i < 4; i++)
#pragma unroll
        for (int j = 0; j < 4; j++) acc[i][j] += kv[i] * wv[j];
    }
#pragma unroll
    for (int i = 0; i < 4; i++) {
      uint2 o; o.x = pack2(acc[i][0], acc[i][1]); o.y = pack2(acc[i][2], acc[i][3]);
      *(uint2*)(dst + (size_t)(n0 + ty * 4 + i) * 1024 + k0 + tx * 4) = o;
    }
    __syncthreads();
  }
}

__device__ __forceinline__ void ssm_tables(KP P, int li, float* lds, int jb, int jn) {
  const float* lam_re = P->in[I_LRE] + li * 1024;
  const float* lam_im = P->in[I_LIM] + li * 1024;
  const float* b_re = P->in[I_BRE] + (size_t)li * 16 * 64 * 16;
  const float* b_im = P->in[I_BIM] + (size_t)li * 16 * 64 * 16;
  const float* c_re = P->in[I_CRE] + (size_t)li * 16 * 16 * 64;
  const float* c_im = P->in[I_CIM] + (size_t)li * 16 * 16 * 64;
  const float* log_dt = P->in[I_LDT] + li * 16;
  bf16* Tt = (bf16*)(P->ws + W_TT);
  bf16* Bst = (bf16*)(P->ws + W_BST);
  float* wr = lds; float* wi = lds + 64;
  const int tid = tidx();
  const int NT1 = 16 * 64, NT2 = 16 * 64, NT3 = 16 * 64;
  for (int t = jb; t < NT1 + NT2 + NT3; t += jn) {
    int kind, g, idx;
    if (t < NT1) { kind = 0; g = t / 64; idx = t % 64; }
    else if (t < NT1 + NT2) { kind = 1; g = (t - NT1) / 64; idx = (t - NT1) % 64; }
    else { kind = 2; g = (t - NT1 - NT2) / 64; idx = (t - NT1 - NT2) % 64; }
    int d = (kind == 0) ? idx : (kind == 1 ? idx + 1 : 63 - idx);
    const bool need_coef = (kind != 1);
    if (tid < 64) {
      int n = tid;
      float dt = expf(log_dt[g]);
      float lr = lam_re[g * 64 + n], lim = lam_im[g * 64 + n];
      float ar = lr * dt, ai = lim * dt;
      float dd = (float)(d < 0 ? 0 : d);
      float mag = expf(ar * dd);
      float sn, cs;
      sincosf(ai * dd, &sn, &cs);
      float pr = mag * cs, pi = mag * sn;
      if (need_coef) {
        float m1 = expf(ar); float s1, c1; sincosf(ai, &s1, &c1);
        float nr = m1 * c1 - 1.f, ni = m1 * s1;
        float den = lr * lr + lim * lim;
        float cr = (nr * lr + ni * lim) / den, ci = (ni * lr - nr * lim) / den;
        float xr = pr * cr - pi * ci, xi = pr * ci + pi * cr;
        pr = xr; pi = xi;
      }
      wr[n] = pr; wi[n] = pi;
    }
    __syncthreads();
    if (kind == 0) {
      int p = tid >> 4, q = tid & 15;
      if (d >= 0) {
        float* lcr = lds + 128; float* lci = lcr + 1024; float* lbr = lci + 1024; float* lbi = lbr + 1024;
        for (int i = tid; i < 1024; i += 256) {
          lcr[i] = c_re[(size_t)g * 1024 + i]; lci[i] = c_im[(size_t)g * 1024 + i];
          lbr[i] = b_re[(size_t)g * 1024 + i]; lbi[i] = b_im[(size_t)g * 1024 + i];
        }
        __syncthreads();
        float s = 0.f;
#pragma unroll 8
        for (int n = 0; n < 64; n++) {
          float cr = lcr[p * 64 + n], ci = lci[p * 64 + n];
          float xr = cr * wr[n] - ci * wi[n], xi = cr * wi[n] + ci * wr[n];
          float br = lbr[n * 16 + q], bi = lbi[n * 16 + q];
          s += xr * br - xi * bi;
        }
        Tt[(((size_t)g * 64 + d) * 16 + p) * 16 + q] = f2bf(s);
      }
    } else if (kind == 1) {
      int tt = idx;
      for (int i = tid; i < 2048; i += 256) {
        int p = i >> 7, nn = i & 127, n = nn >> 1, ri = nn & 1;
        float cr = c_re[((size_t)g * 16 + p) * 64 + n], ci = c_im[((size_t)g * 16 + p) * 64 + n];
        float v = ri == 0 ? (cr * wr[n] - ci * wi[n]) : -(cr * wi[n] + ci * wr[n]);
        Tt[KERN_ELEMS + ((size_t)g * 1024 + tt * 16 + p) * 128 + nn] = f2bf(v);
      }
    } else {
      int ss = idx;
      for (int i = tid; i < 2048; i += 256) {
        int nn = i >> 4, q = i & 15, n = nn >> 1, ri = nn & 1;
        float br = b_re[((size_t)g * 64 + n) * 16 + q], bi = b_im[((size_t)g * 64 + n) * 16 + q];
        float v = ri == 0 ? (wr[n] * br - wi[n] * bi) : (wr[n] * bi + wi[n] * br);
        Bst[((size_t)g * 128 + nn) * 1024 + ss * 16 + q] = f2bf(v);
      }
    }
    __syncthreads();
  }
}

__device__ __forceinline__ void pro_misc(KP P, int li, float* lds, int jb, int jn) {
  unsigned char* ws = P->ws;
  transpose_job(P->in[I_WIN] + (size_t)li * 1024 * 5888, (bf16*)(ws + W_IN), 1024, 5888, 1, lds, jb, jn);
  transpose_job(P->in[I_WBS] + (size_t)li * 256 * 1024, (bf16*)(ws + W_BRS), 256, 1024, 1, lds, jb, jn);
  transpose_job(P->in[I_WBA] + (size_t)li * 512 * 1024, (bf16*)(ws + W_BRA), 512, 1024, 1, lds, jb, jn);
  transpose_job(P->in[I_WBR] + (size_t)li * 256 * 1024, (bf16*)(ws + W_BRR), 256, 1024, 1, lds, jb, jn);
  transpose_job(P->in[I_WO] + (size_t)li * 1024 * 1024, (bf16*)(ws + W_O), 1024, 1024, 1, lds, jb, jn);
  transpose_job(P->in[I_WGLU] + (size_t)li * 256 * 256, (bf16*)(ws + W_GLU), 256, 256, 1, lds, jb, jn);
  wqk_job(P->in[I_WQ] + (size_t)li * 1024 * 2048, P->in[I_KEYS] + (size_t)li * 16 * 128 * 128, (bf16*)(ws + W_QK), lds, jb, jn);
  ssm_tables(P, li, lds, jb, jn);
}
__device__ __forceinline__ void pro_cache(KP P, int li, float* lds, int jb, int jn) {
  unsigned char* ws = P->ws;
  transpose_job(P->in[I_CV] + (size_t)li * 16 * 512 * 512, (bf16*)(ws + W_CVT), 512, 512, 16, lds, jb, jn);
  convert_job(P->in[I_CK] + (size_t)li * 16 * 512 * 512, (bf16*)(ws + W_CK), 16ull * 512 * 512, jb, jn);
}

__device__ __forceinline__ void phase_prologue(KP P, int li, bf16* smem) {
  float* lds = (float*)smem;
  unsigned char* ws = P->ws;
  pro_misc(P, li, lds, bidx(), gdim());
  pro_cache(P, li, lds, bidx(), gdim());
  if (li == 0) {
    convert_job(P->in[I_XP], (bf16*)(ws + W_X), (size_t)NPTOK * 1024, bidx(), gdim());
    convert_job(P->in[I_XS], (bf16*)(ws + W_X) + (size_t)NPTOK * 1024, 1024ull * 1024, bidx(), gdim());
    float2* rope = (float2*)(ws + W_ROPE);
    for (int i = bidx() * 256 + tidx(); i < 4096 * 32; i += gdim() * 256) {
      int pos = i >> 5, j = i & 31;
      float freq = expf(-(float)j * (9.210340371976184f / 32.f));
      float ang = (float)pos * freq;
      float sn, cs; sincosf(ang, &sn, &cs);
      rope[i] = make_float2(cs, sn);
    }
  }
}

__device__ __forceinline__ void phase_gemm_in(KP P, int li, bf16* smem) {
  EPI_VARS
  const bf16* X = (const bf16*)(P->ws + W_X);
  const bf16* Wt = (const bf16*)(P->ws + W_IN);
  bf16* H = (bf16*)(P->ws + W_H);
  bf16* HT = (bf16*)(P->ws + W_HT);
  const float2* rope = (const float2*)(P->ws + W_ROPE);
  float* out = P->out;
  for (int t = bidx(); t < 7 * 512; t += gdim()) {
    const int x_ = t & 7, q_ = t >> 3;
    const int loc_ = q_ & 63;
    int mt2, nt;
    if (t < 6 * 512) {
      const int sidx_ = ((q_ >> 6) * 8 + x_) * 2 + (loc_ >> 5);
      const int sm_ = sidx_ / 6, sn_ = sidx_ - sm_ * 6;
      mt2 = sm_ * 4 + ((loc_ & 31) >> 3); nt = sn_ * 8 + (loc_ & 7);
    } else {
      if (loc_ >= 24) continue;
      const int id_ = loc_ * 8 + x_;
      mt2 = 64 + (id_ & 3); nt = id_ >> 2;
    }
    if (nt >= 46) continue;
    const int n0 = nt * 128;
    f32x16 acc2[2][2][2];
    zero_acc(acc2[0]); zero_acc(acc2[1]);
    {
      const bf16* Ab = X + (size_t)mt2 * 256 * 1024;
      const bf16* Bb = Wt + (size_t)n0 * 1024;
      gemm_kloop_tall(acc2,
        [&](int r, int kc) { return *(const uint4*)(Ab + (size_t)r * 1024 + kc * 8); },
        [&](int r, int kc) { return *(const uint4*)(Bb + (size_t)r * 1024 + kc * 8); }, 32, smem);
    }
   auto epilogue = [&](f32x16 (&acc)[2][2], const int m0) {
    EPI_BASE
    const int cb = n0 + wn * 64;
    if (cb >= C_QRET && cb < C_VRET) {
      const float sc = (cb < C_KRET) ? 0.125f : 1.f;
#pragma unroll
      for (int mi = 0; mi < 2; mi++)
#pragma unroll
        for (int r = 0; r < 16; r++) {
          int row = m0 + EPI_ROW(mi, r);
          int pos = row < NPTOK ? (row & 4095) : 2048 + ((row - NPTOK) & 63);
          float2 cs = rope[pos * 32 + (lane & 31)];
          float x1 = acc[mi][0][r], x2 = acc[mi][1][r];
          acc[mi][0][r] = (x1 * cs.x - x2 * cs.y) * sc;
          acc[mi][1][r] = (x1 * cs.y + x2 * cs.x) * sc;
        }
    }
    if (cb >= C_KATT && cb < C_QRET) {
      const bool isv = cb >= C_VATT;
      const int c0 = isv ? C_VATT : C_KATT;
#pragma unroll
      for (int mi = 0; mi < 2; mi++)
#pragma unroll
        for (int r = 0; r < 16; r++) {
          int row = m0 + EPI_ROW(mi, r);
#pragma unroll
          for (int ni = 0; ni < 2; ni++) {
            int col = n0 + EPI_COL(ni) - c0;
            if (row < NPTOK) {
              int b = row >> 12, tt = row & 4095;
              if (tt >= 3584) out[(isv ? O_AV_P : O_AK_P) + (((size_t)(li * 4 + b) * 512 + (tt - 3584)) * 512 + col)] = acc[mi][ni][r];
            } else {
              int rs = row - NPTOK;
              out[(isv ? O_AV_S : O_AK_S) + ((size_t)li * 1024 + rs) * 512 + col] = acc[mi][ni][r];
            }
          }
        }
    }
    int trow = -1;
    if (cb >= C_VATT && cb < C_QRET) trow = cb - C_VATT;
    else if (cb >= C_KRET && cb < C_VRET) trow = 512 + cb - C_KRET;
    else if (cb >= C_VRET && cb < C_GRET) trow = 768 + cb - C_VRET;
    if (trow >= 0) {
#pragma unroll
      for (int mi = 0; mi < 2; mi++)
#pragma unroll
        for (int ni = 0; ni < 2; ni++)
#pragma unroll
          for (int rg = 0; rg < 4; rg++) {
            int rowb = m0 + wm * 64 + mi * 32 + 8 * rg + 4 * (lane >> 5);
            uint2 o; o.x = pack2(acc[mi][ni][rg * 4], acc[mi][ni][rg * 4 + 1]); o.y = pack2(acc[mi][ni][rg * 4 + 2], acc[mi][ni][rg * 4 + 3]);
            *(uint2*)(HT + (size_t)(trow + ni * 32 + (lane & 31)) * NTOK + rowb) = o;
          }
    }
    const bool skipH = (n0 >= C_VATT && n0 < C_QRET) || (n0 >= C_VRET && n0 < C_GRET);
    if (!skipH) epi_rowmajor(acc, smem, [&](int row, int c8, float (&v)[8]) {
      uint4 o; o.x = pack2(v[0], v[1]); o.y = pack2(v[2], v[3]); o.z = pack2(v[4], v[5]); o.w = pack2(v[6], v[7]);
      *(uint4*)(H + (size_t)(m0 + row) * INC + n0 + c8) = o;
    });
   };
   epilogue(acc2[0], mt2 * 256);
   epilogue(acc2[1], mt2 * 256 + 128);
  }
}

#define AP_LD 72
__device__ __forceinline__ void attn_item(KP P, int li, int item, bf16* smem) {
  float* bias = (float*)smem;
  bf16* pbuf = smem + 2048;
  const bf16* H = (const bf16*)(P->ws + W_H);
  const bf16* HT = (const bf16*)(P->ws + W_HT);
  bf16* Yatt = (bf16*)(P->ws + W_YATT);
  const int h = item & 7, cidx = item >> 3;
  const float* tab = P->in[I_BIAS] + (size_t)li * 513 * 8;
  const int tid = opaque(tidx());
  const int lane = tid & 63, w = tid >> 6, l15 = lane & 15, g = lane >> 4;
  __syncthreads();
  for (int i = tid; i < 640; i += 256) bias[i] = tab[(min(i - 63, 256) + 256) * 8 + h];
  const int row0 = cidx * 64;
  const bf16* Qp = H + (size_t)(row0 + w * 16) * INC + C_QATT + h * 64;
  const bf16* Kcur = H + (size_t)row0 * INC + C_KATT + h * 64;
  const bf16* VTcur = HT + (size_t)(h * 64) * NTOK + row0;
  bf16* Yout = Yatt + (size_t)(row0 + w * 16) * 512 + h * 64;
  const bf16* Kpast; const bf16* VTpast; int kst; size_t vst; int jt_start, smin;
  if (cidx < 256) {
    int c = cidx & 63;
    jt_start = c >= 8 ? 0 : 32 - 4 * c;
    smin = c >= 8 ? 0 : 8 - c;
    Kpast = Kcur - (ptrdiff_t)512 * INC; kst = INC;
    VTpast = VTcur - 512; vst = NTOK;
  } else {
    int b = cidx - 256;
    jt_start = 0; smin = 0;
    Kpast = (const bf16*)(P->ws + W_CK) + (size_t)b * 512 * 512 + h * 64; kst = 512;
    VTpast = (const bf16*)(P->ws + W_CVT) + (size_t)b * 512 * 512 + (size_t)(h * 64) * 512; vst = 512;
  }
  const int lr = tid >> 2, lc = (tid & 3) * 16;
  bf16x8 qf[2];
#pragma unroll
  for (int ks = 0; ks < 2; ks++) qf[ks] = u4_to_frag(*(const uint4*)(Qp + (size_t)l15 * INC + ks * 32 + g * 8));
  uint4 r0a, r0b, r1a, r1b, r2a, r2b;
#define AP_LOAD(p, va, vb) { const int step_ = ((p) < 9) ? (p) : (p) - 9; const int se_ = max(step_, smin); const bf16* src_; \
    if ((p) < 9) src_ = (se_ < 8) ? (Kpast + (ptrdiff_t)(se_ * 64 + lr) * kst) : (Kcur + (size_t)lr * INC); \
    else src_ = (se_ < 8) ? (VTpast + (size_t)lr * vst + se_ * 64) : (VTcur + (size_t)lr * NTOK); \
    va = *(const uint4*)(src_ + lc); vb = *(const uint4*)(src_ + lc + 8); }
#define AP_STORE(p, va, vb) { bf16* dst_ = pbuf + ((p) & 1) * (64 * AP_LD) + lr * AP_LD + lc; *(uint4*)dst_ = va; *(uint4*)(dst_ + 8) = vb; }
  AP_LOAD(0, r0a, r0b) AP_LOAD(1, r1a, r1b) AP_LOAD(2, r2a, r2b)
  AP_STORE(0, r0a, r0b)
  __syncthreads();
  f32x4 s[36];
#pragma unroll
  for (int p = 0; p < 9; p++) {
    const bf16* pc = pbuf + (p & 1) * (64 * AP_LD);
#pragma unroll
    for (int t = 0; t < 4; t++) {
      const int jt = p * 4 + t;
      s[jt] = f32x4{0.f, 0.f, 0.f, 0.f};
#pragma unroll
      for (int ks = 0; ks < 2; ks++) {
        bf16x8 kf = *(const bf16x8*)(pc + (t * 16 + l15) * AP_LD + ks * 32 + g * 8);
        s[jt] = __builtin_amdgcn_mfma_f32_16x16x32_bf16(kf, qf[ks], s[jt], 0, 0, 0);
      }
    }
    AP_STORE(p + 1, r1a, r1b)
    r1a = r2a; r1b = r2b;
    AP_LOAD(p + 3, r2a, r2b)
    __syncthreads();
  }
  float inv;
  {
    const int iq = w * 16 + l15;
    const float* bq = bias + (iq - 4 * g + 575);
    float mx = -3.0e38f;
#pragma unroll
    for (int jt = 0; jt < 36; jt++) {
#pragma unroll
      for (int r = 0; r < 4; r++) {
        float v = s[jt][r] * 0.125f + bq[-(jt * 16 + r)];
        if (jt < 32) v = (jt < jt_start) ? -3.0e38f : v;
        s[jt][r] = v;
        mx = fmaxf(mx, v);
      }
    }
    mx = fmaxf(mx, __shfl_xor(mx, 16));
    mx = fmaxf(mx, __shfl_xor(mx, 32));
    float sum = 0.f;
#pragma unroll
    for (int jt = 0; jt < 36; jt++) {
#pragma unroll
      for (int r = 0; r < 4; r++) { float e = __expf(s[jt][r] - mx); s[jt][r] = e; sum += e; }
    }
    sum += __shfl_xor(sum, 16);
    sum += __shfl_xor(sum, 32);
    inv = 1.f / sum;
  }
  f32x4 o[4];
#pragma unroll
  for (int et = 0; et < 4; et++) o[et] = f32x4{0.f, 0.f, 0.f, 0.f};
#pragma unroll
  for (int p = 9; p < 18; p++) {
    const bf16* pc = pbuf + (p & 1) * (64 * AP_LD);
    const int step = p - 9;
#pragma unroll
    for (int u = 0; u < 2; u++) {
      const int kk = step * 2 + u;
      union { uint4 u4; bf16x8 f; } pf;
      pf.u4.x = pack2(s[2 * kk][0], s[2 * kk][1]); pf.u4.y = pack2(s[2 * kk][2], s[2 * kk][3]);
      pf.u4.z = pack2(s[2 * kk + 1][0], s[2 * kk + 1][1]); pf.u4.w = pack2(s[2 * kk + 1][2], s[2 * kk + 1][3]);
#pragma unroll
      for (int et = 0; et < 4; et++) {
        const bf16* vp = pc + (et * 16 + l15) * AP_LD + u * 32 + 4 * g;
        union { uint4 u4; bf16x8 f; } vf;
        uint2 a = *(const uint2*)vp, b = *(const uint2*)(vp + 16);
        vf.u4.x = a.x; vf.u4.y = a.y; vf.u4.z = b.x; vf.u4.w = b.y;
        o[et] = __builtin_amdgcn_mfma_f32_16x16x32_bf16(vf.f, pf.f, o[et], 0, 0, 0);
      }
    }
    if (p + 1 < 18) { AP_STORE(p + 1, r1a, r1b) }
    r1a = r2a; r1b = r2b;
    if (p + 3 < 18) { AP_LOAD(p + 3, r2a, r2b) }
    __syncthreads();
  }
#pragma unroll
  for (int et = 0; et < 4; et++) {
    uint2 ov; ov.x = pack2(o[et][0] * inv, o[et][1] * inv); ov.y = pack2(o[et][2] * inv, o[et][3] * inv);
    *(uint2*)(Yout + (size_t)l15 * 512 + et * 16 + 4 * g) = ov;
  }
}

__device__ __forceinline__ void ret_contrib_item(KP P, int item) {
  const bf16* HT = (const bf16*)(P->ws + W_HT);
  float* CT = (float*)(P->ws + W_CT);
  const int h = item & 3, cidx = item >> 2;
  const int lane = opaque(tidx() & 63), w = tidx() >> 6, l15 = lane & 15, g = lane >> 4;
  const float lg2 = log2f(1.f - exp2f(-5.f - (float)h));
  const int tok0 = cidx * 64;
  f32x4 acc[4];
#pragma unroll
  for (int dt = 0; dt < 4; dt++) acc[dt] = f32x4{0.f, 0.f, 0.f, 0.f};
#pragma unroll
  for (int ks = 0; ks < 2; ks++) {
    uint4 vr = *(const uint4*)(HT + (size_t)(768 + h * 64 + w * 16 + l15) * NTOK + tok0 + ks * 32 + g * 8);
    unsigned vv[4] = {vr.x, vr.y, vr.z, vr.w};
    union { uint4 u; bf16x8 f; } vf;
    unsigned oo[4];
#pragma unroll
    for (int q = 0; q < 4; q++) {
      int j = ks * 32 + g * 8 + 2 * q;
      float k0 = exp2f(lg2 * (float)(63 - j)), k1 = exp2f(lg2 * (float)(62 - j));
      oo[q] = pack2(bflo(vv[q]) * k0, bfhi(vv[q]) * k1);
    }
    vf.u = make_uint4(oo[0], oo[1], oo[2], oo[3]);
#pragma unroll
    for (int dt = 0; dt < 4; dt++) {
      bf16x8 kf = u4_to_frag(*(const uint4*)(HT + (size_t)(512 + h * 64 + dt * 16 + l15) * NTOK + tok0 + ks * 32 + g * 8));
      acc[dt] = __builtin_amdgcn_mfma_f32_16x16x32_bf16(vf.f, kf, acc[dt], 0, 0, 0);
    }
  }
#pragma unroll
  for (int dt = 0; dt < 4; dt++)
#pragma unroll
    for (int r = 0; r < 4; r++) {
      int e = w * 16 + 4 * g + r, d = dt * 16 + l15;
      CT[((size_t)(cidx * 4 + h) * 64 + e) * 64 + d] = acc[dt][r];
    }
}

__device__ __forceinline__ void ssm_state_tile(KP P, int t, bf16* smem) {
  EPI_VARS
  const bf16* H = (const bf16*)(P->ws + W_H);
  const bf16* Bst = (const bf16*)(P->ws + W_BST);
  float* SC = (float*)(P->ws + W_SC);
  const int g = t / 3, mt = t % 3;
  const int m0 = mt * 128;
  f32x16 acc[2][2];
  zero_acc(acc);
  const bf16* Bb = Bst + (size_t)g * 128 * 1024;
  gemm_kloop(acc,
    [&](int r, int kc) { int c = min(m0 + r, NCHUNK - 1); int s = kc >> 1, q0 = (kc & 1) * 8;
                         return *(const uint4*)(H + (size_t)(c * 64 + s) * INC + g * 16 + q0); },
    [&](int r, int kc) { return *(const uint4*)(Bb + (size_t)r * 1024 + kc * 8); }, 0, 16, smem);
    EPI_BASE
#pragma unroll
  for (int mi = 0; mi < 2; mi++)
#pragma unroll
    for (int ni = 0; ni < 2; ni++)
#pragma unroll
      for (int r = 0; r < 16; r++) {
        int c = m0 + EPI_ROW(mi, r), nn = EPI_COL(ni);
        if (c < NCHUNK) SC[((size_t)c * 16 + g) * 128 + nn] = acc[mi][ni][r];
      }
}

__device__ __forceinline__ void phase_A(KP P, int li, bf16* smem) {
  const int n_attn = NCHUNK * 8, n_ret = NCHUNK * 4, n_ssm = 48;
  const int total = n_attn + n_ret + n_ssm;
  for (int t = bidx(); t < total; t += gdim()) {
    if (t < n_ssm) ssm_state_tile(P, t, smem);
    else if (t < n_ssm + n_attn) attn_item(P, li, t - n_ssm, smem);
    else ret_contrib_item(P, t - n_ssm - n_attn);
  }
}

__device__ __forceinline__ void phase_B(KP P, int li) {
  const float* CT = (const float*)(P->ws + W_CT);
  bf16* SP = (bf16*)(P->ws + W_SPREV);
  const float* SC = (const float*)(P->ws + W_SC);
  bf16* HS = (bf16*)(P->ws + W_HS);
  float* out = P->out;
  const int gt = bidx() * 256 + tidx(), gn = gdim() * 256;
  for (int i = gt; i < 65536; i += gn) {
    int ed = i & 4095, h = (i >> 12) & 3, b = i >> 14;
    float g64 = exp2f(64.f * log2f(1.f - exp2f(-5.f - (float)h)));
    float S = 0.f;
    for (int c0 = 0; c0 < 64; c0 += 16) {
      float ct[16];
#pragma unroll
      for (int u = 0; u < 16; u++) ct[u] = CT[((size_t)((b * 64 + c0 + u) * 4 + h)) * 4096 + ed];
#pragma unroll
      for (int u = 0; u < 16; u++) {
        SP[((size_t)((b * 64 + c0 + u) * 4 + h)) * 4096 + ed] = f2bf(S);
        S = g64 * S + ct[u];
      }
    }
    int e = ed >> 6, d = ed & 63;
    out[O_RET_P + ((size_t)((li * 4 + b) * 4 + h)) * 4096 + d * 64 + e] = S;
  }
  for (int i = gt; i < 262144; i += gn) {
    int ed = i & 4095, h = (i >> 12) & 3, b = i >> 14;
    int e = ed >> 6, d = ed & 63;
    float g64 = exp2f(64.f * log2f(1.f - exp2f(-5.f - (float)h)));
    size_t sidx = ((size_t)((li * 16 + b) * 4 + h)) * 4096 + d * 64 + e;
    float S = P->in[I_SRET][sidx];
    size_t idx = ((size_t)((256 + b) * 4 + h)) * 4096 + ed;
    SP[idx] = f2bf(S);
    S = g64 * S + CT[idx];
    out[O_RET_S + sidx] = S;
  }
  for (int i = gt; i < 4096 + 16384; i += gn) {
    const bool prompt = i < 4096;
    int j = prompt ? i : i - 4096;
    int n = j & 63, g = (j >> 6) & 15, b = j >> 10;
    float dt = expf(P->in[I_LDT][li * 16 + g]);
    float ar = P->in[I_LRE][li * 1024 + g * 64 + n] * dt, ai = P->in[I_LIM][li * 1024 + g * 64 + n] * dt;
    float mag = expf(ar * 64.f); float sn, cs; sincosf(ai * 64.f, &sn, &cs);
    float a_r = mag * cs, a_i = mag * sn;
    if (prompt) {
      float hr = 0.f, hi = 0.f;
      for (int c0 = 0; c0 < 64; c0 += 16) {
        float2 cc[16];
#pragma unroll
        for (int u = 0; u < 16; u++) cc[u] = *(const float2*)(SC + ((size_t)(b * 64 + c0 + u) * 16 + g) * 128 + n * 2);
#pragma unroll
        for (int u = 0; u < 16; u++) {
          size_t idx = ((size_t)(b * 64 + c0 + u) * 16 + g) * 128 + n * 2;
          *(unsigned*)(HS + idx) = pack2(hr, hi);
          float nr = a_r * hr - a_i * hi + cc[u].x, ni = a_r * hi + a_i * hr + cc[u].y;
          hr = nr; hi = ni;
        }
      }
      out[O_SRE_P + ((size_t)(li * 4 + b) * 16 + g) * 64 + n] = hr;
      out[O_SIM_P + ((size_t)(li * 4 + b) * 16 + g) * 64 + n] = hi;
    } else {
      size_t sidx = ((size_t)(li * 16 + b) * 16 + g) * 64 + n;
      float hr = P->in[I_SRE][sidx], hi = P->in[I_SIM][sidx];
      size_t idx = ((size_t)(256 + b) * 16 + g) * 128 + n * 2;
      *(unsigned*)(HS + idx) = pack2(hr, hi);
      float cr = SC[idx], ci = SC[idx + 1];
      out[O_SRE_S + sidx] = a_r * hr - a_i * hi + cr;
      out[O_SIM_S + sidx] = a_r * hi + a_i * hr + ci;
    }
  }
}

__device__ __forceinline__ void ret_finish_item(KP P, int li, int item) {
  const bf16* H = (const bf16*)(P->ws + W_H);
  const bf16* HT = (const bf16*)(P->ws + W_HT);
  const bf16* SP = (const bf16*)(P->ws + W_SPREV);
  bf16* Yret = (bf16*)(P->ws + W_YRET);
  const float* gng = P->in[I_GNG] + li * 256;
  const int h = item & 3, cidx = item >> 2;
  const int lane = opaque(tidx() & 63), w = tidx() >> 6, l15 = lane & 15, g = lane >> 4;
  const float lg2 = log2f(1.f - exp2f(-5.f - (float)h));
  const int row0 = cidx * 64;
  const int iq = w * 16 + l15;
  bf16x8 qf[2];
#pragma unroll
  for (int ks = 0; ks < 2; ks++) qf[ks] = u4_to_frag(*(const uint4*)(H + (size_t)(row0 + iq) * INC + C_QRET + h * 64 + ks * 32 + g * 8));
  f32x4 s[4];
#pragma unroll
  for (int jt = 0; jt < 4; jt++) {
    s[jt] = f32x4{0.f, 0.f, 0.f, 0.f};
#pragma unroll
    for (int ks = 0; ks < 2; ks++) {
      bf16x8 kf = u4_to_frag(*(const uint4*)(H + (size_t)(row0 + jt * 16 + l15) * INC + C_KRET + h * 64 + ks * 32 + g * 8));
      s[jt] = __builtin_amdgcn_mfma_f32_16x16x32_bf16(kf, qf[ks], s[jt], 0, 0, 0);
    }
#pragma unroll
    for (int r = 0; r < 4; r++) {
      int j = jt * 16 + 4 * g + r;
      int dd = iq - j; dd = dd < 0 ? -dd : dd;
      s[jt][r] *= exp2f(lg2 * (float)dd);
    }
  }
  f32x4 o[4], oi[4];
#pragma unroll
  for (int et = 0; et < 4; et++) { o[et] = f32x4{0.f, 0.f, 0.f, 0.f}; oi[et] = f32x4{0.f, 0.f, 0.f, 0.f}; }
#pragma unroll
  for (int kk = 0; kk < 2; kk++) {
    union { uint4 u; bf16x8 f; } pf;
    pf.u.x = pack2(s[2 * kk][0], s[2 * kk][1]); pf.u.y = pack2(s[2 * kk][2], s[2 * kk][3]);
    pf.u.z = pack2(s[2 * kk + 1][0], s[2 * kk + 1][1]); pf.u.w = pack2(s[2 * kk + 1][2], s[2 * kk + 1][3]);
#pragma unroll
    for (int et = 0; et < 4; et++) {
      const bf16* vp = HT + (size_t)(768 + h * 64 + et * 16 + l15) * NTOK + row0 + kk * 32 + 4 * g;
      union { uint4 u; bf16x8 f; } vf;
      uint2 a = *(const uint2*)vp, b = *(const uint2*)(vp + 16);
      vf.u.x = a.x; vf.u.y = a.y; vf.u.z = b.x; vf.u.w = b.y;
      o[et] = __builtin_amdgcn_mfma_f32_16x16x32_bf16(vf.f, pf.f, o[et], 0, 0, 0);
    }
  }
#pragma unroll
  for (int ks = 0; ks < 2; ks++)
#pragma unroll
    for (int et = 0; et < 4; et++) {
      bf16x8 sf = u4_to_frag(*(const uint4*)(SP + ((size_t)(cidx * 4 + h) * 64 + et * 16 + l15) * 64 + ks * 32 + g * 8));
      oi[et] = __builtin_amdgcn_mfma_f32_16x16x32_bf16(sf, qf[ks], oi[et], 0, 0, 0);
    }
  const float qw = exp2f(lg2 * (float)(iq + 1));
  float sum = 0.f;
#pragma unroll
  for (int et = 0; et < 4; et++)
#pragma unroll
    for (int r = 0; r < 4; r++) { o[et][r] += qw * oi[et][r]; sum += o[et][r]; }
  sum += __shfl_xor(sum, 16); sum += __shfl_xor(sum, 32);
  const float mu = sum * (1.f / 64.f);
  float vs = 0.f;
#pragma unroll
  for (int et = 0; et < 4; et++)
#pragma unroll
    for (int r = 0; r < 4; r++) { float d = o[et][r] - mu; vs += d * d; }
  vs += __shfl_xor(vs, 16); vs += __shfl_xor(vs, 32);
  const float rstd = rsqrtf(vs * (1.f / 64.f) + LN_EPS);
#pragma unroll
  for (int et = 0; et < 4; et++) {
    int e0 = et * 16 + 4 * g;
    uint2 gr = *(const uint2*)(H + (size_t)(row0 + iq) * INC + C_GRET + h * 64 + e0);
    float gv[4] = {bflo(gr.x), bfhi(gr.x), bflo(gr.y), bfhi(gr.y)};
    float y[4];
#pragma unroll
    for (int r = 0; r < 4; r++) {
      float gg = gv[r];
      y[r] = (o[et][r] - mu) * rstd * gng[h * 64 + e0 + r] * (gg * sigmoidf_(gg));
    }
    uint2 ov; ov.x = pack2(y[0], y[1]); ov.y = pack2(y[2], y[3]);
    *(uint2*)(Yret + (size_t)(row0 + iq) * 256 + h * 64 + e0) = ov;
  }
}

__device__ __forceinline__ void ssm_toep_tile(KP P, int li, int t, bf16* smem) {
  EPI_VARS
  const bf16* H = (const bf16*)(P->ws + W_H);
  const bf16* Tt = (const bf16*)(P->ws + W_TT);
  const bf16* HS = (const bf16*)(P->ws + W_HS);
  bf16* Zs = (bf16*)(P->ws + W_CT);
  const float* dsk = P->in[I_SD] + li * 256;
  const int g = t / 24, r24 = t % 24, mt = r24 / 8, nt = r24 % 8;
  const int m0 = mt * 128, n0 = nt * 128;
  f32x16 acc[2][2];
  zero_acc(acc);
  const bf16* Kg = Tt + (size_t)g * 64 * 256;
  const bf16* Cg = Tt + KERN_ELEMS + ((size_t)g * 1024 + n0) * 128;
  auto al = [&](int r, int kc) {
    int c = min(m0 + r, NCHUNK - 1);
    if (kc < 128) { int s = kc >> 1, q0 = (kc & 1) * 8; return *(const uint4*)(H + (size_t)(c * 64 + s) * INC + g * 16 + q0); }
    return *(const uint4*)(HS + ((size_t)c * 16 + g) * 128 + (kc - 128) * 8);
  };
  auto bl = [&](int r, int kc) {
    if (kc < 128) {
      int n = n0 + r, tt = n >> 4, p = n & 15, ss = kc >> 1, q0 = (kc & 1) * 8;
      int d = tt - ss;
      uint4 v = *(const uint4*)(Kg + ((size_t)max(d, 0) * 16 + p) * 16 + q0);
      if (d < 0) v = make_uint4(0u, 0u, 0u, 0u);
      return v;
    }
    return *(const uint4*)(Cg + (size_t)r * 128 + (kc - 128) * 8);
  };
  gemm_kloop(acc, al, bl, 0, 2 * (nt + 1), smem);
  gemm_kloop(acc, al, bl, 16, 2, smem);
    EPI_BASE
#pragma unroll
  for (int mi = 0; mi < 2; mi++)
#pragma unroll
    for (int ni = 0; ni < 2; ni++)
#pragma unroll
      for (int r = 0; r < 16; r++) {
        int c = m0 + EPI_ROW(mi, r), n = n0 + EPI_COL(ni);
        if (c < NCHUNK) {
          int tt = n >> 4, p = n & 15;
          size_t tok = (size_t)c * 64 + tt;
          float u = bf2f(H[tok * INC + g * 16 + p]);
          float y = acc[mi][ni][r] + dsk[g * 16 + p] * u;
          Zs[tok * 256 + g * 16 + p] = f2bf(gelu_tanh(y));
        }
      }
}

__device__ __forceinline__ void phase_C(KP P, int li, bf16* smem) {
  const int n_toep = 16 * 24, n_ret = NCHUNK * 4;
  for (int t = bidx(); t < n_toep + n_ret; t += gdim()) {
    if (t < n_toep) ssm_toep_tile(P, li, t, smem);
    else ret_finish_item(P, li, t - n_toep);
  }
}

__device__ __forceinline__ void phase_D(KP P, int li, bf16* smem) {
  EPI_VARS
  const bf16* Zs = (const bf16*)(P->ws + W_CT);
  const bf16* Wt = (const bf16*)(P->ws + W_GLU);
  bf16* Yssm = (bf16*)(P->ws + W_YSSM);
  const float* bg = P->in[I_BGLU] + li * 256;
  for (int t = bidx(); t < 136 * 2; t += gdim()) {
    const int m0 = (t >> 1) * 128, n0 = (t & 1) * 128;
    f32x16 acc[2][2];
    zero_acc(acc);
    const bf16* Ab = Zs + (size_t)m0 * 256;
    const bf16* Bb = Wt + (size_t)n0 * 256;
    gemm_kloop(acc,
      [&](int r, int kc) { return *(const uint4*)(Ab + (size_t)r * 256 + kc * 8); },
      [&](int r, int kc) { return *(const uint4*)(Bb + (size_t)r * 256 + kc * 8); }, 0, 4, smem);
    EPI_BASE
#pragma unroll
    for (int mi = 0; mi < 2; mi++)
#pragma unroll
      for (int ni = 0; ni < 2; ni++)
#pragma unroll
        for (int r = 0; r < 16; r++) {
          int row = m0 + EPI_ROW(mi, r), col = n0 + EPI_COL(ni);
          float z = bf2f(Zs[(size_t)row * 256 + col]);
          Yssm[(size_t)row * 256 + col] = f2bf(z * sigmoidf_(acc[mi][ni][r] + bg[col]));
        }
  }
}

__device__ __forceinline__ void phase_E(KP P, int li, bf16* smem) {
  EPI_VARS
  const bf16* H = (const bf16*)(P->ws + W_H);
  bf16* MG = (bf16*)(P->ws + W_HT);
  for (int t = bidx(); t < SWZ_TOTAL(8); t += gdim()) {
    int mt_, nt_;
    if (!tile_swz(t, 8, mt_, nt_)) continue;
    const int m0 = mt_ * 128, n0 = nt_ * 128;
    f32x16 tot[2][2];
    zero_acc(tot);
#pragma unroll 1
    for (int br = 0; br < 3; br++) {
      const bf16* Y = (const bf16*)(P->ws + (br == 0 ? W_YSSM : (br == 1 ? W_YATT : W_YRET)));
      const bf16* Wt = (const bf16*)(P->ws + (br == 0 ? W_BRS : (br == 1 ? W_BRA : W_BRR)));
      const int K = (br == 1) ? 512 : 256;
      f32x16 acc[2][2];
      zero_acc(acc);
      const bf16* Ab = Y + (size_t)m0 * K;
      const bf16* Bb = Wt + (size_t)n0 * K;
      gemm_kloop_light(acc,
        [&](int r, int kc) { return *(const uint4*)(Ab + (size_t)r * K + kc * 8); },
        [&](int r, int kc) { return *(const uint4*)(Bb + (size_t)r * K + kc * 8); }, 0, K / 64, smem);
#pragma unroll
      for (int mi = 0; mi < 2; mi++)
#pragma unroll
        for (int ni = 0; ni < 2; ni++) {
          EPI_BASE
#pragma unroll
          for (int r = 0; r < 16; r++) {
            int row = m0 + EPI_ROW(mi, r), col = n0 + EPI_COL(ni);
            float gt = bf2f(H[(size_t)row * INC + C_GATE + br * 1024 + col]);
            tot[mi][ni][r] += sigmoidf_(gt) * acc[mi][ni][r];
          }
        }
    }
    EPI_BASE
#pragma unroll
    for (int mi = 0; mi < 2; mi++)
#pragma unroll
      for (int ni = 0; ni < 2; ni++)
#pragma unroll
        for (int r = 0; r < 16; r++) {
          int row = m0 + EPI_ROW(mi, r), col = n0 + EPI_COL(ni);
          MG[(size_t)row * 1024 + col] = f2bf(tot[mi][ni][r]);
        }
  }
  { int jb, jn; if (light_block(1, jb, jn)) convert_fp8_job(P->in[I_PU] + (size_t)li * 16384 * 1024, P->ws + W_U, 16384ull * 1024, 256.f, jb, jn); }
}

__device__ __forceinline__ void phase_WO(KP P, int li, bf16* smem) {
  EPI_VARS
  const bf16* MG = (const bf16*)(P->ws + W_HT);
  const bf16* Wt = (const bf16*)(P->ws + W_O);
  const bf16* X = (const bf16*)(P->ws + W_X);
  bf16* Z = (bf16*)(P->ws + W_H);
  for (int t = bidx(); t < SWZ_TOTAL(8); t += gdim()) {
    int mt_, nt_;
    if (!tile_swz(t, 8, mt_, nt_)) continue;
    const int m0 = mt_ * 128, n0 = nt_ * 128;
    f32x16 acc[2][2];
    zero_acc(acc);
    const bf16* Ab = MG + (size_t)m0 * 1024;
    const bf16* Bb = Wt + (size_t)n0 * 1024;
    gemm_kloop(acc,
      [&](int r, int kc) { return *(const uint4*)(Ab + (size_t)r * 1024 + kc * 8); },
      [&](int r, int kc) { return *(const uint4*)(Bb + (size_t)r * 1024 + kc * 8); }, 0, 16, smem);
    EPI_BASE
    epi_rowmajor(acc, smem, [&](int row, int c8, float (&v)[8]) {
      uint4 xr = *(const uint4*)(X + (size_t)(m0 + row) * 1024 + n0 + c8);
      uint4 o;
      o.x = pack2(DN_ALPHA * bflo(xr.x) + v[0], DN_ALPHA * bfhi(xr.x) + v[1]); o.y = pack2(DN_ALPHA * bflo(xr.y) + v[2], DN_ALPHA * bfhi(xr.y) + v[3]);
      o.z = pack2(DN_ALPHA * bflo(xr.z) + v[4], DN_ALPHA * bfhi(xr.z) + v[5]); o.w = pack2(DN_ALPHA * bflo(xr.w) + v[6], DN_ALPHA * bfhi(xr.w) + v[7]);
      *(uint4*)(Z + (size_t)(m0 + row) * 1024 + n0 + c8) = o;
    });
  }
  { int jb, jn; if (light_block(1, jb, jn)) convert_fp8_job(P->in[I_PV] + (size_t)li * 16384 * 1024, P->ws + W_V, 16384ull * 1024, 64.f, jb, jn); }
}

__device__ __forceinline__ void phase_LN(KP P, const float* gam, const float* bet, bool final_out, size_t xoff) {
  const bf16* Z = (const bf16*)(P->ws + W_H);
  bf16* X = (bf16*)(P->ws + xoff);
  const int lane = tidx() & 63;
  const int gw = bidx() * 4 + (tidx() >> 6), nw = gdim() * 4;
#pragma unroll 4
  for (int row = gw; row < NTOK; row += nw) {
    float4 v[4];
    float s = 0.f;
#pragma unroll
    for (int i = 0; i < 4; i++) {
      uint2 zr = *(const uint2*)(Z + (size_t)row * 1024 + i * 256 + lane * 4);
      v[i] = make_float4(bflo(zr.x), bfhi(zr.x), bflo(zr.y), bfhi(zr.y));
      s += v[i].x + v[i].y + v[i].z + v[i].w;
    }
    s = wsum(s);
    const float mu = s * (1.f / 1024.f);
    float q = 0.f;
#pragma unroll
    for (int i = 0; i < 4; i++) { float a = v[i].x - mu, b = v[i].y - mu, c = v[i].z - mu, d = v[i].w - mu; q += a * a + b * b + c * c + d * d; }
    q = wsum(q);
    const float rstd = rsqrtf(q * (1.f / 1024.f) + LN_EPS);
#pragma unroll
    for (int i = 0; i < 4; i++) {
      int col = i * 256 + lane * 4;
      float4 gg = *(const float4*)(gam + col), bb = *(const float4*)(bet + col);
      float4 y;
      y.x = (v[i].x - mu) * rstd * gg.x + bb.x; y.y = (v[i].y - mu) * rstd * gg.y + bb.y;
      y.z = (v[i].z - mu) * rstd * gg.z + bb.z; y.w = (v[i].w - mu) * rstd * gg.w + bb.w;
      uint2 o; o.x = pack2(y.x, y.y); o.y = pack2(y.z, y.w);
      if (!final_out) *(uint2*)(X + (size_t)row * 1024 + col) = o;
      else *(float4*)(P->out + (size_t)row * 1024 + col) = y;
    }
  }
}

__device__ __forceinline__ void phase_PQ(KP P, int li, bf16* smem) {
  EPI_VARS
  const bf16* X = (const bf16*)(P->ws + W_HT);
  const bf16* Wt = (const bf16*)(P->ws + W_QK);
  float* S = (float*)(P->ws + W_H);
  for (int t = bidx(); t < 1024; t += gdim()) {
    const int x_ = t & 7, q_ = t >> 3, loc_ = q_ & 63;
    const int sidx_ = ((q_ >> 6) * 8 + x_) * 2 + (loc_ >> 5);
    const int mt2 = (sidx_ >> 1) * 4 + ((loc_ & 31) >> 3), n0 = ((sidx_ & 1) * 8 + (loc_ & 7)) * 128;
    f32x16 acc2[2][2][2];
    zero_acc(acc2[0]); zero_acc(acc2[1]);
    {
      const bf16* Ab = X + (size_t)mt2 * 256 * 1024;
      const bf16* Bb = Wt + (size_t)n0 * 1024;
      gemm_kloop_tall(acc2,
        [&](int r, int kc) { return *(const uint4*)(Ab + (size_t)r * 1024 + kc * 8); },
        [&](int r, int kc) { return *(const uint4*)(Bb + (size_t)r * 1024 + kc * 8); }, 32, smem);
    }
    auto store_half = [&](f32x16 (&acc)[2][2], const int m0) {
      epi_rowmajor(acc, smem, [&](int row, int c8, float (&v)[8]) {
        float* sp = S + (size_t)(m0 + row) * 2048 + n0 + c8;
        *(float4*)sp = make_float4(v[0], v[1], v[2], v[3]);
        *(float4*)(sp + 4) = make_float4(v[4], v[5], v[6], v[7]);
      });
    };
    store_half(acc2[0], mt2 * 256);
    store_half(acc2[1], mt2 * 256 + 128);
  }
  for (int t = 2048 + bidx(); t < SWZ_TOTAL(16); t += gdim()) {
    int mt_, nt_;
    if (!tile_swz(t, 16, mt_, nt_)) continue;
    const int m0 = mt_ * 128, n0 = nt_ * 128;
    f32x16 acc[2][2];
    zero_acc(acc);
    const bf16* Ab = X + (size_t)m0 * 1024;
    const bf16* Bb = Wt + (size_t)n0 * 1024;
    gemm_kloop(acc,
      [&](int r, int kc) { return *(const uint4*)(Ab + (size_t)r * 1024 + kc * 8); },
      [&](int r, int kc) { return *(const uint4*)(Bb + (size_t)r * 1024 + kc * 8); }, 0, 16, smem);
    EPI_BASE
    epi_rowmajor(acc, smem, [&](int row, int c8, float (&v)[8]) {
      float* sp = S + (size_t)(m0 + row) * 2048 + n0 + c8;
      *(float4*)sp = make_float4(v[0], v[1], v[2], v[3]);
      *(float4*)(sp + 4) = make_float4(v[4], v[5], v[6], v[7]);
    });
  }
  { int jb, jn;
    if (light_block(2, jb, jn)) {
      float* lds = (float*)smem;
      convert_job(P->in[I_PP] + (size_t)li * NPTOK * 256, (bf16*)(P->ws + W_PE), (size_t)NPTOK * 256, jb, jn);
      convert_job(P->in[I_PS] + (size_t)li * 1024 * 256, (bf16*)(P->ws + W_PE) + (size_t)NPTOK * 256, 1024ull * 256, jb, jn);
      transpose_job(P->in[I_WG] + (size_t)li * 1024 * 1024, (bf16*)(P->ws + W_G), 1024, 1024, 1, lds, jb, jn);
      transpose_job(P->in[I_WP] + (size_t)li * 256 * 1024, (bf16*)(P->ws + W_P), 256, 1024, 1, lds, jb, jn);
      if (li == 0 && !MULTI_LAUNCH) pro_cache(P, 1, lds, jb, jn);
    }
  }
}

__device__ __forceinline__ float dpp_max_step(float v, const int ctrl_dummy);
#define DPP_MAX(v, ctrl) v = fmaxf(v, __int_as_float(__builtin_amdgcn_update_dpp(__float_as_int(v), __float_as_int(v), ctrl, 0xf, 0xf, false)))
__device__ __forceinline__ float wave_max(float v) {
  DPP_MAX(v, 0x111);
  DPP_MAX(v, 0x112);
  DPP_MAX(v, 0x114);
  DPP_MAX(v, 0x118);
  DPP_MAX(v, 0x142);
  DPP_MAX(v, 0x143);
  return __int_as_float(__builtin_amdgcn_readlane(__float_as_int(v), 63));
}

__device__ __forceinline__ void top16_of128(float v0, float v1, int lane, float& osc, int& oix) {
  osc = -3.0e38f; oix = 0;
#pragma unroll
  for (int r = 0; r < 16; r++) {
    float m = fmaxf(v0, v1);
    float wm = wave_max(m);
    unsigned long long bal = __ballot(m == wm);
    int src = __ffsll((long long)bal) - 1;
    int sel = (v0 == wm) ? 0 : 1;
    int selu = __builtin_amdgcn_readlane(sel, src);
    if (lane == src) { if (selu == 0) v0 = -3.0e38f; else v1 = -3.0e38f; }
    if (lane == r) { osc = wm; oix = src + 64 * selu; }
  }
}

typedef float f2v __attribute__((ext_vector_type(2)));
__device__ __forceinline__ unsigned fkey(float f) { unsigned u = __float_as_uint(f); return u ^ ((unsigned)((int)u >> 31) | 0x80000000u); }
__device__ __forceinline__ int mbcnt64(unsigned long long m) {
  return __builtin_amdgcn_mbcnt_hi((unsigned)(m >> 32), __builtin_amdgcn_mbcnt_lo((unsigned)m, 0u));
}
template <int NV>
__device__ __forceinline__ unsigned top16_threshold(const unsigned (&k)[NV]) {
  unsigned T = 0u;
#pragma unroll 1
  for (int bit = 31; bit >= 0; bit--) {
    const unsigned c = T | (1u << bit);
    int cnt = 0;
#pragma unroll
    for (int i = 0; i < NV; i++) cnt += __popcll(__ballot(k[i] >= c));
    if (cnt >= 16) T = c;
    if (cnt == 16) break;
  }
  return T;
}

__device__ __forceinline__ void phase_PEER(KP P, int li, bf16* smem) {
  const float* S = (const float*)(P->ws + W_H);
  bf16* X = (bf16*)(P->ws + W_X);
  const bf16* XA = (const bf16*)(P->ws + W_HT);
  const unsigned char* U = P->ws + W_U;
  const unsigned char* V = P->ws + W_V;
  const float* gam = P->in[I_L2G] + li * 1024;
  const float* bet = P->in[I_L2B] + li * 1024;
  const int lane = tidx() & 63;
  const int wv = tidx() >> 6;
  const int gw = bidx() * 4 + wv, nw = gdim() * 4;
  float* wl = (float*)smem + wv * 128;
  int* wli = (int*)wl;
  for (int tok = gw; tok < NTOK; tok += nw) {
    f2v xv[8];
    {
      uint4 a = *(const uint4*)(XA + (size_t)tok * 1024 + lane * 16);
      uint4 b = *(const uint4*)(XA + (size_t)tok * 1024 + lane * 16 + 8);
      xv[0] = f2v{bflo(a.x), bfhi(a.x)}; xv[1] = f2v{bflo(a.y), bfhi(a.y)}; xv[2] = f2v{bflo(a.z), bfhi(a.z)}; xv[3] = f2v{bflo(a.w), bfhi(a.w)};
      xv[4] = f2v{bflo(b.x), bfhi(b.x)}; xv[5] = f2v{bflo(b.y), bfhi(b.y)}; xv[6] = f2v{bflo(b.z), bfhi(b.z)}; xv[7] = f2v{bflo(b.w), bfhi(b.w)};
    }
    f2v outv[8];
#pragma unroll
    for (int i = 0; i < 8; i++) outv[i] = f2v{0.f, 0.f};
    const float* Srow = S + (size_t)tok * 2048;
#define PEER_ROUTE(sv, ts_out, eid_out) { \
      _Pragma("unroll") for (int side = 0; side < 2; side++) { \
        float v0 = sv[side * 2], v1 = sv[side * 2 + 1]; \
        unsigned kk[2] = {fkey(v0), fkey(v1)}; \
        unsigned T = top16_threshold<2>(kk); \
        bool s0 = kk[0] >= T, s1 = kk[1] >= T; \
        unsigned long long m0 = __ballot(s0), m1 = __ballot(s1); \
        int r0 = mbcnt64(m0), r1 = __popcll(m0) + mbcnt64(m1); \
        if (s0 && r0 < 16) { wl[side * 16 + r0] = v0; wli[32 + side * 16 + r0] = lane; } \
        if (s1 && r1 < 16) { wl[side * 16 + r1] = v1; wli[32 + side * 16 + r1] = lane + 64; } \
      } \
      { const int i = lane & 15, j0 = lane >> 4; \
        const float a = wl[i]; const int ai = wli[32 + i]; \
        float cs[4]; int ce[4]; unsigned kk[4]; \
        _Pragma("unroll") for (int m = 0; m < 4; m++) { cs[m] = a + wl[16 + j0 + 4 * m]; ce[m] = ai * 128 + wli[48 + j0 + 4 * m]; kk[m] = fkey(cs[m]); } \
        unsigned T = top16_threshold<4>(kk); \
        int base = 0; \
        _Pragma("unroll") for (int m = 0; m < 4; m++) { \
          bool sl = kk[m] >= T; unsigned long long mm = __ballot(sl); int r = base + mbcnt64(mm); \
          if (sl && r < 16) { wl[64 + r] = cs[m]; wli[80 + r] = ce[m]; } \
          base += __popcll(mm); } } \
      ts_out = wl[64 + (lane & 15)]; eid_out = wli[80 + (lane & 15)]; }
    float sva[4], svb[4];
#pragma unroll
    for (int i = 0; i < 4; i++) { sva[i] = __builtin_nontemporal_load(Srow + i * 64 + lane); svb[i] = __builtin_nontemporal_load(Srow + 256 + i * 64 + lane); }
    float ts; int eid;
    PEER_ROUTE(sva, ts, eid)
#pragma unroll 1
    for (int h = 0; h < 8; h++) {
#pragma unroll
      for (int i = 0; i < 4; i++) { sva[i] = svb[i]; }
      if (h + 2 < 8) {
#pragma unroll
        for (int i = 0; i < 4; i++) svb[i] = __builtin_nontemporal_load(Srow + (h + 2) * 256 + i * 64 + lane);
      }
      uint4 ub[16], vb[8];
#pragma unroll
      for (int k = 0; k < 16; k++) {
        int e = __builtin_amdgcn_readlane(eid, k);
        ub[k] = *(const uint4*)(U + (size_t)e * 1024 + lane * 16);
        if (k < 8) vb[k] = *(const uint4*)(V + (size_t)e * 1024 + lane * 16);
      }
      int eidc = eid;
      float tmax = ts;
      tmax = fmaxf(tmax, __shfl_xor(tmax, 1)); tmax = fmaxf(tmax, __shfl_xor(tmax, 2));
      tmax = fmaxf(tmax, __shfl_xor(tmax, 4)); tmax = fmaxf(tmax, __shfl_xor(tmax, 8));
      float ex = __expf(ts - tmax);
      float den = ex;
      den += __shfl_xor(den, 1); den += __shfl_xor(den, 2); den += __shfl_xor(den, 4); den += __shfl_xor(den, 8);
      float gate = ex / den;
      if (h + 1 < 8) { PEER_ROUTE(sva, ts, eid) }
      float dk[16];
#pragma unroll
      for (int k = 0; k < 16; k++) {
        f2v acc = f2v{0.f, 0.f};
        acc += __builtin_amdgcn_cvt_pk_f32_fp8((int)ub[k].x, false) * xv[0]; acc += __builtin_amdgcn_cvt_pk_f32_fp8((int)ub[k].x, true) * xv[1];
        acc += __builtin_amdgcn_cvt_pk_f32_fp8((int)ub[k].y, false) * xv[2]; acc += __builtin_amdgcn_cvt_pk_f32_fp8((int)ub[k].y, true) * xv[3];
        acc += __builtin_amdgcn_cvt_pk_f32_fp8((int)ub[k].z, false) * xv[4]; acc += __builtin_amdgcn_cvt_pk_f32_fp8((int)ub[k].z, true) * xv[5];
        acc += __builtin_amdgcn_cvt_pk_f32_fp8((int)ub[k].w, false) * xv[6]; acc += __builtin_amdgcn_cvt_pk_f32_fp8((int)ub[k].w, true) * xv[7];
        dk[k] = acc[0] + acc[1];
      }
      uint4 vc[8];
#pragma unroll
      for (int k = 0; k < 8; k++) {
        int e = __builtin_amdgcn_readlane(eidc, 8 + k);
        vc[k] = *(const uint4*)(V + (size_t)e * 1024 + lane * 16);
      }
      {
        bool hi = (lane & 32) != 0;
#pragma unroll
        for (int i = 0; i < 8; i++) { float send = hi ? dk[i] : dk[i + 8]; float keep = hi ? dk[i + 8] : dk[i]; dk[i] = keep + __shfl_xor(send, 32); }
        hi = (lane & 16) != 0;
#pragma unroll
        for (int i = 0; i < 4; i++) { float send = hi ? dk[i] : dk[i + 4]; float keep = hi ? dk[i + 4] : dk[i]; dk[i] = keep + __shfl_xor(send, 16); }
        hi = (lane & 8) != 0;
#pragma unroll
        for (int i = 0; i < 2; i++) { float send = hi ? dk[i] : dk[i + 2]; float keep = hi ? dk[i + 2] : dk[i]; dk[i] = keep + __shfl_xor(send, 8); }
        hi = (lane & 4) != 0;
        { float send = hi ? dk[0] : dk[1]; float keep = hi ? dk[1] : dk[0]; dk[0] = keep + __shfl_xor(send, 4); }
        dk[0] += __shfl_xor(dk[0], 2);
        dk[0] += __shfl_xor(dk[0], 1);
      }
      float wgt = __shfl(gate, (lane >> 2) & 15) * gelu_tanh(dk[0] * (1.f / 256.f)) * (1.f / 64.f);
#pragma unroll
      for (int k = 0; k < 16; k++) {
        float wk = __int_as_float(__builtin_amdgcn_readlane(__float_as_int(wgt), k * 4));
        const f2v wk2 = f2v{wk, wk};
        const uint4 vv = (k < 8) ? vb[k & 7] : vc[k & 7];
        outv[0] += wk2 * __builtin_amdgcn_cvt_pk_f32_fp8((int)vv.x, false); outv[1] += wk2 * __builtin_amdgcn_cvt_pk_f32_fp8((int)vv.x, true);
        outv[2] += wk2 * __builtin_amdgcn_cvt_pk_f32_fp8((int)vv.y, false); outv[3] += wk2 * __builtin_amdgcn_cvt_pk_f32_fp8((int)vv.y, true);
        outv[4] += wk2 * __builtin_amdgcn_cvt_pk_f32_fp8((int)vv.z, false); outv[5] += wk2 * __builtin_amdgcn_cvt_pk_f32_fp8((int)vv.z, true);
        outv[6] += wk2 * __builtin_amdgcn_cvt_pk_f32_fp8((int)vv.w, false); outv[7] += wk2 * __builtin_amdgcn_cvt_pk_f32_fp8((int)vv.w, true);
      }
    }
    float z[16];
    float s = 0.f;
#pragma unroll
    for (int i = 0; i < 8; i++) { z[2 * i] = outv[i][0] + DN_ALPHA * xv[i][0]; z[2 * i + 1] = outv[i][1] + DN_ALPHA * xv[i][1]; s += z[2 * i] + z[2 * i + 1]; }
    s = wsum(s);
    const float mu = s * (1.f / 1024.f);
    float q = 0.f;
#pragma unroll
    for (int i = 0; i < 16; i++) { float d = z[i] - mu; q += d * d; }
    q = wsum(q);
    const float rstd = rsqrtf(q * (1.f / 1024.f) + LN_EPS);
    float y[16];
    const int col = lane * 16;
#pragma unroll
    for (int i4 = 0; i4 < 4; i4++) {
      float4 g = *(const float4*)(gam + col + i4 * 4), b = *(const float4*)(bet + col + i4 * 4);
      y[i4 * 4 + 0] = (z[i4 * 4 + 0] - mu) * rstd * g.x + b.x; y[i4 * 4 + 1] = (z[i4 * 4 + 1] - mu) * rstd * g.y + b.y;
      y[i4 * 4 + 2] = (z[i4 * 4 + 2] - mu) * rstd * g.z + b.z; y[i4 * 4 + 3] = (z[i4 * 4 + 3] - mu) * rstd * g.w + b.w;
    }
    uint4 o0, o1;
    o0.x = pack2(y[0], y[1]); o0.y = pack2(y[2], y[3]); o0.z = pack2(y[4], y[5]); o0.w = pack2(y[6], y[7]);
    o1.x = pack2(y[8], y[9]); o1.y = pack2(y[10], y[11]); o1.z = pack2(y[12], y[13]); o1.w = pack2(y[14], y[15]);
    *(uint4*)(X + (size_t)tok * 1024 + col) = o0;
    *(uint4*)(X + (size_t)tok * 1024 + col + 8) = o1;
  }
}

__device__ __forceinline__ void phase_PLE(KP P, int li, bf16* smem) {
  EPI_VARS
  const bf16* X = (const bf16*)(P->ws + W_X);
  const bf16* PE = (const bf16*)(P->ws + W_PE);
  const bf16* Wg = (const bf16*)(P->ws + W_G);
  const bf16* Wp = (const bf16*)(P->ws + W_P);
  bf16* Z = (bf16*)(P->ws + W_H);
  for (int t = bidx(); t < SWZ_TOTAL(8); t += gdim()) {
    int mt_, nt_;
    if (!tile_swz(t, 8, mt_, nt_)) continue;
    const int m0 = mt_ * 128, n0 = nt_ * 128;
    f32x16 acc[2][2], acc2[2][2];
    zero_acc(acc); zero_acc(acc2);
    {
      const bf16* Ab = X + (size_t)m0 * 1024;
      const bf16* Bb = Wg + (size_t)n0 * 1024;
      gemm_kloop(acc,
        [&](int r, int kc) { return *(const uint4*)(Ab + (size_t)r * 1024 + kc * 8); },
        [&](int r, int kc) { return *(const uint4*)(Bb + (size_t)r * 1024 + kc * 8); }, 0, 16, smem);
    }
    {
      const bf16* Ab = PE + (size_t)m0 * 256;
      const bf16* Bb = Wp + (size_t)n0 * 256;
      gemm_kloop(acc2,
        [&](int r, int kc) { return *(const uint4*)(Ab + (size_t)r * 256 + kc * 8); },
        [&](int r, int kc) { return *(const uint4*)(Bb + (size_t)r * 256 + kc * 8); }, 0, 4, smem);
    }
    EPI_BASE
#pragma unroll
    for (int mi = 0; mi < 2; mi++)
#pragma unroll
      for (int ni = 0; ni < 2; ni++)
#pragma unroll
        for (int r = 0; r < 16; r++) acc[mi][ni][r] = sigmoidf_(acc[mi][ni][r]) * acc2[mi][ni][r];
    epi_rowmajor(acc, smem, [&](int row, int c8, float (&v)[8]) {
      uint4 xr = *(const uint4*)(X + (size_t)(m0 + row) * 1024 + n0 + c8);
      uint4 o;
      o.x = pack2(DN_ALPHA * bflo(xr.x) + v[0], DN_ALPHA * bfhi(xr.x) + v[1]); o.y = pack2(DN_ALPHA * bflo(xr.y) + v[2], DN_ALPHA * bfhi(xr.y) + v[3]);
      o.z = pack2(DN_ALPHA * bflo(xr.z) + v[4], DN_ALPHA * bfhi(xr.z) + v[5]); o.w = pack2(DN_ALPHA * bflo(xr.w) + v[6], DN_ALPHA * bfhi(xr.w) + v[7]);
      *(uint4*)(Z + (size_t)(m0 + row) * 1024 + n0 + c8) = o;
    });
  }
  if (li == 0 && !MULTI_LAUNCH) { int jb, jn; if (light_block(1, jb, jn)) pro_misc(P, 1, (float*)smem, jb, jn); }
}

__device__ __forceinline__ void run_phase(KP P, int li, int k, bf16* smem) {
  switch (k) {
    case PH_PRO: phase_prologue(P, li, smem); break;
    case PH_GIN: phase_gemm_in(P, li, smem); break;
    case PH_A: phase_A(P, li, smem); break;
    case PH_B: phase_B(P, li); break;
    case PH_C: phase_C(P, li, smem); break;
    case PH_D: phase_D(P, li, smem); break;
    case PH_E: phase_E(P, li, smem); break;
    case PH_WO: phase_WO(P, li, smem); break;
    case PH_LN1: phase_LN(P, P->in[I_L1G] + li * 1024, P->in[I_L1B] + li * 1024, false, W_HT); break;
    case PH_PQ: phase_PQ(P, li, smem); break;
    case PH_PEER: phase_PEER(P, li, smem); break;
    case PH_PLE: phase_PLE(P, li, smem); break;
    case PH_LN3: phase_LN(P, P->in[I_L3G] + li * 1024, P->in[I_L3B] + li * 1024, li == 1, W_X); break;
  }
}

#ifndef DUP_MASK
#define DUP_MASK 0
#endif
#define SYNC() xcd_barrier(xb)
#define RUN(k, call) { { KP P = kp_get(); call; } if ((DUP_MASK >> (k)) & 1) { SYNC(); KP P = kp_get(); call; } }
__global__ void __launch_bounds__(256, 2) fwd_kernel(Params Parg) {
  extern __shared__ __attribute__((aligned(16))) unsigned char lds_raw[];
  bf16* smem = (bf16*)lds_raw;
#if MULTI_LAUNCH
  { KP P = kp_get(); run_phase(P, P->pbeg / PH_N, P->pbeg % PH_N, smem); }
#else
  volatile LAS unsigned* st = (volatile LAS unsigned*)(lds_raw + LDS_TILE_BYTES);
  if (threadIdx.x == 0) { st[0] = 0u; st[1] = 0u; st[2] = 0u; st[3] = 0u; }
  __syncthreads();
  XcdBarrier xb;
  { KP P = kp_get(); xb = xcd_barrier_post((unsigned*)(P->ws + W_BAR), st);
    if (P->pad0 == 0x5eed) cg::this_grid().sync();
  }
#pragma unroll 1
  for (int li = 0; li < 2; li++) {
    if (li == 0) { RUN(PH_PRO, phase_prologue(P, li, smem)) SYNC(); }
    RUN(PH_GIN, phase_gemm_in(P, li, smem)) SYNC();
    RUN(PH_A, phase_A(P, li, smem)) SYNC();
    RUN(PH_B, phase_B(P, li)) SYNC();
    RUN(PH_C, phase_C(P, li, smem)) SYNC();
    RUN(PH_D, phase_D(P, li, smem)) SYNC();
    RUN(PH_E, phase_E(P, li, smem)) SYNC();
    RUN(PH_WO, phase_WO(P, li, smem)) SYNC();
    RUN(PH_LN1, phase_LN(P, P->in[I_L1G] + li * 1024, P->in[I_L1B] + li * 1024, false, W_HT)) SYNC();
    RUN(PH_PQ, phase_PQ(P, li, smem)) SYNC();
    RUN(PH_PEER, phase_PEER(P, li, smem)) SYNC();
    RUN(PH_PLE, phase_PLE(P, li, smem)) SYNC();
    RUN(PH_LN3, phase_LN(P, P->in[I_L3G] + li * 1024, P->in[I_L3B] + li * 1024, li == 1, W_X))
    if (li == 0) SYNC();
  }
#endif
}

extern "C" void kernel_launch(void* const* d_in, const int* in_sizes, int n_in, void* d_out, int out_size, void* d_ws,
                              size_t ws_size, hipStream_t stream) {
  static int grid_blocks = 0;
  if (grid_blocks == 0) {
    if (n_in != 38 || (size_t)out_size != O_END || ws_size < WS_END) {
      fprintf(stderr, "kernel_launch: unexpected sizes n_in=%d out=%d ws=%zu need %zu\n", n_in, out_size, ws_size, (size_t)WS_END);
      grid_blocks = -1; return;
    }
    int dev = 0, cus = 0, per_cu = 0;
    hipGetDevice(&dev);
    hipDeviceGetAttribute(&cus, hipDeviceAttributeMultiprocessorCount, dev);
    if (hipFuncSetAttribute((const void*)fwd_kernel, hipFuncAttributeMaxDynamicSharedMemorySize, LDS_BYTES) != hipSuccess) {
      fprintf(stderr, "kernel_launch: hipFuncSetAttribute failed\n"); grid_blocks = -1; return;
    }
    hipOccupancyMaxActiveBlocksPerMultiprocessor(&per_cu, (const void*)fwd_kernel, 256, LDS_BYTES);
    if (per_cu < 1) { fprintf(stderr, "kernel_launch: occupancy query gave %d\n", per_cu); grid_blocks = -1; return; }
    if (per_cu > 2) per_cu = 2;
    grid_blocks = cus * per_cu;
  }
  if (grid_blocks < 0) return;
  Params p{};
  for (int i = 0; i < 38; i++) p.in[i] = (const float*)d_in[i];
  p.out = (float*)d_out;
  p.ws = (unsigned char*)d_ws;
#if MULTI_LAUNCH
  for (int ph = 0; ph < 2 * PH_N; ph++) {
    p.pbeg = ph; p.pend = ph + 1;
    hipLaunchKernelGGL(fwd_kernel, dim3(grid_blocks), dim3(256), LDS_BYTES, stream, p);
  }
#else
  p.pbeg = 0; p.pend = 2 * PH_N;
  if (hipMemsetAsync((char*)d_ws + W_BAR, 0, 16384, stream) != hipSuccess) { fprintf(stderr, "memset failed\n"); return; }
  void* args[] = {&p};
#ifdef PLAIN_LAUNCH
  hipLaunchKernelGGL(fwd_kernel, dim3(grid_blocks), dim3(256), LDS_BYTES, stream, p);
  hipError_t e = hipSuccess; (void)args;
#else
  hipError_t e = hipLaunchCooperativeKernel((const void*)fwd_kernel, dim3(grid_blocks), dim3(256), args, LDS_BYTES, stream);
#endif
  if (e != hipSuccess) fprintf(stderr, "cooperative launch failed: %s (grid %d)\n", hipGetErrorString(e), grid_blocks);
#endif
}
```

```cpp
#include <hip/hip_runtime.h>
#include <hip/hip_cooperative_groups.h>
#include <cstdio>
#include <cstdint>
namespace cg = cooperative_groups;

#ifndef MULTI_LAUNCH
#define MULTI_LAUNCH 0
#endif

typedef unsigned short bf16;
using bf16x8 = __attribute__((ext_vector_type(8))) short;
using f32x16 = __attribute__((ext_vector_type(16))) float;
using f32x4 = __attribute__((ext_vector_type(4))) float;

#define NTOK 17408
#define NPTOK 16384
#define DM 1024
#define INC 5888
#define NCHUNK 272
#define C_USSM 0
#define C_QATT 256
#define C_KATT 768
#define C_VATT 1280
#define C_QRET 1792
#define C_KRET 2048
#define C_VRET 2304
#define C_GRET 2560
#define C_GATE 2816
#define DN_ALPHA 1.41421356237f
#define LN_EPS 1e-5f

constexpr size_t O_YP = 0;
constexpr size_t O_YS = O_YP + 4ull * 4096 * 1024;
constexpr size_t O_SRE_P = O_YS + 16ull * 64 * 1024;
constexpr size_t O_SIM_P = O_SRE_P + 2 * 4 * 16 * 64;
constexpr size_t O_AK_P = O_SIM_P + 2 * 4 * 16 * 64;
constexpr size_t O_AV_P = O_AK_P + 2ull * 4 * 512 * 512;
constexpr size_t O_RET_P = O_AV_P + 2ull * 4 * 512 * 512;
constexpr size_t O_SRE_S = O_RET_P + 2 * 4 * 4 * 4096;
constexpr size_t O_SIM_S = O_SRE_S + 2 * 16 * 16 * 64;
constexpr size_t O_AK_S = O_SIM_S + 2 * 16 * 16 * 64;
constexpr size_t O_AV_S = O_AK_S + 2ull * 16 * 64 * 512;
constexpr size_t O_RET_S = O_AV_S + 2ull * 16 * 64 * 512;
constexpr size_t O_END = O_RET_S + 2ull * 16 * 4 * 4096;

constexpr size_t W_IN = 0;
constexpr size_t W_BRS = W_IN + 5888ull * 1024 * 2;
constexpr size_t W_BRA = W_BRS + 1024ull * 256 * 2;
constexpr size_t W_BRR = W_BRA + 1024ull * 512 * 2;
constexpr size_t W_O = W_BRR + 1024ull * 256 * 2;
constexpr size_t W_QK = W_O + 1024ull * 1024 * 2;
constexpr size_t W_G = W_QK + 2048ull * 1024 * 2;
constexpr size_t W_P = W_G + 1024ull * 1024 * 2;
constexpr size_t W_GLU = W_P + 1024ull * 256 * 2;
constexpr size_t W_U = W_GLU + 256ull * 256 * 2;
constexpr size_t W_V = W_U + 16384ull * 1024 * 2;
constexpr size_t W_TT = W_V + 16384ull * 1024 * 2;
#define KERN_ELEMS (16 * 64 * 256)
constexpr size_t W_BST = W_TT + 16ull * 1024 * 1152 * 2;
constexpr size_t W_ROPE = W_BST + 16ull * 128 * 1024 * 2;
constexpr size_t W_X = W_ROPE + 4096ull * 32 * 8;
constexpr size_t W_PE = W_X + (size_t)NTOK * 1024 * 2;
constexpr size_t W_H = W_PE + (size_t)NTOK * 256 * 2;
constexpr size_t W_HT = W_H + (size_t)NTOK * 5888 * 2;
constexpr size_t W_YSSM = W_HT + 1024ull * NTOK * 2;
constexpr size_t W_YATT = W_YSSM + (size_t)NTOK * 256 * 2;
constexpr size_t W_YRET = W_YATT + (size_t)NTOK * 512 * 2;
constexpr size_t W_CK = W_YRET + (size_t)NTOK * 256 * 2;
constexpr size_t W_CVT = W_CK + 16ull * 512 * 512 * 2;
constexpr size_t W_CT = W_CVT + 16ull * 512 * 512 * 2;
constexpr size_t W_SPREV = W_CT + 272ull * 4 * 4096 * 4;
constexpr size_t W_SC = W_SPREV + 272ull * 4 * 4096 * 2;
constexpr size_t W_HS = W_SC + 272ull * 16 * 128 * 4;
constexpr size_t W_BAR = W_HS + 272ull * 16 * 128 * 2;
constexpr size_t WS_END = W_BAR + 16384;

#define LDS_TILE_BYTES 73728
#define LDS_BYTES (73728 + 16)
#define LDS_ROW 72
#define STAGE_ELEMS (128 * LDS_ROW)

struct Params {
  const float* in[38];
  float* out;
  unsigned char* ws;
  int pbeg, pend;
  int pad0, pad1;
};

typedef const __attribute__((address_space(4))) Params* KP;
__device__ __forceinline__ KP kp_get() { KP p = (KP)__builtin_amdgcn_kernarg_segment_ptr(); asm volatile("" : "+s"(p)); return p; }

enum { I_XP = 0, I_XS, I_PP, I_PS, I_SRE, I_SIM, I_CK, I_CV, I_SRET, I_WIN, I_LRE, I_LIM, I_BRE, I_BIM, I_CRE, I_CIM,
       I_LDT, I_SD, I_WGLU, I_BGLU, I_BIAS, I_GNG, I_WBS, I_WBA, I_WBR, I_WO, I_L1G, I_L1B, I_WQ, I_KEYS, I_PU, I_PV,
       I_L2G, I_L2B, I_WG, I_WP, I_L3G, I_L3B };

enum { PH_PRO = 0, PH_GIN, PH_A, PH_B, PH_C, PH_D, PH_E, PH_WO, PH_LN1, PH_PQ, PH_PEER, PH_PLE, PH_LN3, PH_N };

__device__ __forceinline__ bf16 f2bf(float f) {
  unsigned u = __float_as_uint(f);
  u += 0x7fffu + ((u >> 16) & 1u);
  return (bf16)(u >> 16);
}
__device__ __forceinline__ float bf2f(bf16 h) { return __uint_as_float(((unsigned)h) << 16); }
__device__ __forceinline__ unsigned pack2(float a, float b) { return (unsigned)f2bf(a) | ((unsigned)f2bf(b) << 16); }
__device__ __forceinline__ float bflo(unsigned u) { return __uint_as_float(u << 16); }
__device__ __forceinline__ float bfhi(unsigned u) { return __uint_as_float(u & 0xffff0000u); }
__device__ __forceinline__ float sigmoidf_(float x) { return __builtin_amdgcn_rcpf(1.f + __expf(-x)); }
__device__ __forceinline__ float gelu_tanh(float x) {
  float y = 0.7978845608028654f * (x + 0.044715f * x * x * x);
  float t = 1.f - 2.f * __builtin_amdgcn_rcpf(1.f + __expf(2.f * y));
  return 0.5f * x * (1.f + t);
}
__device__ __forceinline__ bf16x8 u4_to_frag(uint4 u) {
  union { uint4 u; bf16x8 f; } c; c.u = u; return c.f;
}
template <class T>
__device__ __forceinline__ T* launder(T* p) { asm volatile("" : "+s"(p)); return p; }
__device__ __forceinline__ int opaque(int v) { asm volatile("" : "+v"(v)); return v; }
__device__ __forceinline__ int bidx() { int v = blockIdx.x; asm volatile("" : "+s"(v)); return v; }
__device__ __forceinline__ int gdim() { int v = gridDim.x; asm volatile("" : "+s"(v)); return v; }
__device__ __forceinline__ int tidx() { int v = threadIdx.x; asm volatile("" : "+v"(v)); return v; }
__device__ __forceinline__ float wsum(float v) {
#pragma unroll
  for (int o = 32; o >= 1; o >>= 1) v += __shfl_xor(v, o);
  return v;
}


#define XB_TMO      128
#define XB_XCNT(j)  (256  + 64 * (j))
#define XB_XSUB(j)  (1280 + 64 * (j))
#define XB_XGEN(j)  (2304 + 64 * (j))
#define XB_TOP      3328
#define XB_TOPGEN   3392
#define XCD_BAR_WORDS 3456
#define XB_SPIN_CAP (1u << 20)
#define LAS __attribute__((address_space(3)))
__device__ __forceinline__ unsigned xb_ld(unsigned* p)              { return __hip_atomic_load(p, __ATOMIC_RELAXED, __HIP_MEMORY_SCOPE_AGENT); }
__device__ __forceinline__ unsigned xb_add(unsigned* p, unsigned v) { return __hip_atomic_fetch_add(p, v, __ATOMIC_RELAXED, __HIP_MEMORY_SCOPE_AGENT); }
__device__ __forceinline__ unsigned xb_xcc_id() { return (unsigned)__builtin_amdgcn_s_getreg((3 << 11) | 20) & 0xFu; }
#define XB_SPIN(cond, bar) do { unsigned _sp = 0; while (cond) { __builtin_amdgcn_s_sleep(1); \
    if ((++_sp & 255u) == 0u) { if (xb_ld(&(bar)[XB_TMO])) break; if (_sp > XB_SPIN_CAP) { atomicAdd(&(bar)[XB_TMO], 1u); break; } } } } while (0)
struct XcdBarrier { unsigned* bar; unsigned x; volatile LAS unsigned* st; };
__device__ __forceinline__ XcdBarrier xcd_barrier_post(unsigned* bar, volatile LAS unsigned* st) {
    XcdBarrier b; b.bar = bar; b.x = xb_xcc_id(); b.st = st;
    if (threadIdx.x == 0) (void)xb_add(&bar[XB_XCNT(b.x)], 1u);
    return b;
}
__device__ __forceinline__ void xcd_barrier_complete(unsigned* bar, unsigned x, unsigned& nloc, unsigned& nx) {
    const unsigned G = gridDim.x * gridDim.y * gridDim.z;
    unsigned sum, cnt, mine, sp = 0u;
    for (;;) {
        sum = 0u; cnt = 0u; mine = 0u;
#pragma unroll
        for (unsigned j = 0; j < 16; ++j) { const unsigned c = xb_ld(&bar[XB_XCNT(j)]); sum += c; cnt += (c > 0u) ? 1u : 0u; mine = (j == x) ? c : mine; }
        if (sum == G) break;
        __builtin_amdgcn_s_sleep(1);
        if ((++sp & 255u) == 0u) { if (xb_ld(&bar[XB_TMO])) break; if (sp > XB_SPIN_CAP) { atomicAdd(&bar[XB_TMO], 1u); break; } }
    }
    nloc = mine > 0u ? mine : 1u; nx = cnt > 0u ? cnt : 1u;
}
__device__ __forceinline__ void xcd_barrier(const XcdBarrier& b) {
    asm volatile("s_waitcnt vmcnt(0)" ::: "memory");
    __syncthreads();
    if (threadIdx.x == 0) {
        unsigned* bar = b.bar;
        __builtin_amdgcn_s_waitcnt(0);
        unsigned nloc = b.st[0], nx = b.st[1];
        if (nloc == 0u) { xcd_barrier_complete(bar, b.x, nloc, nx); b.st[0] = nloc; b.st[1] = nx; }
        const unsigned old = xb_add(&bar[XB_XSUB(b.x)], 1u);
        const unsigned gen = old / nloc;
        if (old + 1u == (gen + 1u) * nloc) {
            __builtin_amdgcn_fence(__ATOMIC_RELEASE, "agent");
            asm volatile("s_waitcnt vmcnt(0)" ::: "memory");
            const unsigned og = xb_add(&bar[XB_TOP], 1u);
            const unsigned tg = og / nx;
            if (og + 1u == (tg + 1u) * nx) xb_add(&bar[XB_TOPGEN], 1u);
            else XB_SPIN(xb_ld(&bar[XB_TOPGEN]) == tg, bar);
            __builtin_amdgcn_fence(__ATOMIC_ACQUIRE, "agent");
            xb_add(&bar[XB_XGEN(b.x)], 1u);
            asm volatile("s_waitcnt vmcnt(0)" ::: "memory");
        } else {
            XB_SPIN(xb_ld(&bar[XB_XGEN(b.x)]) == gen, bar);
            __builtin_amdgcn_fence(__ATOMIC_ACQUIRE, "agent");
            asm volatile("s_waitcnt vmcnt(0)" ::: "memory");
        }
    }
    __syncthreads();
}

__device__ __forceinline__ void gemm_compute_stage(f32x16 (&acc)[2][2], const bf16* Ac, const bf16* Bc, int wm, int wn, int lane) {
#pragma unroll
  for (int kk = 0; kk < 4; kk++) {
    bf16x8 a[2], b[2];
#pragma unroll
    for (int mi = 0; mi < 2; mi++) a[mi] = *(const bf16x8*)(Ac + (wm * 64 + mi * 32 + (lane & 31)) * LDS_ROW + kk * 16 + (lane >> 5) * 8);
#pragma unroll
    for (int ni = 0; ni < 2; ni++) b[ni] = *(const bf16x8*)(Bc + (wn * 64 + ni * 32 + (lane & 31)) * LDS_ROW + kk * 16 + (lane >> 5) * 8);
#pragma unroll
    for (int mi = 0; mi < 2; mi++)
#pragma unroll
      for (int ni = 0; ni < 2; ni++) acc[mi][ni] = __builtin_amdgcn_mfma_f32_32x32x16_bf16(a[mi], b[ni], acc[mi][ni], 0, 0, 0);
  }
}

template <class AL, class BL>
__device__ __forceinline__ void gemm_kloop(f32x16 (&acc)[2][2], AL aload, BL bload, int kt0, int nkt, bf16* smem) {
  const int tid = tidx(), lane = tid & 63, w = tid >> 6;
  const int wm = w >> 1, wn = w & 1;
  const int lr = tid >> 3, lc = tid & 7;
  uint4 a0[4], b0[4], a1[4], b1[4];
  bf16* const buf0 = smem;
  bf16* const buf1 = smem + 2 * STAGE_ELEMS;
#define KL_LOAD(A_, B_, st) { _Pragma("unroll") for (int i = 0; i < 4; i++) { A_[i] = aload(lr + 32 * i, (kt0 + (st)) * 8 + lc); B_[i] = bload(lr + 32 * i, (kt0 + (st)) * 8 + lc); } }
#define KL_STORE(A_, B_, buf) { _Pragma("unroll") for (int i = 0; i < 4; i++) { \
    *(uint4*)((buf) + (lr + 32 * i) * LDS_ROW + lc * 8) = A_[i]; *(uint4*)((buf) + STAGE_ELEMS + (lr + 32 * i) * LDS_ROW + lc * 8) = B_[i]; } }
  KL_LOAD(a0, b0, 0)
  KL_STORE(a0, b0, buf0)
  if (nkt > 1) KL_LOAD(a0, b0, 1)
  if (nkt > 2) KL_LOAD(a1, b1, 2)
  __syncthreads();
  int kt = 0;
  for (; kt + 4 < nkt; kt += 2) {
    KL_STORE(a0, b0, buf1)
    KL_LOAD(a0, b0, kt + 3)
    gemm_compute_stage(acc, buf0, buf0 + STAGE_ELEMS, wm, wn, lane);
    __syncthreads();
    KL_STORE(a1, b1, buf0)
    KL_LOAD(a1, b1, kt + 4)
    gemm_compute_stage(acc, buf1, buf1 + STAGE_ELEMS, wm, wn, lane);
    __syncthreads();
  }
  for (; kt < nkt; kt += 2) {
    if (kt + 1 < nkt) KL_STORE(a0, b0, buf1)
    if (kt + 3 < nkt) KL_LOAD(a0, b0, kt + 3)
    gemm_compute_stage(acc, buf0, buf0 + STAGE_ELEMS, wm, wn, lane);
    __syncthreads();
    if (kt + 1 >= nkt) break;
    if (kt + 2 < nkt) KL_STORE(a1, b1, buf0)
    if (kt + 4 < nkt) KL_LOAD(a1, b1, kt + 4)
    gemm_compute_stage(acc, buf1, buf1 + STAGE_ELEMS, wm, wn, lane);
    __syncthreads();
  }
#undef KL_LOAD
#undef KL_STORE
}

#define TL_ROW 40
#define TL_STAGE (384 * TL_ROW)
__device__ __forceinline__ void gemm_tall_compute(f32x16 (&acc)[2][2][2], const bf16* St, int wm, int wn, int lane) {
  const bf16* Ac = St; const bf16* Bc = St + 256 * TL_ROW;
#pragma unroll
  for (int kk = 0; kk < 2; kk++) {
    bf16x8 a[2][2], b[2];
#pragma unroll
    for (int h = 0; h < 2; h++)
#pragma unroll
      for (int mi = 0; mi < 2; mi++) a[h][mi] = *(const bf16x8*)(Ac + (h * 128 + wm * 64 + mi * 32 + (lane & 31)) * TL_ROW + kk * 16 + (lane >> 5) * 8);
#pragma unroll
    for (int ni = 0; ni < 2; ni++) b[ni] = *(const bf16x8*)(Bc + (wn * 64 + ni * 32 + (lane & 31)) * TL_ROW + kk * 16 + (lane >> 5) * 8);
#pragma unroll
    for (int h = 0; h < 2; h++)
#pragma unroll
      for (int mi = 0; mi < 2; mi++)
#pragma unroll
        for (int ni = 0; ni < 2; ni++) acc[h][mi][ni] = __builtin_amdgcn_mfma_f32_32x32x16_bf16(a[h][mi], b[ni], acc[h][mi][ni], 0, 0, 0);
  }
}
template <class AL, class BL>
__device__ __forceinline__ void gemm_kloop_tall(f32x16 (&acc)[2][2][2], AL aload, BL bload, int nkt, bf16* smem) {
  const int tid = tidx(), lane = tid & 63, w = tid >> 6;
  const int wm = w >> 1, wn = w & 1;
  const int lr = tid >> 2, lc = tid & 3;
  uint4 a0[4], b0[2], a1[4], b1[2];
  bf16* const buf0 = smem;
  bf16* const buf1 = smem + TL_STAGE;
#define TL_LOAD(A_, B_, st) { _Pragma("unroll") for (int i = 0; i < 4; i++) A_[i] = aload(lr + 64 * i, (st) * 4 + lc); \
                              _Pragma("unroll") for (int i = 0; i < 2; i++) B_[i] = bload(lr + 64 * i, (st) * 4 + lc); }
#define TL_STORE(A_, B_, buf) { _Pragma("unroll") for (int i = 0; i < 4; i++) *(uint4*)((buf) + (lr + 64 * i) * TL_ROW + lc * 8) = A_[i]; \
                                _Pragma("unroll") for (int i = 0; i < 2; i++) *(uint4*)((buf) + (256 + lr + 64 * i) * TL_ROW + lc * 8) = B_[i]; }
  TL_LOAD(a0, b0, 0)
  TL_STORE(a0, b0, buf0)
  if (nkt > 1) TL_LOAD(a0, b0, 1)
  if (nkt > 2) TL_LOAD(a1, b1, 2)
  __syncthreads();
  int kt = 0;
  for (; kt + 4 < nkt; kt += 2) {
    TL_STORE(a0, b0, buf1)
    TL_LOAD(a0, b0, kt + 3)
    gemm_tall_compute(acc, buf0, wm, wn, lane);
    __syncthreads();
    TL_STORE(a1, b1, buf0)
    TL_LOAD(a1, b1, kt + 4)
    gemm_tall_compute(acc, buf1, wm, wn, lane);
    __syncthreads();
  }
  for (; kt < nkt; kt += 2) {
    if (kt + 1 < nkt) TL_STORE(a0, b0, buf1)
    if (kt + 3 < nkt) TL_LOAD(a0, b0, kt + 3)
    gemm_tall_compute(acc, buf0, wm, wn, lane);
    __syncthreads();
    if (kt + 1 >= nkt) break;
    if (kt + 2 < nkt) TL_STORE(a1, b1, buf0)
    if (kt + 4 < nkt) TL_LOAD(a1, b1, kt + 4)
    gemm_tall_compute(acc, buf1, wm, wn, lane);
    __syncthreads();
  }
#undef TL_LOAD
#undef TL_STORE
}

template <class AL, class BL>
__device__ __forceinline__ void gemm_kloop_light(f32x16 (&acc)[2][2], AL aload, BL bload, int kt0, int nkt, bf16* smem) {
  const int tid = tidx(), lane = tid & 63, w = tid >> 6;
  const int wm = w >> 1, wn = w & 1;
  const int lr = tid >> 3, lc = tid & 7;
  uint4 a0[4], b0[4];
#define KL_LOAD(A_, B_, st) { _Pragma("unroll") for (int i = 0; i < 4; i++) { A_[i] = aload(lr + 32 * i, (kt0 + (st)) * 8 + lc); B_[i] = bload(lr + 32 * i, (kt0 + (st)) * 8 + lc); } }
#define KL_STORE(A_, B_, buf) { _Pragma("unroll") for (int i = 0; i < 4; i++) { \
    *(uint4*)((buf) + (lr + 32 * i) * LDS_ROW + lc * 8) = A_[i]; *(uint4*)((buf) + STAGE_ELEMS + (lr + 32 * i) * LDS_ROW + lc * 8) = B_[i]; } }
  KL_LOAD(a0, b0, 0)
  KL_STORE(a0, b0, smem)
  if (nkt > 1) KL_LOAD(a0, b0, 1)
  __syncthreads();
  for (int kt = 0; kt < nkt; kt++) {
    bf16* cur = smem + (kt & 1) * 2 * STAGE_ELEMS;
    bf16* nxt = smem + ((kt + 1) & 1) * 2 * STAGE_ELEMS;
    if (kt + 1 < nkt) KL_STORE(a0, b0, nxt)
    if (kt + 2 < nkt) KL_LOAD(a0, b0, kt + 2)
    gemm_compute_stage(acc, cur, cur + STAGE_ELEMS, wm, wn, lane);
    __syncthreads();
  }
#undef KL_LOAD
#undef KL_STORE
}

__device__ __forceinline__ void zero_acc(f32x16 (&acc)[2][2]) {
#pragma unroll
  for (int mi = 0; mi < 2; mi++)
#pragma unroll
    for (int ni = 0; ni < 2; ni++)
#pragma unroll
      for (int r = 0; r < 16; r++) acc[mi][ni][r] = 0.f;
}

#define EPI_ROW(mi, r) (erb + (mi) * 32 + ((r) & 3) + 8 * ((r) >> 2))
#define EPI_BASE int erb = opaque(wm * 64 + 4 * (lane >> 5));
#define EPI_COL(ni) (wn * 64 + (ni) * 32 + (lane & 31))
#define EPI_VARS const int lane = tidx() & 63, w = tidx() >> 6, wm = w >> 1, wn = w & 1;


#define CS_LD 132
template <class F>
__device__ __forceinline__ void epi_rowmajor(const f32x16 (&acc)[2][2], bf16* smem, F f) {
  const int tid = tidx(), lane = tid & 63, w = tid >> 6, wm = w >> 1, wn = w & 1;
  float* Cs = (float*)smem;
#pragma unroll
  for (int mi = 0; mi < 2; mi++)
#pragma unroll
    for (int ni = 0; ni < 2; ni++)
#pragma unroll
      for (int r = 0; r < 16; r++) {
        int row = wm * 64 + mi * 32 + (r & 3) + 8 * (r >> 2) + 4 * (lane >> 5), col = wn * 64 + ni * 32 + (lane & 31);
        Cs[row * CS_LD + col] = acc[mi][ni][r];
      }
  __syncthreads();
#pragma unroll
  for (int it = 0; it < 8; it++) {
    int ch = tid + 256 * it;
    int row = ch >> 4, c8 = (ch & 15) * 8;
    float4 a = *(const float4*)(Cs + row * CS_LD + c8), b = *(const float4*)(Cs + row * CS_LD + c8 + 4);
    float v[8] = {a.x, a.y, a.z, a.w, b.x, b.y, b.z, b.w};
    f(row, c8, v);
  }
  __syncthreads();
}


__device__ __forceinline__ bool tile_swz(int t, int NT, int& mt, int& nt) {
  const int SN = (NT + 7) >> 3;
  {
    const int full = (16 * SN / 8) * 512;
    if ((16 * SN) % 8 == 0 && t >= full) {
      const int x8 = t & 7, jl = (t - full) >> 3;
      mt = 128 + x8; nt = jl;
      return jl < NT;
    }
  }
  const int x = t & 7, q = t >> 3;
  const int sidx = (q >> 6) * 8 + x, loc = q & 63;
  const int sm = sidx / SN, sn = sidx - sm * SN;
  mt = sm * 8 + (loc >> 3); nt = sn * 8 + (loc & 7);
  return (mt < 136) && (nt < NT);
}
#define SWZ_TOTAL(NT) (((17 * (((NT) + 7) >> 3) + 7) >> 3) * 512)

__device__ __forceinline__ void transpose_tile(const float* __restrict__ src, int ldsrc, bf16* __restrict__ dst, int lddst, int k0, int n0, float* lds) {
  const int tid = tidx();
  const int tx = tid & 15, ty = tid >> 4;
#pragma unroll
  for (int i = 0; i < 4; i++) {
    int k = ty + 16 * i;
    float4 v = *(const float4*)(src + (size_t)(k0 + k) * ldsrc + n0 + tx * 4);
    lds[k * 65 + tx * 4 + 0] = v.x; lds[k * 65 + tx * 4 + 1] = v.y; lds[k * 65 + tx * 4 + 2] = v.z; lds[k * 65 + tx * 4 + 3] = v.w;
  }
  __syncthreads();
#pragma unroll
  for (int i = 0; i < 2; i++) {
    int ch = tid + 256 * i;
    int n = ch >> 3, kc = (ch & 7) * 8;
    uint4 o;
    o.x = pack2(lds[(kc + 0) * 65 + n], lds[(kc + 1) * 65 + n]); o.y = pack2(lds[(kc + 2) * 65 + n], lds[(kc + 3) * 65 + n]);
    o.z = pack2(lds[(kc + 4) * 65 + n], lds[(kc + 5) * 65 + n]); o.w = pack2(lds[(kc + 6) * 65 + n], lds[(kc + 7) * 65 + n]);
    *(uint4*)(dst + (size_t)(n0 + n) * lddst + k0 + kc) = o;
  }
  __syncthreads();
}

__device__ __forceinline__ void transpose_job(const float* src, bf16* dst, int K, int N, int batch, float* lds, int jb, int jn) {
  const int tk = K / 64, tn = N / 64;
  const int ntiles = tk * tn * batch;
  for (int t = jb; t < ntiles; t += jn) {
    int b = t / (tk * tn), r = t % (tk * tn);
    int kt = r / tn, nt = r % tn;
    transpose_tile(src + (size_t)b * K * N, N, dst + (size_t)b * K * N, K, kt * 64, nt * 64, lds);
  }
}

__device__ __forceinline__ void convert_job(const float* __restrict__ src, bf16* __restrict__ dst, size_t n, int jb, int jn) {
  size_t n8 = n / 8;
#pragma unroll 4
  for (size_t i = (size_t)jb * 256 + tidx(); i < n8; i += (size_t)jn * 256) {
    float4 a = ((const float4*)src)[2 * i], b = ((const float4*)src)[2 * i + 1];
    uint4 o;
    o.x = pack2(a.x, a.y); o.y = pack2(a.z, a.w); o.z = pack2(b.x, b.y); o.w = pack2(b.z, b.w);
    ((uint4*)dst)[i] = o;
  }
}

__device__ __forceinline__ void convert_fp8_job(const float* __restrict__ src, unsigned char* __restrict__ dst, size_t n, float scale, int jb, int jn) {
  size_t n16 = n / 16;
#pragma unroll 2
  for (size_t i = (size_t)jb * 256 + tidx(); i < n16; i += (size_t)jn * 256) {
    const float4* sp = (const float4*)src + 4 * i;
    unsigned o[4];
#pragma unroll
    for (int q = 0; q < 4; q++) {
      float4 a = sp[q];
      float f0 = fminf(fmaxf(a.x * scale, -448.f), 448.f), f1 = fminf(fmaxf(a.y * scale, -448.f), 448.f);
      float f2 = fminf(fmaxf(a.z * scale, -448.f), 448.f), f3 = fminf(fmaxf(a.w * scale, -448.f), 448.f);
      int wv = 0;
      wv = __builtin_amdgcn_cvt_pk_fp8_f32(f0, f1, wv, false);
      wv = __builtin_amdgcn_cvt_pk_fp8_f32(f2, f3, wv, true);
      o[q] = (unsigned)wv;
    }
    ((uint4*)dst)[i] = make_uint4(o[0], o[1], o[2], o[3]);
  }
}

__device__ __forceinline__ bool light_block(int heavy_x, int& jb, int& jn) {
  const int b = bidx(), g = gdim();
  if ((g & 7) || g < 128) { jb = b; jn = g; return true; }
  {
    const int nh = heavy_x == 1 ? 8 : 16;
    const int jl = b >> 3;
    jn = ((g >> 3) - nh) * 8;
    jb = (jl - nh) * 8 + (b & 7);
    return jl >= nh;
  }
  const int x = b & 7;
  jn = (g >> 3) * (8 - heavy_x);
  jb = (b >> 3) * (8 - heavy_x) + (x - heavy_x);
  return x >= heavy_x;
}

__device__ __forceinline__ void wqk_job(const float* __restrict__ wq, const float* __restrict__ keys, bf16* __restrict__ dst, float* lds, int jb, int jn) {
  float* Ks = lds;
  float* Ws = lds + 64 * 129;
  const int tid = tidx();
  for (int t = jb; t < 32 * 16; t += jn) {
    int n0 = (t / 16) * 64, k0 = (t % 16) * 64;
    int hs = n0 / 128, key0 = n0 % 128;
    for (int i = tid; i < 64 * 128; i += 256) {
      int r = i / 128, d = i % 128;
      Ks[r * 129 + d] = keys[((size_t)hs * 128 + key0 + r) * 128 + d];
      Ws[r * 129 + d] = wq[(size_t)(k0 + r) * 2048 + hs * 128 + d];
    }
    __syncthreads();
    int tx = tid & 15, ty = tid >> 4;
    float acc[4][4];
#pragma unroll
    for (int i = 0; i < 4; i++)
#pragma unroll
      for (int j = 0; j < 4; j++) acc[i][j] = 0.f;
    for (int d = 0; d < 128; d++) {
      float kv[4], wv[4];
#pragma unroll
      for (int i = 0; i < 4; i++) { kv[i] = Ks[(ty * 4 + i) * 129 + d]; wv[i] = Ws[(tx * 4 + i) * 129 + d]; }
#pragma unroll
      for (int i = 0; i < 4; i++)
#pragma unroll
        for (int j = 0; j < 4; j++) acc[i][j] += kv[i] * wv[j];
    }
#pragma unroll
    for (int i = 0; i < 4; i++) {
      uint2 o; o.x = pack2(acc[i][0], acc[i][1]); o.y = pack2(acc[i][2], acc[i][3]);
      *(uint2*)(dst + (size_t)(n0 + ty * 4 + i) * 1024 + k0 + tx * 4) = o;
    }
    __syncthreads();
  }
}

__device__ __forceinline__ void ssm_tables(KP P, int li, float* lds, int jb, int jn) {
  const float* lam_re = P->in[I_LRE] + li * 1024;
  const float* lam_im = P->in[I_LIM] + li * 1024;
  const float* b_re = P->in[I_BRE] + (size_t)li * 16 * 64 * 16;
  const float* b_im = P->in[I_BIM] + (size_t)li * 16 * 64 * 16;
  const float* c_re = P->in[I_CRE] + (size_t)li * 16 * 16 * 64;
  const float* c_im = P->in[I_CIM] + (size_t)li * 16 * 16 * 64;
  const float* log_dt = P->in[I_LDT] + li * 16;
  bf16* Tt = (bf16*)(P->ws + W_TT);
  bf16* Bst = (bf16*)(P->ws + W_BST);
  float* wr = lds; float* wi = lds + 64;
  const int tid = tidx();
  const int NT1 = 16 * 64, NT2 = 16 * 64, NT3 = 16 * 64;
  for (int t = jb; t < NT1 + NT2 + NT3; t += jn) {
    int kind, g, idx;
    if (t < NT1) { kind = 0; g = t / 64; idx = t % 64; }
    else if (t < NT1 + NT2) { kind = 1; g = (t - NT1) / 64; idx = (t - NT1) % 64; }
    else { kind = 2; g = (t - NT1 - NT2) / 64; idx = (t - NT1 - NT2) % 64; }
    int d = (kind == 0) ? idx : (kind == 1 ? idx + 1 : 63 - idx);
    const bool need_coef = (kind != 1);
    if (tid < 64) {
      int n = tid;
      float dt = expf(log_dt[g]);
      float lr = lam_re[g * 64 + n], lim = lam_im[g * 64 + n];
      float ar = lr * dt, ai = lim * dt;
      float dd = (float)(d < 0 ? 0 : d);
      float mag = expf(ar * dd);
      float sn, cs;
      sincosf(ai * dd, &sn, &cs);
      float pr = mag * cs, pi = mag * sn;
      if (need_coef) {
        float m1 = expf(ar); float s1, c1; sincosf(ai, &s1, &c1);
        float nr = m1 * c1 - 1.f, ni = m1 * s1;
        float den = lr * lr + lim * lim;
        float cr = (nr * lr + ni * lim) / den, ci = (ni * lr - nr * lim) / den;
        float xr = pr * cr - pi * ci, xi = pr * ci + pi * cr;
        pr = xr; pi = xi;
      }
      wr[n] = pr; wi[n] = pi;
    }
    __syncthreads();
    if (kind == 0) {
      int p = tid >> 4, q = tid & 15;
      if (d >= 0) {
        float* lcr = lds + 128; float* lci = lcr + 1024; float* lbr = lci + 1024; float* lbi = lbr + 1024;
        for (int i = tid; i < 1024; i += 256) {
          lcr[i] = c_re[(size_t)g * 1024 + i]; lci[i] = c_im[(size_t)g * 1024 + i];
          lbr[i] = b_re[(size_t)g * 1024 + i]; lbi[i] = b_im[(size_t)g * 1024 + i];
        }
        __syncthreads();
        float s = 0.f;
#pragma unroll 8
        for (int n = 0; n < 64; n++) {
          float cr = lcr[p * 64 + n], ci = lci[p * 64 + n];
          float xr = cr * wr[n] - ci * wi[n], xi = cr * wi[n] + ci * wr[n];
          float br = lbr[n * 16 + q], bi = lbi[n * 16 + q];
          s += xr * br - xi * bi;
        }
        Tt[(((size_t)g * 64 + d) * 16 + p) * 16 + q] = f2bf(s);
      }
    } else if (kind == 1) {
      int tt = idx;
      for (int i = tid; i < 2048; i += 256) {
        int p = i >> 7, nn = i & 127, n = nn >> 1, ri = nn & 1;
        float cr = c_re[((size_t)g * 16 + p) * 64 + n], ci = c_im[((size_t)g * 16 + p) * 64 + n];
        float v = ri == 0 ? (cr * wr[n] - ci * wi[n]) : -(cr * wi[n] + ci * wr[n]);
        Tt[KERN_ELEMS + ((size_t)g * 1024 + tt * 16 + p) * 128 + nn] = f2bf(v);
      }
    } else {
      int ss = idx;
      for (int i = tid; i < 2048; i += 256) {
        int nn = i >> 4, q = i & 15, n = nn >> 1, ri = nn & 1;
        float br = b_re[((size_t)g * 64 + n) * 16 + q], bi = b_im[((size_t)g * 64 + n) * 16 + q];
        float v = ri == 0 ? (wr[n] * br - wi[n] * bi) : (wr[n] * bi + wi[n] * br);
        Bst[((size_t)g * 128 + nn) * 1024 + ss * 16 + q] = f2bf(v);
      }
    }
    __syncthreads();
  }
}

__device__ __forceinline__ void pro_misc(KP P, int li, float* lds, int jb, int jn) {
  unsigned char* ws = P->ws;
  transpose_job(P->in[I_WIN] + (size_t)li * 1024 * 5888, (bf16*)(ws + W_IN), 1024, 5888, 1, lds, jb, jn);
  transpose_job(P->in[I_WBS] + (size_t)li * 256 * 1024, (bf16*)(ws + W_BRS), 256, 1024, 1, lds, jb, jn);
  transpose_job(P->in[I_WBA] + (size_t)li * 512 * 1024, (bf16*)(ws + W_BRA), 512, 1024, 1, lds, jb, jn);
  transpose_job(P->in[I_WBR] + (size_t)li * 256 * 1024, (bf16*)(ws + W_BRR), 256, 1024, 1, lds, jb, jn);
  transpose_job(P->in[I_WO] + (size_t)li * 1024 * 1024, (bf16*)(ws + W_O), 1024, 1024, 1, lds, jb, jn);
  transpose_job(P->in[I_WGLU] + (size_t)li * 256 * 256, (bf16*)(ws + W_GLU), 256, 256, 1, lds, jb, jn);
  wqk_job(P->in[I_WQ] + (size_t)li * 1024 * 2048, P->in[I_KEYS] + (size_t)li * 16 * 128 * 128, (bf16*)(ws + W_QK), lds, jb, jn);
  ssm_tables(P, li, lds, jb, jn);
}
__device__ __forceinline__ void pro_cache(KP P, int li, float* lds, int jb, int jn) {
  unsigned char* ws = P->ws;
  transpose_job(P->in[I_CV] + (size_t)li * 16 * 512 * 512, (bf16*)(ws + W_CVT), 512, 512, 16, lds, jb, jn);
  convert_job(P->in[I_CK] + (size_t)li * 16 * 512 * 512, (bf16*)(ws + W_CK), 16ull * 512 * 512, jb, jn);
}

__device__ __forceinline__ void phase_prologue(KP P, int li, bf16* smem) {
  float* lds = (float*)smem;
  unsigned char* ws = P->ws;
  pro_misc(P, li, lds, bidx(), gdim());
  pro_cache(P, li, lds, bidx(), gdim());
  if (li == 0) {
    convert_job(P->in[I_XP], (bf16*)(ws + W_X), (size_t)NPTOK * 1024, bidx(), gdim());
    convert_job(P->in[I_XS], (bf16*)(ws + W_X) + (size_t)NPTOK * 1024, 1024ull * 1024, bidx(), gdim());
    float2* rope = (float2*)(ws + W_ROPE);
    for (int i = bidx() * 256 + tidx(); i < 4096 * 32; i += gdim() * 256) {
      int pos = i >> 5, j = i & 31;
      float freq = expf(-(float)j * (9.210340371976184f / 32.f));
      float ang = (float)pos * freq;
      float sn, cs; sincosf(ang, &sn, &cs);
      rope[i] = make_float2(cs, sn);
    }
  }
}

__device__ __forceinline__ void phase_gemm_in(KP P, int li, bf16* smem) {
  EPI_VARS
  const bf16* X = (const bf16*)(P->ws + W_X);
  const bf16* Wt = (const bf16*)(P->ws + W_IN);
  bf16* H = (bf16*)(P->ws + W_H);
  bf16* HT = (bf16*)(P->ws + W_HT);
  const float2* rope = (const float2*)(P->ws + W_ROPE);
  float* out = P->out;
  for (int t = bidx(); t < 7 * 512; t += gdim()) {
    const int x_ = t & 7, q_ = t >> 3;
    const int loc_ = q_ & 63;
    int mt2, nt;
    if (t < 6 * 512) {
      const int sidx_ = ((q_ >> 6) * 8 + x_) * 2 + (loc_ >> 5);
      const int sm_ = sidx_ / 6, sn_ = sidx_ - sm_ * 6;
      mt2 = sm_ * 4 + ((loc_ & 31) >> 3); nt = sn_ * 8 + (loc_ & 7);
    } else {
      if (loc_ >= 24) continue;
      const int id_ = loc_ * 8 + x_;
      mt2 = 64 + (id_ & 3); nt = id_ >> 2;
    }
    if (nt >= 46) continue;
    const int n0 = nt * 128;
    f32x16 acc2[2][2][2];
    zero_acc(acc2[0]); zero_acc(acc2[1]);
    {
      const bf16* Ab = X + (size_t)mt2 * 256 * 1024;
      const bf16* Bb = Wt + (size_t)n0 * 1024;
      gemm_kloop_tall(acc2,
        [&](int r, int kc) { return *(const uint4*)(Ab + (size_t)r * 1024 + kc * 8); },
        [&](int r, int kc) { return *(const uint4*)(Bb + (size_t)r * 1024 + kc * 8); }, 32, smem);
    }
   auto epilogue = [&](f32x16 (&acc)[2][2], const int m0) {
    EPI_BASE
    const int cb = n0 + wn * 64;
    if (cb >= C_QRET && cb < C_VRET) {
      const float sc = (cb < C_KRET) ? 0.125f : 1.f;
#pragma unroll
      for (int mi = 0; mi < 2; mi++)
#pragma unroll
        for (int r = 0; r < 16; r++) {
          int row = m0 + EPI_ROW(mi, r);
          int pos = row < NPTOK ? (row & 4095) : 2048 + ((row - NPTOK) & 63);
          float2 cs = rope[pos * 32 + (lane & 31)];
          float x1 = acc[mi][0][r], x2 = acc[mi][1][r];
          acc[mi][0][r] = (x1 * cs.x - x2 * cs.y) * sc;
          acc[mi][1][r] = (x1 * cs.y + x2 * cs.x) * sc;
        }
    }
    if (cb >= C_KATT && cb < C_QRET) {
      const bool isv = cb >= C_VATT;
      const int c0 = isv ? C_VATT : C_KATT;
#pragma unroll
      for (int mi = 0; mi < 2; mi++)
#pragma unroll
        for (int r = 0; r < 16; r++) {
          int row = m0 + EPI_ROW(mi, r);
#pragma unroll
          for (int ni = 0; ni < 2; ni++) {
            int col = n0 + EPI_COL(ni) - c0;
            if (row < NPTOK) {
              int b = row >> 12, tt = row & 4095;
              if (tt >= 3584) out[(isv ? O_AV_P : O_AK_P) + (((size_t)(li * 4 + b) * 512 + (tt - 3584)) * 512 + col)] = acc[mi][ni][r];
            } else {
              int rs = row - NPTOK;
              out[(isv ? O_AV_S : O_AK_S) + ((size_t)li * 1024 + rs) * 512 + col] = acc[mi][ni][r];
            }
          }
        }
    }
    int trow = -1;
    if (cb >= C_VATT && cb < C_QRET) trow = cb - C_VATT;
    else if (cb >= C_KRET && cb < C_VRET) trow = 512 + cb - C_KRET;
    else if (cb >= C_VRET && cb < C_GRET) trow = 768 + cb - C_VRET;
    if (trow >= 0) {
#pragma unroll
      for (int mi = 0; mi < 2; mi++)
#pragma unroll
        for (int ni = 0; ni < 2; ni++)
#pragma unroll
          for (int rg = 0; rg < 4; rg++) {
            int rowb = m0 + wm * 64 + mi * 32 + 8 * rg + 4 * (lane >> 5);
            uint2 o; o.x = pack2(acc[mi][ni][rg * 4], acc[mi][ni][rg * 4 + 1]); o.y = pack2(acc[mi][ni][rg * 4 + 2], acc[mi][ni][rg * 4 + 3]);
            *(uint2*)(HT + (size_t)(trow + ni * 32 + (lane & 31)) * NTOK + rowb) = o;
          }
    }
    const bool skipH = (n0 >= C_VATT && n0 < C_QRET) || (n0 >= C_VRET && n0 < C_GRET);
    if (!skipH) epi_rowmajor(acc, smem, [&](int row, int c8, float (&v)[8]) {
      uint4 o; o.x = pack2(v[0], v[1]); o.y = pack2(v[2], v[3]); o.z = pack2(v[4], v[5]); o.w = pack2(v[6], v[7]);
      *(uint4*)(H + (size_t)(m0 + row) * INC + n0 + c8) = o;
    });
   };
   epilogue(acc2[0], mt2 * 256);
   epilogue(acc2[1], mt2 * 256 + 128);
  }
}

#define AP_LD 72
__device__ __forceinline__ void attn_item(KP P, int li, int item, bf16* smem) {
  float* bias = (float*)smem;
  bf16* pbuf = smem + 2048;
  const bf16* H = (const bf16*)(P->ws + W_H);
  const bf16* HT = (const bf16*)(P->ws + W_HT);
  bf16* Yatt = (bf16*)(P->ws + W_YATT);
  const int h = item & 7, cidx = item >> 3;
  const float* tab = P->in[I_BIAS] + (size_t)li * 513 * 8;
  const int tid = opaque(tidx());
  const int lane = tid & 63, w = tid >> 6, l15 = lane & 15, g = lane >> 4;
  __syncthreads();
  for (int i = tid; i < 640; i += 256) bias[i] = tab[(min(i - 63, 256) + 256) * 8 + h];
  const int row0 = cidx * 64;
  const bf16* Qp = H + (size_t)(row0 + w * 16) * INC + C_QATT + h * 64;
  const bf16* Kcur = H + (size_t)row0 * INC + C_KATT + h * 64;
  const bf16* VTcur = HT + (size_t)(h * 64) * NTOK + row0;
  bf16* Yout = Yatt + (size_t)(row0 + w * 16) * 512 + h * 64;
  const bf16* Kpast; const bf16* VTpast; int kst; size_t vst; int jt_start, smin;
  if (cidx < 256) {
    int c = cidx & 63;
    jt_start = c >= 8 ? 0 : 32 - 4 * c;
    smin = c >= 8 ? 0 : 8 - c;
    Kpast = Kcur - (ptrdiff_t)512 * INC; kst = INC;
    VTpast = VTcur - 512; vst = NTOK;
  } else {
    int b = cidx - 256;
    jt_start = 0; smin = 0;
    Kpast = (const bf16*)(P->ws + W_CK) + (size_t)b * 512 * 512 + h * 64; kst = 512;
    VTpast = (const bf16*)(P->ws + W_CVT) + (size_t)b * 512 * 512 + (size_t)(h * 64) * 512; vst = 512;
  }
  const int lr = tid >> 2, lc = (tid & 3) * 16;
  bf16x8 qf[2];
#pragma unroll
  for (int ks = 0; ks < 2; ks++) qf[ks] = u4_to_frag(*(const uint4*)(Qp + (size_t)l15 * INC + ks * 32 + g * 8));
  uint4 r0a, r0b, r1a, r1b, r2a, r2b;
#define AP_LOAD(p, va, vb) { const int step_ = ((p) < 9) ? (p) : (p) - 9; const int se_ = max(step_, smin); const bf16* src_; \
    if ((p) < 9) src_ = (se_ < 8) ? (Kpast + (ptrdiff_t)(se_ * 64 + lr) * kst) : (Kcur + (size_t)lr * INC); \
    else src_ = (se_ < 8) ? (VTpast + (size_t)lr * vst + se_ * 64) : (VTcur + (size_t)lr * NTOK); \
    va = *(const uint4*)(src_ + lc); vb = *(const uint4*)(src_ + lc + 8); }
#define AP_STORE(p, va, vb) { bf16* dst_ = pbuf + ((p) & 1) * (64 * AP_LD) + lr * AP_LD + lc; *(uint4*)dst_ = va; *(uint4*)(dst_ + 8) = vb; }
  AP_LOAD(0, r0a, r0b) AP_LOAD(1, r1a, r1b) AP_LOAD(2, r2a, r2b)
  AP_STORE(0, r0a, r0b)
  __syncthreads();
  f32x4 s[36];
#pragma unroll
  for (int p = 0; p < 9; p++) {
    const bf16* pc = pbuf + (p & 1) * (64 * AP_LD);
#pragma unroll
    for (int t = 0; t < 4; t++) {
      const int jt = p * 4 + t;
      s[jt] = f32x4{0.f, 0.f, 0.f, 0.f};
#pragma unroll
      for (int ks = 0; ks < 2; ks++) {
        bf16x8 kf = *(const bf16x8*)(pc + (t * 16 + l15) * AP_LD + ks * 32 + g * 8);
        s[jt] = __builtin_amdgcn_mfma_f32_16x16x32_bf16(kf, qf[ks], s[jt], 0, 0, 0);
      }
    }
    AP_STORE(p + 1, r1a, r1b)
    r1a = r2a; r1b = r2b;
    AP_LOAD(p + 3, r2a, r2b)
    __syncthreads();
  }
  float inv;
  {
    const int iq = w * 16 + l15;
    const float* bq = bias + (iq - 4 * g + 575);
    float mx = -3.0e38f;
#pragma unroll
    for (int jt = 0; jt < 36; jt++) {
#pragma unroll
      for (int r = 0; r < 4; r++) {
        float v = s[jt][r] * 0.125f + bq[-(jt * 16 + r)];
        if (jt < 32) v = (jt < jt_start) ? -3.0e38f : v;
        s[jt][r] = v;
        mx = fmaxf(mx, v);
      }
    }
    mx = fmaxf(mx, __shfl_xor(mx, 16));
    mx = fmaxf(mx, __shfl_xor(mx, 32));
    float sum = 0.f;
#pragma unroll
    for (int jt = 0; jt < 36; jt++) {
#pragma unroll
      for (int r = 0; r < 4; r++) { float e = __expf(s[jt][r] - mx); s[jt][r] = e; sum += e; }
    }
    sum += __shfl_xor(sum, 16);
    sum += __shfl_xor(sum, 32);
    inv = 1.f / sum;
  }
  f32x4 o[4];
#pragma unroll
  for (int et = 0; et < 4; et++) o[et] = f32x4{0.f, 0.f, 0.f, 0.f};
#pragma unroll
  for (int p = 9; p < 18; p++) {
    const bf16* pc = pbuf + (p & 1) * (64 * AP_LD);
    const int step = p - 9;
#pragma unroll
    for (int u = 0; u < 2; u++) {
      const int kk = step * 2 + u;
      union { uint4 u4; bf16x8 f; } pf;
      pf.u4.x = pack2(s[2 * kk][0], s[2 * kk][1]); pf.u4.y = pack2(s[2 * kk][2], s[2 * kk][3]);
      pf.u4.z = pack2(s[2 * kk + 1][0], s[2 * kk + 1][1]); pf.u4.w = pack2(s[2 * kk + 1][2], s[2 * kk + 1][3]);
#pragma unroll
      for (int et = 0; et < 4; et++) {
        const bf16* vp = pc + (et * 16 + l15) * AP_LD + u * 32 + 4 * g;
        union { uint4 u4; bf16x8 f; } vf;
        uint2 a = *(const uint2*)vp, b = *(const uint2*)(vp + 16);
        vf.u4.x = a.x; vf.u4.y = a.y; vf.u4.z = b.x; vf.u4.w = b.y;
        o[et] = __builtin_amdgcn_mfma_f32_16x16x32_bf16(vf.f, pf.f, o[et], 0, 0, 0);
      }
    }
    if (p + 1 < 18) { AP_STORE(p + 1, r1a, r1b) }
    r1a = r2a; r1b = r2b;
    if (p + 3 < 18) { AP_LOAD(p + 3, r2a, r2b) }
    __syncthreads();
  }
#pragma unroll
  for (int et = 0; et < 4; et++) {
    uint2 ov; ov.x = pack2(o[et][0] * inv, o[et][1] * inv); ov.y = pack2(o[et][2] * inv, o[et][3] * inv);
    *(uint2*)(Yout + (size_t)l15 * 512 + et * 16 + 4 * g) = ov;
  }
}

__device__ __forceinline__ void ret_contrib_item(KP P, int item) {
  const bf16* HT = (const bf16*)(P->ws + W_HT);
  float* CT = (float*)(P->ws + W_CT);
  const int h = item & 3, cidx = item >> 2;
  const int lane = opaque(tidx() & 63), w = tidx() >> 6, l15 = lane & 15, g = lane >> 4;
  const float lg2 = log2f(1.f - exp2f(-5.f - (float)h));
  const int tok0 = cidx * 64;
  f32x4 acc[4];
#pragma unroll
  for (int dt = 0; dt < 4; dt++) acc[dt] = f32x4{0.f, 0.f, 0.f, 0.f};
#pragma unroll
  for (int ks = 0; ks < 2; ks++) {
    uint4 vr = *(const uint4*)(HT + (size_t)(768 + h * 64 + w * 16 + l15) * NTOK + tok0 + ks * 32 + g * 8);
    unsigned vv[4] = {vr.x, vr.y, vr.z, vr.w};
    union { uint4 u; bf16x8 f; } vf;
    unsigned oo[4];
#pragma unroll
    for (int q = 0; q < 4; q++) {
      int j = ks * 32 + g * 8 + 2 * q;
      float k0 = exp2f(lg2 * (float)(63 - j)), k1 = exp2f(lg2 * (float)(62 - j));
      oo[q] = pack2(bflo(vv[q]) * k0, bfhi(vv[q]) * k1);
    }
    vf.u = make_uint4(oo[0], oo[1], oo[2], oo[3]);
#pragma unroll
    for (int dt = 0; dt < 4; dt++) {
      bf16x8 kf = u4_to_frag(*(const uint4*)(HT + (size_t)(512 + h * 64 + dt * 16 + l15) * NTOK + tok0 + ks * 32 + g * 8));
      acc[dt] = __builtin_amdgcn_mfma_f32_16x16x32_bf16(vf.f, kf, acc[dt], 0, 0, 0);
    }
  }
#pragma unroll
  for (int dt = 0; dt < 4; dt++)
#pragma unroll
    for (int r = 0; r < 4; r++) {
      int e = w * 16 + 4 * g + r, d = dt * 16 + l15;
      CT[((size_t)(cidx * 4 + h) * 64 + e) * 64 + d] = acc[dt][r];
    }
}

__device__ __forceinline__ void ssm_state_tile(KP P, int t, bf16* smem) {
  EPI_VARS
  const bf16* H = (const bf16*)(P->ws + W_H);
  const bf16* Bst = (const bf16*)(P->ws + W_BST);
  float* SC = (float*)(P->ws + W_SC);
  const int g = t / 3, mt = t % 3;
  const int m0 = mt * 128;
  f32x16 acc[2][2];
  zero_acc(acc);
  const bf16* Bb = Bst + (size_t)g * 128 * 1024;
  gemm_kloop(acc,
    [&](int r, int kc) { int c = min(m0 + r, NCHUNK - 1); int s = kc >> 1, q0 = (kc & 1) * 8;
                         return *(const uint4*)(H + (size_t)(c * 64 + s) * INC + g * 16 + q0); },
    [&](int r, int kc) { return *(const uint4*)(Bb + (size_t)r * 1024 + kc * 8); }, 0, 16, smem);
    EPI_BASE
#pragma unroll
  for (int mi = 0; mi < 2; mi++)
#pragma unroll
    for (int ni = 0; ni < 2; ni++)
#pragma unroll
      for (int r = 0; r < 16; r++) {
        int c = m0 + EPI_ROW(mi, r), nn = EPI_COL(ni);
        if (c < NCHUNK) SC[((size_t)c * 16 + g) * 128 + nn] = acc[mi][ni][r];
      }
}

__device__ __forceinline__ void phase_A(KP P, int li, bf16* smem) {
  const int n_attn = NCHUNK * 8, n_ret = NCHUNK * 4, n_ssm = 48;
  const int total = n_attn + n_ret + n_ssm;
  for (int t = bidx(); t < total; t += gdim()) {
    if (t < n_ssm) ssm_state_tile(P, t, smem);
    else if (t < n_ssm + n_attn) attn_item(P, li, t - n_ssm, smem);
    else ret_contrib_item(P, t - n_ssm - n_attn);
  }
}

__device__ __forceinline__ void phase_B(KP P, int li) {
  const float* CT = (const float*)(P->ws + W_CT);
  bf16* SP = (bf16*)(P->ws + W_SPREV);
  const float* SC = (const float*)(P->ws + W_SC);
  bf16* HS = (bf16*)(P->ws + W_HS);
  float* out = P->out;
  const int gt = bidx() * 256 + tidx(), gn = gdim() * 256;
  for (int i = gt; i < 65536; i += gn) {
    int ed = i & 4095, h = (i >> 12) & 3, b = i >> 14;
    float g64 = exp2f(64.f * log2f(1.f - exp2f(-5.f - (float)h)));
    float S = 0.f;
    for (int c0 = 0; c0 < 64; c0 += 16) {
      float ct[16];
#pragma unroll
      for (int u = 0; u < 16; u++) ct[u] = CT[((size_t)((b * 64 + c0 + u) * 4 + h)) * 4096 + ed];
#pragma unroll
      for (int u = 0; u < 16; u++) {
        SP[((size_t)((b * 64 + c0 + u) * 4 + h)) * 4096 + ed] = f2bf(S);
        S = g64 * S + ct[u];
      }
    }
    int e = ed >> 6, d = ed & 63;
    out[O_RET_P + ((size_t)((li * 4 + b) * 4 + h)) * 4096 + d * 64 + e] = S;
  }
  for (int i = gt; i < 262144; i += gn) {
    int ed = i & 4095, h = (i >> 12) & 3, b = i >> 14;
    int e = ed >> 6, d = ed & 63;
    float g64 = exp2f(64.f * log2f(1.f - exp2f(-5.f - (float)h)));
    size_t sidx = ((size_t)((li * 16 + b) * 4 + h)) * 4096 + d * 64 + e;
    float S = P->in[I_SRET][sidx];
    size_t idx = ((size_t)((256 + b) * 4 + h)) * 4096 + ed;
    SP[idx] = f2bf(S);
    S = g64 * S + CT[idx];
    out[O_RET_S + sidx] = S;
  }
  for (int i = gt; i < 4096 + 16384; i += gn) {
    const bool prompt = i < 4096;
    int j = prompt ? i : i - 4096;
    int n = j & 63, g = (j >> 6) & 15, b = j >> 10;
    float dt = expf(P->in[I_LDT][li * 16 + g]);
    float ar = P->in[I_LRE][li * 1024 + g * 64 + n] * dt, ai = P->in[I_LIM][li * 1024 + g * 64 + n] * dt;
    float mag = expf(ar * 64.f); float sn, cs; sincosf(ai * 64.f, &sn, &cs);
    float a_r = mag * cs, a_i = mag * sn;
    if (prompt) {
      float hr = 0.f, hi = 0.f;
      for (int c0 = 0; c0 < 64; c0 += 16) {
        float2 cc[16];
#pragma unroll
        for (int u = 0; u < 16; u++) cc[u] = *(const float2*)(SC + ((size_t)(b * 64 + c0 + u) * 16 + g) * 128 + n * 2);
#pragma unroll
        for (int u = 0; u < 16; u++) {
          size_t idx = ((size_t)(b * 64 + c0 + u) * 16 + g) * 128 + n * 2;
          *(unsigned*)(HS + idx) = pack2(hr, hi);
          float nr = a_r * hr - a_i * hi + cc[u].x, ni = a_r * hi + a_i * hr + cc[u].y;
          hr = nr; hi = ni;
        }
      }
      out[O_SRE_P + ((size_t)(li * 4 + b) * 16 + g) * 64 + n] = hr;
      out[O_SIM_P + ((size_t)(li * 4 + b) * 16 + g) * 64 + n] = hi;
    } else {
      size_t sidx = ((size_t)(li * 16 + b) * 16 + g) * 64 + n;
      float hr = P->in[I_SRE][sidx], hi = P->in[I_SIM][sidx];
      size_t idx = ((size_t)(256 + b) * 16 + g) * 128 + n * 2;
      *(unsigned*)(HS + idx) = pack2(hr, hi);
      float cr = SC[idx], ci = SC[idx + 1];
      out[O_SRE_S + sidx] = a_r * hr - a_i * hi + cr;
      out[O_SIM_S + sidx] = a_r * hi + a_i * hr + ci;
    }
  }
}

__device__ __forceinline__ void ret_finish_item(KP P, int li, int item) {
  const bf16* H = (const bf16*)(P->ws + W_H);
  const bf16* HT = (const bf16*)(P->ws + W_HT);
  const bf16* SP = (const bf16*)(P->ws + W_SPREV);
  bf16* Yret = (bf16*)(P->ws + W_YRET);
  const float* gng = P->in[I_GNG] + li * 256;
  const int h = item & 3, cidx = item >> 2;
  const int lane = opaque(tidx() & 63), w = tidx() >> 6, l15 = lane & 15, g = lane >> 4;
  const float lg2 = log2f(1.f - exp2f(-5.f - (float)h));
  const int row0 = cidx * 64;
  const int iq = w * 16 + l15;
  bf16x8 qf[2];
#pragma unroll
  for (int ks = 0; ks < 2; ks++) qf[ks] = u4_to_frag(*(const uint4*)(H + (size_t)(row0 + iq) * INC + C_QRET + h * 64 + ks * 32 + g * 8));
  f32x4 s[4];
#pragma unroll
  for (int jt = 0; jt < 4; jt++) {
    s[jt] = f32x4{0.f, 0.f, 0.f, 0.f};
#pragma unroll
    for (int ks = 0; ks < 2; ks++) {
      bf16x8 kf = u4_to_frag(*(const uint4*)(H + (size_t)(row0 + jt * 16 + l15) * INC + C_KRET + h * 64 + ks * 32 + g * 8));
      s[jt] = __builtin_amdgcn_mfma_f32_16x16x32_bf16(kf, qf[ks], s[jt], 0, 0, 0);
    }
#pragma unroll
    for (int r = 0; r < 4; r++) {
      int j = jt * 16 + 4 * g + r;
      int dd = iq - j; dd = dd < 0 ? -dd : dd;
      s[jt][r] *= exp2f(lg2 * (float)dd);
    }
  }
  f32x4 o[4], oi[4];
#pragma unroll
  for (int et = 0; et < 4; et++) { o[et] = f32x4{0.f, 0.f, 0.f, 0.f}; oi[et] = f32x4{0.f, 0.f, 0.f, 0.f}; }
#pragma unroll
  for (int kk = 0; kk < 2; kk++) {
    union { uint4 u; bf16x8 f; } pf;
    pf.u.x = pack2(s[2 * kk][0], s[2 * kk][1]); pf.u.y = pack2(s[2 * kk][2], s[2 * kk][3]);
    pf.u.z = pack2(s[2 * kk + 1][0], s[2 * kk + 1][1]); pf.u.w = pack2(s[2 * kk + 1][2], s[2 * kk + 1][3]);
#pragma unroll
    for (int et = 0; et < 4; et++) {
      const bf16* vp = HT + (size_t)(768 + h * 64 + et * 16 + l15) * NTOK + row0 + kk * 32 + 4 * g;
      union { uint4 u; bf16x8 f; } vf;
      uint2 a = *(const uint2*)vp, b = *(const uint2*)(vp + 16);
      vf.u.x = a.x; vf.u.y = a.y; vf.u.z = b.x; vf.u.w = b.y;
      o[et] = __builtin_amdgcn_mfma_f32_16x16x32_bf16(vf.f, pf.f, o[et], 0, 0, 0);
    }
  }
#pragma unroll
  for (int ks = 0; ks < 2; ks++)
#pragma unroll
    for (int et = 0; et < 4; et++) {
      bf16x8 sf = u4_to_frag(*(const uint4*)(SP + ((size_t)(cidx * 4 + h) * 64 + et * 16 + l15) * 64 + ks * 32 + g * 8));
      oi[et] = __builtin_amdgcn_mfma_f32_16x16x32_bf16(sf, qf[ks], oi[et], 0, 0, 0);
    }
  const float qw = exp2f(lg2 * (float)(iq + 1));
  float sum = 0.f;
#pragma unroll
  for (int et = 0; et < 4; et++)
#pragma unroll
    for (int r = 0; r < 4; r++) { o[et][r] += qw * oi[et][r]; sum += o[et][r]; }
  sum += __shfl_xor(sum, 16); sum += __shfl_xor(sum, 32);
  const float mu = sum * (1.f / 64.f);
  float vs = 0.f;
#pragma unroll
  for (int et = 0; et < 4; et++)
#pragma unroll
    for (int r = 0; r < 4; r++) { float d = o[et][r] - mu; vs += d * d; }
  vs += __shfl_xor(vs, 16); vs += __shfl_xor(vs, 32);
  const float rstd = rsqrtf(vs * (1.f / 64.f) + LN_EPS);
#pragma unroll
  for (int et = 0; et < 4; et++) {
    int e0 = et * 16 + 4 * g;
    uint2 gr = *(const uint2*)(H + (size_t)(row0 + iq) * INC + C_GRET + h * 64 + e0);
    float gv[4] = {bflo(gr.x), bfhi(gr.x), bflo(gr.y), bfhi(gr.y)};
    float y[4];
#pragma unroll
    for (int r = 0; r < 4; r++) {
      float gg = gv[r];
      y[r] = (o[et][r] - mu) * rstd * gng[h * 64 + e0 + r] * (gg * sigmoidf_(gg));
    }
    uint2 ov; ov.x = pack2(y[0], y[1]); ov.y = pack2(y[2], y[3]);
    *(uint2*)(Yret + (size_t)(row0 + iq) * 256 + h * 64 + e0) = ov;
  }
}

__device__ __forceinline__ void ssm_toep_tile(KP P, int li, int t, bf16* smem) {
  EPI_VARS
  const bf16* H = (const bf16*)(P->ws + W_H);
  const bf16* Tt = (const bf16*)(P->ws + W_TT);
  const bf16* HS = (const bf16*)(P->ws + W_HS);
  bf16* Zs = (bf16*)(P->ws + W_CT);
  const float* dsk = P->in[I_SD] + li * 256;
  const int g = t / 24, r24 = t % 24, mt = r24 / 8, nt = r24 % 8;
  const int m0 = mt * 128, n0 = nt * 128;
  f32x16 acc[2][2];
  zero_acc(acc);
  const bf16* Kg = Tt + (size_t)g * 64 * 256;
  const bf16* Cg = Tt + KERN_ELEMS + ((size_t)g * 1024 + n0) * 128;
  auto al = [&](int r, int kc) {
    int c = min(m0 + r, NCHUNK - 1);
    if (kc < 128) { int s = kc >> 1, q0 = (kc & 1) * 8; return *(const uint4*)(H + (size_t)(c * 64 + s) * INC + g * 16 + q0); }
    return *(const uint4*)(HS + ((size_t)c * 16 + g) * 128 + (kc - 128) * 8);
  };
  auto bl = [&](int r, int kc) {
    if (kc < 128) {
      int n = n0 + r, tt = n >> 4, p = n & 15, ss = kc >> 1, q0 = (kc & 1) * 8;
      int d = tt - ss;
      uint4 v = *(const uint4*)(Kg + ((size_t)max(d, 0) * 16 + p) * 16 + q0);
      if (d < 0) v = make_uint4(0u, 0u, 0u, 0u);
      return v;
    }
    return *(const uint4*)(Cg + (size_t)r * 128 + (kc - 128) * 8);
  };
  gemm_kloop(acc, al, bl, 0, 2 * (nt + 1), smem);
  gemm_kloop(acc, al, bl, 16, 2, smem);
    EPI_BASE
#pragma unroll
  for (int mi = 0; mi < 2; mi++)
#pragma unroll
    for (int ni = 0; ni < 2; ni++)
#pragma unroll
      for (int r = 0; r < 16; r++) {
        int c = m0 + EPI_ROW(mi, r), n = n0 + EPI_COL(ni);
        if (c < NCHUNK) {
          int tt = n >> 4, p = n & 15;
          size_t tok = (size_t)c * 64 + tt;
          float u = bf2f(H[tok * INC + g * 16 + p]);
          float y = acc[mi][ni][r] + dsk[g * 16 + p] * u;
          Zs[tok * 256 + g * 16 + p] = f2bf(gelu_tanh(y));
        }
      }
}

__device__ __forceinline__ void phase_C(KP P, int li, bf16* smem) {
  const int n_toep = 16 * 24, n_ret = NCHUNK * 4;
  for (int t = bidx(); t < n_toep + n_ret; t += gdim()) {
    if (t < n_toep) ssm_toep_tile(P, li, t, smem);
    else ret_finish_item(P, li, t - n_toep);
  }
}

__device__ __forceinline__ void phase_D(KP P, int li, bf16* smem) {
  EPI_VARS
  const bf16* Zs = (const bf16*)(P->ws + W_CT);
  const bf16* Wt = (const bf16*)(P->ws + W_GLU);
  bf16* Yssm = (bf16*)(P->ws + W_YSSM);
  const float* bg = P->in[I_BGLU] + li * 256;
  for (int t = bidx(); t < 136 * 2; t += gdim()) {
    const int m0 = (t >> 1) * 128, n0 = (t & 1) * 128;
    f32x16 acc[2][2];
    zero_acc(acc);
    const bf16* Ab = Zs + (size_t)m0 * 256;
    const bf16* Bb = Wt + (size_t)n0 * 256;
    gemm_kloop(acc,
      [&](int r, int kc) { return *(const uint4*)(Ab + (size_t)r * 256 + kc * 8); },
      [&](int r, int kc) { return *(const uint4*)(Bb + (size_t)r * 256 + kc * 8); }, 0, 4, smem);
    EPI_BASE
#pragma unroll
    for (int mi = 0; mi < 2; mi++)
#pragma unroll
      for (int ni = 0; ni < 2; ni++)
#pragma unroll
        for (int r = 0; r < 16; r++) {
          int row = m0 + EPI_ROW(mi, r), col = n0 + EPI_COL(ni);
          float z = bf2f(Zs[(size_t)row * 256 + col]);
          Yssm[(size_t)row * 256 + col] = f2bf(z * sigmoidf_(acc[mi][ni][r] + bg[col]));
        }
  }
}

__device__ __forceinline__ void phase_E(KP P, int li, bf16* smem) {
  EPI_VARS
  const bf16* H = (const bf16*)(P->ws + W_H);
  bf16* MG = (bf16*)(P->ws + W_HT);
  for (int t = bidx(); t < SWZ_TOTAL(8); t += gdim()) {
    int mt_, nt_;
    if (!tile_swz(t, 8, mt_, nt_)) continue;
    const int m0 = mt_ * 128, n0 = nt_ * 128;
    f32x16 tot[2][2];
    zero_acc(tot);
#pragma unroll 1
    for (int br = 0; br < 3; br++) {
      const bf16* Y = (const bf16*)(P->ws + (br == 0 ? W_YSSM : (br == 1 ? W_YATT : W_YRET)));
      const bf16* Wt = (const bf16*)(P->ws + (br == 0 ? W_BRS : (br == 1 ? W_BRA : W_BRR)));
      const int K = (br == 1) ? 512 : 256;
      f32x16 acc[2][2];
      zero_acc(acc);
      const bf16* Ab = Y + (size_t)m0 * K;
      const bf16* Bb = Wt + (size_t)n0 * K;
      gemm_kloop_light(acc,
        [&](int r, int kc) { return *(const uint4*)(Ab + (size_t)r * K + kc * 8); },
        [&](int r, int kc) { return *(const uint4*)(Bb + (size_t)r * K + kc * 8); }, 0, K / 64, smem);
#pragma unroll
      for (int mi = 0; mi < 2; mi++)
#pragma unroll
        for (int ni = 0; ni < 2; ni++) {
          EPI_BASE
#pragma unroll
          for (int r = 0; r < 16; r++) {
            int row = m0 + EPI_ROW(mi, r), col = n0 + EPI_COL(ni);
            float gt = bf2f(H[(size_t)row * INC + C_GATE + br * 1024 + col]);
            tot[mi][ni][r] += sigmoidf_(gt) * acc[mi][ni][r];
          }
        }
    }
    EPI_BASE
#pragma unroll
    for (int mi = 0; mi < 2; mi++)
#pragma unroll
      for (int ni = 0; ni < 2; ni++)
#pragma unroll
        for (int r = 0; r < 16; r++) {
          int row = m0 + EPI_ROW(mi, r), col = n0 + EPI_COL(ni);
          MG[(size_t)row * 1024 + col] = f2bf(tot[mi][ni][r]);
        }
  }
  { int jb, jn; if (light_block(1, jb, jn)) convert_fp8_job(P->in[I_PU] + (size_t)li * 16384 * 1024, P->ws + W_U, 16384ull * 1024, 256.f, jb, jn); }
}

__device__ __forceinline__ void phase_WO(KP P, int li, bf16* smem) {
  EPI_VARS
  const bf16* MG = (const bf16*)(P->ws + W_HT);
  const bf16* Wt = (const bf16*)(P->ws + W_O);
  const bf16* X = (const bf16*)(P->ws + W_X);
  bf16* Z = (bf16*)(P->ws + W_H);
  for (int t = bidx(); t < 512; t += gdim()) {
    const int x_ = t & 7, loc_ = t >> 3;
    const int sidx_ = x_ * 2 + (loc_ >> 5);
    const int mt2 = sidx_ * 4 + ((loc_ & 31) >> 3), n0 = (loc_ & 7) * 128;
    f32x16 acc2[2][2][2];
    zero_acc(acc2[0]); zero_acc(acc2[1]);
    {
      const bf16* Ab = MG + (size_t)mt2 * 256 * 1024;
      const bf16* Bb = Wt + (size_t)n0 * 1024;
      gemm_kloop_tall(acc2,
        [&](int r, int kc) { return *(const uint4*)(Ab + (size_t)r * 1024 + kc * 8); },
        [&](int r, int kc) { return *(const uint4*)(Bb + (size_t)r * 1024 + kc * 8); }, 32, smem);
    }
    auto store_half = [&](f32x16 (&acc)[2][2], const int m0) {
      epi_rowmajor(acc, smem, [&](int row, int c8, float (&v)[8]) {
        uint4 xr = *(const uint4*)(X + (size_t)(m0 + row) * 1024 + n0 + c8);
        uint4 o;
        o.x = pack2(DN_ALPHA * bflo(xr.x) + v[0], DN_ALPHA * bfhi(xr.x) + v[1]); o.y = pack2(DN_ALPHA * bflo(xr.y) + v[2], DN_ALPHA * bfhi(xr.y) + v[3]);
        o.z = pack2(DN_ALPHA * bflo(xr.z) + v[4], DN_ALPHA * bfhi(xr.z) + v[5]); o.w = pack2(DN_ALPHA * bflo(xr.w) + v[6], DN_ALPHA * bfhi(xr.w) + v[7]);
        *(uint4*)(Z + (size_t)(m0 + row) * 1024 + n0 + c8) = o;
      });
    };
    store_half(acc2[0], mt2 * 256);
    store_half(acc2[1], mt2 * 256 + 128);
  }
  for (int t = 1024 + bidx(); t < SWZ_TOTAL(8); t += gdim()) {
    int mt_, nt_;
    if (!tile_swz(t, 8, mt_, nt_)) continue;
    const int m0 = mt_ * 128, n0 = nt_ * 128;
    f32x16 acc[2][2];
    zero_acc(acc);
    const bf16* Ab = MG + (size_t)m0 * 1024;
    const bf16* Bb = Wt + (size_t)n0 * 1024;
    gemm_kloop(acc,
      [&](int r, int kc) { return *(const uint4*)(Ab + (size_t)r * 1024 + kc * 8); },
      [&](int r, int kc) { return *(const uint4*)(Bb + (size_t)r * 1024 + kc * 8); }, 0, 16, smem);
    EPI_BASE
    epi_rowmajor(acc, smem, [&](int row, int c8, float (&v)[8]) {
      uint4 xr = *(const uint4*)(X + (size_t)(m0 + row) * 1024 + n0 + c8);
      uint4 o;
      o.x = pack2(DN_ALPHA * bflo(xr.x) + v[0], DN_ALPHA * bfhi(xr.x) + v[1]); o.y = pack2(DN_ALPHA * bflo(xr.y) + v[2], DN_ALPHA * bfhi(xr.y) + v[3]);
      o.z = pack2(DN_ALPHA * bflo(xr.z) + v[4], DN_ALPHA * bfhi(xr.z) + v[5]); o.w = pack2(DN_ALPHA * bflo(xr.w) + v[6], DN_ALPHA * bfhi(xr.w) + v[7]);
      *(uint4*)(Z + (size_t)(m0 + row) * 1024 + n0 + c8) = o;
    });
  }
  { int jb, jn; if (light_block(1, jb, jn)) convert_fp8_job(P->in[I_PV] + (size_t)li * 16384 * 1024, P->ws + W_V, 16384ull * 1024, 64.f, jb, jn); }
}

__device__ __forceinline__ void phase_LN(KP P, const float* gam, const float* bet, bool final_out, size_t xoff) {
  const bf16* Z = (const bf16*)(P->ws + W_H);
  bf16* X = (bf16*)(P->ws + xoff);
  const int lane = tidx() & 63;
  const int gw = bidx() * 4 + (tidx() >> 6), nw = gdim() * 4;
#pragma unroll 4
  for (int row = gw; row < NTOK; row += nw) {
    float4 v[4];
    float s = 0.f;
#pragma unroll
    for (int i = 0; i < 4; i++) {
      uint2 zr = *(const uint2*)(Z + (size_t)row * 1024 + i * 256 + lane * 4);
      v[i] = make_float4(bflo(zr.x), bfhi(zr.x), bflo(zr.y), bfhi(zr.y));
      s += v[i].x + v[i].y + v[i].z + v[i].w;
    }
    s = wsum(s);
    const float mu = s * (1.f / 1024.f);
    float q = 0.f;
#pragma unroll
    for (int i = 0; i < 4; i++) { float a = v[i].x - mu, b = v[i].y - mu, c = v[i].z - mu, d = v[i].w - mu; q += a * a + b * b + c * c + d * d; }
    q = wsum(q);
    const float rstd = rsqrtf(q * (1.f / 1024.f) + LN_EPS);
#pragma unroll
    for (int i = 0; i < 4; i++) {
      int col = i * 256 + lane * 4;
      float4 gg = *(const float4*)(gam + col), bb = *(const float4*)(bet + col);
      float4 y;
      y.x = (v[i].x - mu) * rstd * gg.x + bb.x; y.y = (v[i].y - mu) * rstd * gg.y + bb.y;
      y.z = (v[i].z - mu) * rstd * gg.z + bb.z; y.w = (v[i].w - mu) * rstd * gg.w + bb.w;
      uint2 o; o.x = pack2(y.x, y.y); o.y = pack2(y.z, y.w);
      if (!final_out) *(uint2*)(X + (size_t)row * 1024 + col) = o;
      else *(float4*)(P->out + (size_t)row * 1024 + col) = y;
    }
  }
}

__device__ __forceinline__ void phase_PQ(KP P, int li, bf16* smem) {
  EPI_VARS
  const bf16* X = (const bf16*)(P->ws + W_HT);
  const bf16* Wt = (const bf16*)(P->ws + W_QK);
  float* S = (float*)(P->ws + W_H);
  for (int t = bidx(); t < 1024; t += gdim()) {
    const int x_ = t & 7, q_ = t >> 3, loc_ = q_ & 63;
    const int sidx_ = ((q_ >> 6) * 8 + x_) * 2 + (loc_ >> 5);
    const int mt2 = (sidx_ >> 1) * 4 + ((loc_ & 31) >> 3), n0 = ((sidx_ & 1) * 8 + (loc_ & 7)) * 128;
    f32x16 acc2[2][2][2];
    zero_acc(acc2[0]); zero_acc(acc2[1]);
    {
      const bf16* Ab = X + (size_t)mt2 * 256 * 1024;
      const bf16* Bb = Wt + (size_t)n0 * 1024;
      gemm_kloop_tall(acc2,
        [&](int r, int kc) { return *(const uint4*)(Ab + (size_t)r * 1024 + kc * 8); },
        [&](int r, int kc) { return *(const uint4*)(Bb + (size_t)r * 1024 + kc * 8); }, 32, smem);
    }
    auto store_half = [&](f32x16 (&acc)[2][2], const int m0) {
      epi_rowmajor(acc, smem, [&](int row, int c8, float (&v)[8]) {
        float* sp = S + (size_t)(m0 + row) * 2048 + n0 + c8;
        *(float4*)sp = make_float4(v[0], v[1], v[2], v[3]);
        *(float4*)(sp + 4) = make_float4(v[4], v[5], v[6], v[7]);
      });
    };
    store_half(acc2[0], mt2 * 256);
    store_half(acc2[1], mt2 * 256 + 128);
  }
  for (int t = 2048 + bidx(); t < SWZ_TOTAL(16); t += gdim()) {
    int mt_, nt_;
    if (!tile_swz(t, 16, mt_, nt_)) continue;
    const int m0 = mt_ * 128, n0 = nt_ * 128;
    f32x16 acc[2][2];
    zero_acc(acc);
    const bf16* Ab = X + (size_t)m0 * 1024;
    const bf16* Bb = Wt + (size_t)n0 * 1024;
    gemm_kloop(acc,
      [&](int r, int kc) { return *(const uint4*)(Ab + (size_t)r * 1024 + kc * 8); },
      [&](int r, int kc) { return *(const uint4*)(Bb + (size_t)r * 1024 + kc * 8); }, 0, 16, smem);
    EPI_BASE
    epi_rowmajor(acc, smem, [&](int row, int c8, float (&v)[8]) {
      float* sp = S + (size_t)(m0 + row) * 2048 + n0 + c8;
      *(float4*)sp = make_float4(v[0], v[1], v[2], v[3]);
      *(float4*)(sp + 4) = make_float4(v[4], v[5], v[6], v[7]);
    });
  }
  { int jb, jn;
    if (light_block(2, jb, jn)) {
      float* lds = (float*)smem;
      convert_job(P->in[I_PP] + (size_t)li * NPTOK * 256, (bf16*)(P->ws + W_PE), (size_t)NPTOK * 256, jb, jn);
      convert_job(P->in[I_PS] + (size_t)li * 1024 * 256, (bf16*)(P->ws + W_PE) + (size_t)NPTOK * 256, 1024ull * 256, jb, jn);
      transpose_job(P->in[I_WG] + (size_t)li * 1024 * 1024, (bf16*)(P->ws + W_G), 1024, 1024, 1, lds, jb, jn);
      transpose_job(P->in[I_WP] + (size_t)li * 256 * 1024, (bf16*)(P->ws + W_P), 256, 1024, 1, lds, jb, jn);
      if (li == 0 && !MULTI_LAUNCH) pro_cache(P, 1, lds, jb, jn);
    }
  }
}

__device__ __forceinline__ float dpp_max_step(float v, const int ctrl_dummy);
#define DPP_MAX(v, ctrl) v = fmaxf(v, __int_as_float(__builtin_amdgcn_update_dpp(__float_as_int(v), __float_as_int(v), ctrl, 0xf, 0xf, false)))
__device__ __forceinline__ float wave_max(float v) {
  DPP_MAX(v, 0x111);
  DPP_MAX(v, 0x112);
  DPP_MAX(v, 0x114);
  DPP_MAX(v, 0x118);
  DPP_MAX(v, 0x142);
  DPP_MAX(v, 0x143);
  return __int_as_float(__builtin_amdgcn_readlane(__float_as_int(v), 63));
}

__device__ __forceinline__ void top16_of128(float v0, float v1, int lane, float& osc, int& oix) {
  osc = -3.0e38f; oix = 0;
#pragma unroll
  for (int r = 0; r < 16; r++) {
    float m = fmaxf(v0, v1);
    float wm = wave_max(m);
    unsigned long long bal = __ballot(m == wm);
    int src = __ffsll((long long)bal) - 1;
    int sel = (v0 == wm) ? 0 : 1;
    int selu = __builtin_amdgcn_readlane(sel, src);
    if (lane == src) { if (selu == 0) v0 = -3.0e38f; else v1 = -3.0e38f; }
    if (lane == r) { osc = wm; oix = src + 64 * selu; }
  }
}

typedef float f2v __attribute__((ext_vector_type(2)));
__device__ __forceinline__ unsigned fkey(float f) { unsigned u = __float_as_uint(f); return u ^ ((unsigned)((int)u >> 31) | 0x80000000u); }
__device__ __forceinline__ int mbcnt64(unsigned long long m) {
  return __builtin_amdgcn_mbcnt_hi((unsigned)(m >> 32), __builtin_amdgcn_mbcnt_lo((unsigned)m, 0u));
}
template <int NV>
__device__ __forceinline__ unsigned top16_threshold(const unsigned (&k)[NV]) {
  unsigned T = 0u;
#pragma unroll 1
  for (int bit = 31; bit >= 0; bit--) {
    const unsigned c = T | (1u << bit);
    int cnt = 0;
#pragma unroll
    for (int i = 0; i < NV; i++) cnt += __popcll(__ballot(k[i] >= c));
    if (cnt >= 16) T = c;
    if (cnt == 16) break;
  }
  return T;
}

__device__ __forceinline__ void phase_PEER(KP P, int li, bf16* smem) {
  const float* S = (const float*)(P->ws + W_H);
  bf16* X = (bf16*)(P->ws + W_X);
  const bf16* XA = (const bf16*)(P->ws + W_HT);
  const unsigned char* U = P->ws + W_U;
  const unsigned char* V = P->ws + W_V;
  const float* gam = P->in[I_L2G] + li * 1024;
  const float* bet = P->in[I_L2B] + li * 1024;
  const int lane = tidx() & 63;
  const int wv = tidx() >> 6;
  const int gw = bidx() * 4 + wv, nw = gdim() * 4;
  float* wl = (float*)smem + wv * 128;
  int* wli = (int*)wl;
  for (int tok = gw; tok < NTOK; tok += nw) {
    f2v xv[8];
    {
      uint4 a = *(const uint4*)(XA + (size_t)tok * 1024 + lane * 16);
      uint4 b = *(const uint4*)(XA + (size_t)tok * 1024 + lane * 16 + 8);
      xv[0] = f2v{bflo(a.x), bfhi(a.x)}; xv[1] = f2v{bflo(a.y), bfhi(a.y)}; xv[2] = f2v{bflo(a.z), bfhi(a.z)}; xv[3] = f2v{bflo(a.w), bfhi(a.w)};
      xv[4] = f2v{bflo(b.x), bfhi(b.x)}; xv[5] = f2v{bflo(b.y), bfhi(b.y)}; xv[6] = f2v{bflo(b.z), bfhi(b.z)}; xv[7] = f2v{bflo(b.w), bfhi(b.w)};
    }
    f2v outv[8];
#pragma unroll
    for (int i = 0; i < 8; i++) outv[i] = f2v{0.f, 0.f};
    const float* Srow = S + (size_t)tok * 2048;
#define PEER_ROUTE(sv, ts_out, eid_out) { \
      _Pragma("unroll") for (int side = 0; side < 2; side++) { \
        float v0 = sv[side * 2], v1 = sv[side * 2 + 1]; \
        unsigned kk[2] = {fkey(v0), fkey(v1)}; \
        unsigned T = top16_threshold<2>(kk); \
        bool s0 = kk[0] >= T, s1 = kk[1] >= T; \
        unsigned long long m0 = __ballot(s0), m1 = __ballot(s1); \
        int r0 = mbcnt64(m0), r1 = __popcll(m0) + mbcnt64(m1); \
        if (s0 && r0 < 16) { wl[side * 16 + r0] = v0; wli[32 + side * 16 + r0] = lane; } \
        if (s1 && r1 < 16) { wl[side * 16 + r1] = v1; wli[32 + side * 16 + r1] = lane + 64; } \
      } \
      { const int i = lane & 15, j0 = lane >> 4; \
        const float a = wl[i]; const int ai = wli[32 + i]; \
        float cs[4]; int ce[4]; unsigned kk[4]; \
        _Pragma("unroll") for (int m = 0; m < 4; m++) { cs[m] = a + wl[16 + j0 + 4 * m]; ce[m] = ai * 128 + wli[48 + j0 + 4 * m]; kk[m] = fkey(cs[m]); } \
        unsigned T = top16_threshold<4>(kk); \
        int base = 0; \
        _Pragma("unroll") for (int m = 0; m < 4; m++) { \
          bool sl = kk[m] >= T; unsigned long long mm = __ballot(sl); int r = base + mbcnt64(mm); \
          if (sl && r < 16) { wl[64 + r] = cs[m]; wli[80 + r] = ce[m]; } \
          base += __popcll(mm); } } \
      ts_out = wl[64 + (lane & 15)]; eid_out = wli[80 + (lane & 15)]; }
    float sva[4], svb[4];
#pragma unroll
    for (int i = 0; i < 4; i++) { sva[i] = __builtin_nontemporal_load(Srow + i * 64 + lane); svb[i] = __builtin_nontemporal_load(Srow + 256 + i * 64 + lane); }
    float ts; int eid;
    PEER_ROUTE(sva, ts, eid)
#pragma unroll 1
    for (int h = 0; h < 8; h++) {
#pragma unroll
      for (int i = 0; i < 4; i++) { sva[i] = svb[i]; }
      if (h + 2 < 8) {
#pragma unroll
        for (int i = 0; i < 4; i++) svb[i] = __builtin_nontemporal_load(Srow + (h + 2) * 256 + i * 64 + lane);
      }
      uint4 ub[16], vb[8];
#pragma unroll
      for (int k = 0; k < 16; k++) {
        int e = __builtin_amdgcn_readlane(eid, k);
        ub[k] = *(const uint4*)(U + (size_t)e * 1024 + lane * 16);
        if (k < 8) vb[k] = *(const uint4*)(V + (size_t)e * 1024 + lane * 16);
      }
      int eidc = eid;
      float tmax = ts;
      tmax = fmaxf(tmax, __shfl_xor(tmax, 1)); tmax = fmaxf(tmax, __shfl_xor(tmax, 2));
      tmax = fmaxf(tmax, __shfl_xor(tmax, 4)); tmax = fmaxf(tmax, __shfl_xor(tmax, 8));
      float ex = __expf(ts - tmax);
      float den = ex;
      den += __shfl_xor(den, 1); den += __shfl_xor(den, 2); den += __shfl_xor(den, 4); den += __shfl_xor(den, 8);
      float gate = ex / den;
      if (h + 1 < 8) { PEER_ROUTE(sva, ts, eid) }
      float dk[16];
#pragma unroll
      for (int k = 0; k < 16; k++) {
        f2v acc = f2v{0.f, 0.f};
        acc += __builtin_amdgcn_cvt_pk_f32_fp8((int)ub[k].x, false) * xv[0]; acc += __builtin_amdgcn_cvt_pk_f32_fp8((int)ub[k].x, true) * xv[1];
        acc += __builtin_amdgcn_cvt_pk_f32_fp8((int)ub[k].y, false) * xv[2]; acc += __builtin_amdgcn_cvt_pk_f32_fp8((int)ub[k].y, true) * xv[3];
        acc += __builtin_amdgcn_cvt_pk_f32_fp8((int)ub[k].z, false) * xv[4]; acc += __builtin_amdgcn_cvt_pk_f32_fp8((int)ub[k].z, true) * xv[5];
        acc += __builtin_amdgcn_cvt_pk_f32_fp8((int)ub[k].w, false) * xv[6]; acc += __builtin_amdgcn_cvt_pk_f32_fp8((int)ub[k].w, true) * xv[7];
        dk[k] = acc[0] + acc[1];
      }
      uint4 vc[8];
#pragma unroll
      for (int k = 0; k < 8; k++) {
        int e = __builtin_amdgcn_readlane(eidc, 8 + k);
        vc[k] = *(const uint4*)(V + (size_t)e * 1024 + lane * 16);
      }
      {
        bool hi = (lane & 32) != 0;
#pragma unroll
        for (int i = 0; i < 8; i++) { float send = hi ? dk[i] : dk[i + 8]; float keep = hi ? dk[i + 8] : dk[i]; dk[i] = keep + __shfl_xor(send, 32); }
        hi = (lane & 16) != 0;
#pragma unroll
        for (int i = 0; i < 4; i++) { float send = hi ? dk[i] : dk[i + 4]; float keep = hi ? dk[i + 4] : dk[i]; dk[i] = keep + __shfl_xor(send, 16); }
        hi = (lane & 8) != 0;
#pragma unroll
        for (int i = 0; i < 2; i++) { float send = hi ? dk[i] : dk[i + 2]; float keep = hi ? dk[i + 2] : dk[i]; dk[i] = keep + __shfl_xor(send, 8); }
        hi = (lane & 4) != 0;
        { float send = hi ? dk[0] : dk[1]; float keep = hi ? dk[1] : dk[0]; dk[0] = keep + __shfl_xor(send, 4); }
        dk[0] += __shfl_xor(dk[0], 2);
        dk[0] += __shfl_xor(dk[0], 1);
      }
      float wgt = __shfl(gate, (lane >> 2) & 15) * gelu_tanh(dk[0] * (1.f / 256.f)) * (1.f / 64.f);
#pragma unroll
      for (int k = 0; k < 16; k++) {
        float wk = __int_as_float(__builtin_amdgcn_readlane(__float_as_int(wgt), k * 4));
        const f2v wk2 = f2v{wk, wk};
        const uint4 vv = (k < 8) ? vb[k & 7] : vc[k & 7];
        outv[0] += wk2 * __builtin_amdgcn_cvt_pk_f32_fp8((int)vv.x, false); outv[1] += wk2 * __builtin_amdgcn_cvt_pk_f32_fp8((int)vv.x, true);
        outv[2] += wk2 * __builtin_amdgcn_cvt_pk_f32_fp8((int)vv.y, false); outv[3] += wk2 * __builtin_amdgcn_cvt_pk_f32_fp8((int)vv.y, true);
        outv[4] += wk2 * __builtin_amdgcn_cvt_pk_f32_fp8((int)vv.z, false); outv[5] += wk2 * __builtin_amdgcn_cvt_pk_f32_fp8((int)vv.z, true);
        outv[6] += wk2 * __builtin_amdgcn_cvt_pk_f32_fp8((int)vv.w, false); outv[7] += wk2 * __builtin_amdgcn_cvt_pk_f32_fp8((int)vv.w, true);
      }
    }
    float z[16];
    float s = 0.f;
#pragma unroll
    for (int i = 0; i < 8; i++) { z[2 * i] = outv[i][0] + DN_ALPHA * xv[i][0]; z[2 * i + 1] = outv[i][1] + DN_ALPHA * xv[i][1]; s += z[2 * i] + z[2 * i + 1]; }
    s = wsum(s);
    const float mu = s * (1.f / 1024.f);
    float q = 0.f;
#pragma unroll
    for (int i = 0; i < 16; i++) { float d = z[i] - mu; q += d * d; }
    q = wsum(q);
    const float rstd = rsqrtf(q * (1.f / 1024.f) + LN_EPS);
    float y[16];
    const int col = lane * 16;
#pragma unroll
    for (int i4 = 0; i4 < 4; i4++) {
      float4 g = *(const float4*)(gam + col + i4 * 4), b = *(const float4*)(bet + col + i4 * 4);
      y[i4 * 4 + 0] = (z[i4 * 4 + 0] - mu) * rstd * g.x + b.x; y[i4 * 4 + 1] = (z[i4 * 4 + 1] - mu) * rstd * g.y + b.y;
      y[i4 * 4 + 2] = (z[i4 * 4 + 2] - mu) * rstd * g.z + b.z; y[i4 * 4 + 3] = (z[i4 * 4 + 3] - mu) * rstd * g.w + b.w;
    }
    uint4 o0, o1;
    o0.x = pack2(y[0], y[1]); o0.y = pack2(y[2], y[3]); o0.z = pack2(y[4], y[5]); o0.w = pack2(y[6], y[7]);
    o1.x = pack2(y[8], y[9]); o1.y = pack2(y[10], y[11]); o1.z = pack2(y[12], y[13]); o1.w = pack2(y[14], y[15]);
    *(uint4*)(X + (size_t)tok * 1024 + col) = o0;
    *(uint4*)(X + (size_t)tok * 1024 + col + 8) = o1;
  }
}

__device__ __forceinline__ void phase_PLE(KP P, int li, bf16* smem) {
  EPI_VARS
  const bf16* X = (const bf16*)(P->ws + W_X);
  const bf16* PE = (const bf16*)(P->ws + W_PE);
  const bf16* Wg = (const bf16*)(P->ws + W_G);
  const bf16* Wp = (const bf16*)(P->ws + W_P);
  bf16* Z = (bf16*)(P->ws + W_H);
  for (int t = bidx(); t < SWZ_TOTAL(8); t += gdim()) {
    int mt_, nt_;
    if (!tile_swz(t, 8, mt_, nt_)) continue;
    const int m0 = mt_ * 128, n0 = nt_ * 128;
    f32x16 acc[2][2], acc2[2][2];
    zero_acc(acc); zero_acc(acc2);
    {
      const bf16* Ab = X + (size_t)m0 * 1024;
      const bf16* Bb = Wg + (size_t)n0 * 1024;
      gemm_kloop(acc,
        [&](int r, int kc) { return *(const uint4*)(Ab + (size_t)r * 1024 + kc * 8); },
        [&](int r, int kc) { return *(const uint4*)(Bb + (size_t)r * 1024 + kc * 8); }, 0, 16, smem);
    }
    {
      const bf16* Ab = PE + (size_t)m0 * 256;
      const bf16* Bb = Wp + (size_t)n0 * 256;
      gemm_kloop(acc2,
        [&](int r, int kc) { return *(const uint4*)(Ab + (size_t)r * 256 + kc * 8); },
        [&](int r, int kc) { return *(const uint4*)(Bb + (size_t)r * 256 + kc * 8); }, 0, 4, smem);
    }
    EPI_BASE
#pragma unroll
    for (int mi = 0; mi < 2; mi++)
#pragma unroll
      for (int ni = 0; ni < 2; ni++)
#pragma unroll
        for (int r = 0; r < 16; r++) acc[mi][ni][r] = sigmoidf_(acc[mi][ni][r]) * acc2[mi][ni][r];
    epi_rowmajor(acc, smem, [&](int row, int c8, float (&v)[8]) {
      uint4 xr = *(const uint4*)(X + (size_t)(m0 + row) * 1024 + n0 + c8);
      uint4 o;
      o.x = pack2(DN_ALPHA * bflo(xr.x) + v[0], DN_ALPHA * bfhi(xr.x) + v[1]); o.y = pack2(DN_ALPHA * bflo(xr.y) + v[2], DN_ALPHA * bfhi(xr.y) + v[3]);
      o.z = pack2(DN_ALPHA * bflo(xr.z) + v[4], DN_ALPHA * bfhi(xr.z) + v[5]); o.w = pack2(DN_ALPHA * bflo(xr.w) + v[6], DN_ALPHA * bfhi(xr.w) + v[7]);
      *(uint4*)(Z + (size_t)(m0 + row) * 1024 + n0 + c8) = o;
    });
  }
  if (li == 0 && !MULTI_LAUNCH) { int jb, jn; if (light_block(1, jb, jn)) pro_misc(P, 1, (float*)smem, jb, jn); }
}

__device__ __forceinline__ void run_phase(KP P, int li, int k, bf16* smem) {
  switch (k) {
    case PH_PRO: phase_prologue(P, li, smem); break;
    case PH_GIN: phase_gemm_in(P, li, smem); break;
    case PH_A: phase_A(P, li, smem); break;
    case PH_B: phase_B(P, li); break;
    case PH_C: phase_C(P, li, smem); break;
    case PH_D: phase_D(P, li, smem); break;
    case PH_E: phase_E(P, li, smem); break;
    case PH_WO: phase_WO(P, li, smem); break;
    case PH_LN1: phase_LN(P, P->in[I_L1G] + li * 1024, P->in[I_L1B] + li * 1024, false, W_HT); break;
    case PH_PQ: phase_PQ(P, li, smem); break;
    case PH_PEER: phase_PEER(P, li, smem); break;
    case PH_PLE: phase_PLE(P, li, smem); break;
    case PH_LN3: phase_LN(P, P->in[I_L3G] + li * 1024, P->in[I_L3B] + li * 1024, li == 1, W_X); break;
  }
}

#ifndef DUP_MASK
#define DUP_MASK 0
#endif
#define SYNC() xcd_barrier(xb)
#define RUN(k, call) { { KP P = kp_get(); call; } if ((DUP_MASK >> (k)) & 1) { SYNC(); KP P = kp_get(); call; } }
__global__ void __launch_bounds__(256, 2) fwd_kernel(Params Parg) {
  extern __shared__ __attribute__((aligned(16))) unsigned char lds_raw[];
  bf16* smem = (bf16*)lds_raw;
#if MULTI_LAUNCH
  { KP P = kp_get(); run_phase(P, P->pbeg / PH_N, P->pbeg % PH_N, smem); }
#else
  volatile LAS unsigned* st = (volatile LAS unsigned*)(lds_raw + LDS_TILE_BYTES);
  if (threadIdx.x == 0) { st[0] = 0u; st[1] = 0u; st[2] = 0u; st[3] = 0u; }
  __syncthreads();
  XcdBarrier xb;
  { KP P = kp_get(); xb = xcd_barrier_post((unsigned*)(P->ws + W_BAR), st);
    if (P->pad0 == 0x5eed) cg::this_grid().sync();
  }
#pragma unroll 1
  for (int li = 0; li < 2; li++) {
    if (li == 0) { RUN(PH_PRO, phase_prologue(P, li, smem)) SYNC(); }
    RUN(PH_GIN, phase_gemm_in(P, li, smem)) SYNC();
    RUN(PH_A, phase_A(P, li, smem)) SYNC();
    RUN(PH_B, phase_B(P, li)) SYNC();
    RUN(PH_C, phase_C(P, li, smem)) SYNC();
    RUN(PH_D, phase_D(P, li, smem)) SYNC();
    RUN(PH_E, phase_E(P, li, smem)) SYNC();
    RUN(PH_WO, phase_WO(P, li, smem)) SYNC();
    RUN(PH_LN1, phase_LN(P, P->in[I_L1G] + li * 1024, P->in[I_L1B] + li * 1024, false, W_HT)) SYNC();
    RUN(PH_PQ, phase_PQ(P, li, smem)) SYNC();
    RUN(PH_PEER, phase_PEER(P, li, smem)) SYNC();
    RUN(PH_PLE, phase_PLE(P, li, smem)) SYNC();
    RUN(PH_LN3, phase_LN(P, P->in[I_L3G] + li * 1024, P->in[I_L3B] + li * 1024, li == 1, W_X))
    if (li == 0) SYNC();
  }
#endif
}

extern "C" void kernel_launch(void* const* d_in, const int* in_sizes, int n_in, void* d_out, int out_size, void* d_ws,
                              size_t ws_size, hipStream_t stream) {
  static int grid_blocks = 0;
  if (grid_blocks == 0) {
    if (n_in != 38 || (size_t)out_size != O_END || ws_size < WS_END) {
      fprintf(stderr, "kernel_launch: unexpected sizes n_in=%d out=%d ws=%zu need %zu\n", n_in, out_size, ws_size, (size_t)WS_END);
      grid_blocks = -1; return;
    }
    int dev = 0, cus = 0, per_cu = 0;
    hipGetDevice(&dev);
    hipDeviceGetAttribute(&cus, hipDeviceAttributeMultiprocessorCount, dev);
    if (hipFuncSetAttribute((const void*)fwd_kernel, hipFuncAttributeMaxDynamicSharedMemorySize, LDS_BYTES) != hipSuccess) {
      fprintf(stderr, "kernel_launch: hipFuncSetAttribute failed\n"); grid_blocks = -1; return;
    }
    hipOccupancyMaxActiveBlocksPerMultiprocessor(&per_cu, (const void*)fwd_kernel, 256, LDS_BYTES);
    if (per_cu < 1) { fprintf(stderr, "kernel_launch: occupancy query gave %d\n", per_cu); grid_blocks = -1; return; }
    if (per_cu > 2) per_cu = 2;
    grid_blocks = cus * per_cu;
  }
  if (grid_blocks < 0) return;
  Params p{};
  for (int i = 0; i < 38; i++) p.in[i] = (const float*)d_in[i];
  p.out = (float*)d_out;
  p.ws = (unsigned char*)d_ws;
#if MULTI_LAUNCH
  for (int ph = 0; ph < 2 * PH_N; ph++) {
    p.pbeg = ph; p.pend = ph + 1;
    hipLaunchKernelGGL(fwd_kernel, dim3(grid_blocks), dim3(256), LDS_BYTES, stream, p);
  }
#else
  p.pbeg = 0; p.pend = 2 * PH_N;
  if (hipMemsetAsync((char*)d_ws + W_BAR, 0, 16384, stream) != hipSuccess) { fprintf(stderr, "memset failed\n"); return; }
  void* args[] = {&p};
#ifdef PLAIN_LAUNCH
  hipLaunchKernelGGL(fwd_kernel, dim3(grid_blocks), dim3(256), LDS_BYTES, stream, p);
  hipError_t e = hipSuccess; (void)args;
#else
  hipError_t e = hipLaunchCooperativeKernel((const void*)fwd_kernel, dim3(grid_blocks), dim3(256), args, LDS_BYTES, stream);
#endif
  if (e != hipSuccess) fprintf(stderr, "cooperative launch failed: %s (grid %d)\n", hipGetErrorString(e), grid_blocks);
#endif
}
```
